# Optimizing an MI355X kernel written in HIP

```python
import jax, jax.numpy as jnp
from jax import lax
import numpy as np

D_MODEL = 1024
BATCH = 2
SEQ = 16384
DEPTH = 2

GRID_W = 64
CTX_LEN = 256
D_MIX = D_MODEL
D_LRU = D_MIX // 4
LRU_HEADS = 4
LRU_BW = D_LRU // LRU_HEADS
LRU_C = 8.0
CONV_W = 4
CONV_LEFT = 2
D_S5 = D_MIX // 4
S5_H = 16
S5_G = D_S5 // S5_H
S5_P = 64
D_ATT = D_MIX - D_LRU - D_S5
NA_HD = 64
NA_HEADS = D_ATT // NA_HD
NA_KH = 8
NA_KW = 16
NA_QB = NA_KW
NA_KWB = 2 * NA_KW
ROPE_BASE = 10000.0
D_IN = 2 * D_LRU + D_S5 + 3 * D_ATT
N_EXPERTS = 32
TOP_K = 4
D_FF = D_MODEL
SWIGLU_LIMIT = 7.0
SWIGLU_ALPHA = 1.702
MOE_BLOCK = 256
N_MOD = 6
EPS = 1e-6

kernel_name = 'hybrid_rglru_s5_natten_moe_dit'

F32 = jnp.float32


def rmsnorm(x, g):
    xf = x.astype(F32)
    y = xf * lax.rsqrt(jnp.mean(xf * xf, axis=-1, keepdims=True) + EPS)
    return (y * g.astype(F32)).astype(x.dtype)


def modulate(x, g, shift, scale):
    return rmsnorm(x, g) * (1.0 + scale) + shift


def centred_dwconv(x, w, b):
    n = x.shape[1]
    xp = jnp.pad(x, ((0, 0), (CONV_LEFT, CONV_W - 1 - CONV_LEFT), (0, 0)))
    out = b
    for k in range(CONV_W):
        out = out + xp[:, k:k + n] * w[k]
    return out


def _lin_op(e1, e2):
    a1, b1 = e1
    a2, b2 = e2
    return a1 * a2, a2 * b1 + b2


def linear_scan(a, b, h0, reverse):
    a_cum, h = lax.associative_scan(_lin_op, (a, b), axis=1, reverse=reverse)
    if h0 is not None:
        h = h + a_cum * h0[:, None]
    return h


def _cplx_op(e1, e2):
    a1r, a1i, b1r, b1i = e1
    a2r, a2i, b2r, b2i = e2
    return (a1r * a2r - a1i * a2i, a1r * a2i + a1i * a2r,
            a2r * b1r - a2i * b1i + b2r, a2r * b1i + a2i * b1r + b2i)


def complex_scan(ar, ai, br, bi, h0, reverse):
    car, cai, hr, hi = lax.associative_scan(_cplx_op, (ar, ai, br, bi), axis=1, reverse=reverse)
    if h0 is not None:
        h0r, h0i = h0[0][:, None], h0[1][:, None]
        hr = hr + car * h0r - cai * h0i
        hi = hi + car * h0i + cai * h0r
    return hr, hi


def block_diag_linear(x, w, b):
    xb = x.reshape(x.shape[:-1] + (LRU_HEADS, LRU_BW))
    return jnp.einsum('blnc,ncd->blnd', xb, w).reshape(x.shape) + b


def rglru_coeffs(u, w_a, b_a, w_x, b_x, lam):
    uf = u.astype(F32)
    r = jax.nn.sigmoid(block_diag_linear(uf, w_a.astype(F32), b_a.astype(F32)))
    i = jax.nn.sigmoid(block_diag_linear(uf, w_x.astype(F32), b_x.astype(F32)))
    log_a = -LRU_C * r * jax.nn.softplus(-lam.astype(F32))
    a = jnp.exp(log_a)
    b = jnp.sqrt(-jnp.expm1(2.0 * log_a)) * (i * uf)
    return a, b


def rglru_mixer(u_lat, g_lat, u_ctx, g_ctx, conv_w, conv_b, w_a, b_a, w_x, b_x, lam, need_ctx):
    c_lat = centred_dwconv(u_lat, conv_w, conv_b)
    c_ctx = centred_dwconv(u_ctx, conv_w, conv_b)
    y_lat, y_ctx = [], []
    for d, rev in enumerate((False, True)):
        a_c, b_c = rglru_coeffs(c_ctx, w_a[d], b_a[d], w_x[d], b_x[d], lam[d])
        h_c = linear_scan(a_c, b_c, None, rev)
        h_end = h_c[:, 0] if rev else h_c[:, -1]
        a_l, b_l = rglru_coeffs(c_lat, w_a[d], b_a[d], w_x[d], b_x[d], lam[d])
        y_lat.append(linear_scan(a_l, b_l, h_end, rev))
        y_ctx.append(h_c)
    out_lat = (y_lat[0] + y_lat[1]).astype(u_lat.dtype) * jax.nn.gelu(g_lat)
    out_ctx = (y_ctx[0] + y_ctx[1]).astype(u_ctx.dtype) * jax.nn.gelu(g_ctx) if need_ctx else None
    return out_lat, out_ctx


def s5_discretise(a_re, a_im, log_dt, b_re, b_im):
    a_re, a_im = a_re.astype(F32), a_im.astype(F32)
    dt = jnp.exp(log_dt.astype(F32))[:, None]
    mag = jnp.exp(a_re * dt)
    abar_r, abar_i = mag * jnp.cos(a_im * dt), mag * jnp.sin(a_im * dt)
    den = a_re * a_re + a_im * a_im
    nr = abar_r - 1.0
    coef_r = (nr * a_re + abar_i * a_im) / den
    coef_i = (abar_i * a_re - nr * a_im) / den
    br, bi = b_re.astype(F32), b_im.astype(F32)
    bbar_r = coef_r[..., None] * br - coef_i[..., None] * bi
    bbar_i = coef_r[..., None] * bi + coef_i[..., None] * br
    return abar_r, abar_i, bbar_r, bbar_i


def s5_scan(u, abar_r, abar_i, bbar_r, bbar_i, h0, reverse):
    bu_r = jnp.einsum('blgh,gph->blgp', u, bbar_r)
    bu_i = jnp.einsum('blgh,gph->blgp', u, bbar_i)
    ar = jnp.broadcast_to(abar_r, bu_r.shape)
    ai = jnp.broadcast_to(abar_i, bu_r.shape)
    return complex_scan(ar, ai, bu_r, bu_i, h0, reverse)


def s5_readout(hr, hi, c_re, c_im):
    return (jnp.einsum('blgp,ghp->blgh', hr, c_re.astype(F32))
            - jnp.einsum('blgp,ghp->blgh', hi, c_im.astype(F32)))


def s5_mixer(u_lat, u_ctx, a_re, a_im, log_dt, b_re, b_im, c_re, c_im, d_skip, w_glu, b_glu, need_ctx):
    def groups(u):
        return u.astype(F32).reshape(u.shape[0], u.shape[1], S5_G, S5_H)
    ul, uc = groups(u_lat), groups(u_ctx)
    dsk = d_skip.astype(F32).reshape(S5_G, S5_H)
    y_lat = ul * dsk
    y_ctx = uc * dsk
    for d, rev in enumerate((False, True)):
        ab_r, ab_i, bb_r, bb_i = s5_discretise(a_re[d], a_im[d], log_dt[d], b_re[d], b_im[d])
        hc_r, hc_i = s5_scan(uc, ab_r, ab_i, bb_r, bb_i, None, rev)
        end = 0 if rev else -1
        hl_r, hl_i = s5_scan(ul, ab_r, ab_i, bb_r, bb_i, (hc_r[:, end], hc_i[:, end]), rev)
        y_lat = y_lat + s5_readout(hl_r, hl_i, c_re[d], c_im[d])
        if need_ctx:
            y_ctx = y_ctx + s5_readout(hc_r, hc_i, c_re[d], c_im[d])

    def glu(y, dtype):
        z = jax.nn.gelu(y.reshape(y.shape[0], y.shape[1], D_S5)).astype(dtype)
        return z * jax.nn.sigmoid(z @ w_glu + b_glu)
    out_lat = glu(y_lat, u_lat.dtype)
    out_ctx = glu(y_ctx, u_ctx.dtype) if need_ctx else None
    return out_lat, out_ctx


def axial_rope(t):
    rows, cols = t.shape[2], t.shape[3]
    nf = NA_HD // 4
    half = NA_HD // 2
    inv = ROPE_BASE ** (-jnp.arange(nf, dtype=F32) / nf)
    ang_r = jnp.arange(rows, dtype=F32)[:, None, None] * inv
    ang_c = jnp.arange(cols, dtype=F32)[None, :, None] * inv

    def rot(u, ang):
        cos, sin = jnp.cos(ang).astype(u.dtype), jnp.sin(ang).astype(u.dtype)
        u1, u2 = u[..., :nf], u[..., nf:]
        return jnp.concatenate([u1 * cos - u2 * sin, u2 * cos + u1 * sin], axis=-1)
    return jnp.concatenate([rot(t[..., :half], ang_r), rot(t[..., half:], ang_c)], axis=-1)


def neighbourhood_attention(q_lat, k_lat, v_lat, q_ctx, k_ctx, v_ctx, rpb, need_ctx):
    b, n, _ = q_lat.shape
    rows = n // GRID_W
    kh = min(NA_KH, rows)
    ncb = GRID_W // NA_QB
    scale = NA_HD ** -0.5

    def heads(t):
        return t.reshape(b, t.shape[1], NA_HEADS, NA_HD).transpose(0, 2, 1, 3)
    qc, kc, vc = heads(q_ctx), heads(k_ctx), heads(v_ctx)

    def grid(t):
        return heads(t).reshape(b, NA_HEADS, rows, GRID_W, NA_HD)
    qg, kg, vg = grid(q_lat), grid(k_lat), grid(v_lat)
    qg_rot, kg_rot = axial_rope(qg), axial_rope(kg)

    blk_start = jnp.clip(jnp.arange(ncb) * NA_QB - NA_KW // 2, 0, GRID_W - NA_KWB)
    key_col = blk_start[:, None] + jnp.arange(NA_KWB)
    q_col = jnp.arange(GRID_W).reshape(ncb, NA_QB)
    win_start = jnp.clip(q_col - NA_KW // 2, 0, GRID_W - NA_KW)
    kc3 = key_col[:, None, :]
    col_ok = (kc3 >= win_start[..., None]) & (kc3 < win_start[..., None] + NA_KW)
    key_ok = jnp.broadcast_to(col_ok[:, :, None, :], (ncb, NA_QB, kh, NA_KWB)).reshape(ncb, NA_QB, kh * NA_KWB)
    dc = jnp.clip(kc3 - q_col[..., None] + NA_KW - 1, 0, 2 * NA_KW - 2)
    rpb_cols = rpb[:, :, dc]
    n_loc = kh * NA_KWB

    def row_block(args):
        r, q_rot_r, q_r = args
        rs = jnp.clip(r - kh // 2, 0, rows - kh)

        def gather(t):
            blk = lax.dynamic_slice_in_dim(t, rs, kh, axis=2)[:, :, :, key_col]
            return blk.transpose(0, 1, 3, 2, 4, 5).reshape(b, NA_HEADS, ncb, n_loc, NA_HD)
        k_blk, v_blk = gather(kg_rot), gather(vg)
        qr = q_rot_r.reshape(b, NA_HEADS, ncb, NA_QB, NA_HD)
        qp = q_r.reshape(b, NA_HEADS, ncb, NA_QB, NA_HD)
        dr = rs + jnp.arange(kh) - r + NA_KH - 1
        bias = jnp.take(rpb_cols, dr, axis=1).transpose(0, 2, 3, 1, 4).reshape(NA_HEADS, ncb, NA_QB, n_loc)
        s_loc = jnp.einsum('bhnqd,bhnkd->bhnqk', qr, k_blk).astype(F32) * scale + bias.astype(F32)
        s_loc = jnp.where(key_ok, s_loc, -jnp.inf)
        s_ctx = jnp.einsum('bhnqd,bhcd->bhnqc', qp, kc).astype(F32) * scale
        p = jax.nn.softmax(jnp.concatenate([s_loc, s_ctx], axis=-1), axis=-1).astype(v_blk.dtype)
        out = (jnp.einsum('bhnqk,bhnkd->bhnqd', p[..., :n_loc], v_blk)
               + jnp.einsum('bhnqc,bhcd->bhnqd', p[..., n_loc:], vc))
        return out.reshape(b, NA_HEADS, GRID_W, NA_HD)

    xs = (jnp.arange(rows), jnp.moveaxis(qg_rot, 2, 0), jnp.moveaxis(qg, 2, 0))
    out = lax.map(row_block, xs)
    out_lat = out.transpose(1, 0, 3, 2, 4).reshape(b, n, D_ATT)
    out_ctx = None
    if need_ctx:
        s = jnp.einsum('bhqd,bhkd->bhqk', qc, kc).astype(F32) * scale
        p = jax.nn.softmax(s, axis=-1).astype(vc.dtype)
        oc = jnp.einsum('bhqk,bhkd->bhqd', p, vc)
        out_ctx = oc.transpose(0, 2, 1, 3).reshape(b, q_ctx.shape[1], D_ATT)
    return out_lat, out_ctx


def moe_ffn(h, w_router, b_router, w_gu, b_gu, w_down, b_down):
    n, d = h.shape
    logits = h.astype(F32) @ w_router.astype(F32) + b_router.astype(F32)
    top_v, top_i = lax.top_k(logits, TOP_K)
    gates = jax.nn.softmax(top_v, axis=-1)
    n_assign = n * TOP_K
    e_flat = top_i.reshape(-1)
    tok_flat = jnp.arange(n_assign, dtype=jnp.int32) // TOP_K
    order = jnp.argsort(e_flat)
    e_s, tok_s, g_s = e_flat[order], tok_flat[order], gates.reshape(-1)[order]
    counts = jnp.zeros((N_EXPERTS,), jnp.int32).at[e_flat].add(1)
    padded = (counts + MOE_BLOCK - 1) // MOE_BLOCK * MOE_BLOCK
    start = jnp.cumsum(counts) - counts
    p_end = jnp.cumsum(padded)
    p_start = p_end - padded
    dest = p_start[e_s] + jnp.arange(n_assign, dtype=jnp.int32) - start[e_s]
    n_blocks = -(-n_assign // MOE_BLOCK) + N_EXPERTS
    cap = n_blocks * MOE_BLOCK
    tok_buf = jnp.zeros((cap,), jnp.int32).at[dest].set(tok_s)
    g_buf = jnp.zeros((cap,), F32).at[dest].set(g_s)
    blk_e = jnp.minimum(jnp.searchsorted(p_end, jnp.arange(n_blocks, dtype=jnp.int32) * MOE_BLOCK, side='right'),
                        N_EXPERTS - 1)

    def expert_block(args):
        tok, g, e = args
        xb = h[tok]
        gu = xb @ w_gu[e] + b_gu[e]
        glu = jnp.minimum(gu[:, :D_FF], SWIGLU_LIMIT)
        lin = jnp.clip(gu[:, D_FF:], -SWIGLU_LIMIT, SWIGLU_LIMIT)
        act = glu * jax.nn.sigmoid(SWIGLU_ALPHA * glu) * (lin + 1.0)
        return (act @ w_down[e] + b_down[e]) * g[:, None].astype(h.dtype)

    y_buf = lax.map(expert_block, (tok_buf.reshape(n_blocks, MOE_BLOCK), g_buf.reshape(n_blocks, MOE_BLOCK), blk_e))
    return jnp.zeros_like(h).at[tok_buf].add(y_buf.reshape(cap, d))


def setup_inputs(seed: int = 0) -> dict:
    key = jax.random.key(seed)
    ks = iter(jax.random.split(key, 40))

    def nrm(shape, s):
        return jax.random.normal(next(ks), shape, F32) * s
    L = DEPTH
    a_c = jax.random.uniform(next(ks), (L, 2, D_LRU), F32, minval=0.9, maxval=0.999)
    a0 = a_c ** (1.0 / LRU_C)
    return {
        'x': nrm((BATCH, SEQ, D_MODEL), 1.0),
        'c': nrm((BATCH, D_MODEL), 1.0),
        'ctx': nrm((BATCH, CTX_LEN, D_MODEL), 1.0),
        'c_ctx': nrm((D_MODEL,), 1.0),
        'w_mod': nrm((L, D_MODEL, N_MOD * D_MODEL), 0.5 * D_MODEL ** -0.5),
        'b_mod': nrm((L, N_MOD * D_MODEL), 0.01),
        'norm_g': 1.0 + nrm((L, 4, D_MODEL), 0.05),
        'w_in': nrm((L, D_MODEL, D_IN), D_MODEL ** -0.5),
        'w_out': nrm((L, D_MIX, D_MODEL), D_MIX ** -0.5),
        'lru_conv_w': nrm((L, CONV_W, D_LRU), CONV_W ** -0.5),
        'lru_conv_b': nrm((L, D_LRU), 0.01),
        'lru_w_a': nrm((L, 2, LRU_HEADS, LRU_BW, LRU_BW), LRU_BW ** -0.5),
        'lru_b_a': nrm((L, 2, D_LRU), 0.01),
        'lru_w_x': nrm((L, 2, LRU_HEADS, LRU_BW, LRU_BW), LRU_BW ** -0.5),
        'lru_b_x': nrm((L, 2, D_LRU), 0.01),
        'lru_lambda': jnp.log(a0) - jnp.log1p(-a0),
        's5_a_re': -0.5 + nrm((L, 2, S5_G, S5_P), 0.01),
        's5_a_im': jnp.pi * jnp.arange(S5_P, dtype=F32) + nrm((L, 2, S5_G, S5_P), 0.01),
        's5_log_dt': jax.random.uniform(next(ks), (L, 2, S5_G), F32, minval=float(np.log(1e-3)), maxval=float(np.log(1e-1))),
        's5_b_re': nrm((L, 2, S5_G, S5_P, S5_H), (2.0 * S5_H) ** -0.5),
        's5_b_im': nrm((L, 2, S5_G, S5_P, S5_H), (2.0 * S5_H) ** -0.5),
        's5_c_re': nrm((L, 2, S5_G, S5_H, S5_P), (2.0 * S5_P) ** -0.5),
        's5_c_im': nrm((L, 2, S5_G, S5_H, S5_P), (2.0 * S5_P) ** -0.5),
        's5_d': nrm((L, D_S5), 1.0),
        's5_w_glu': nrm((L, D_S5, D_S5), D_S5 ** -0.5),
        's5_b_glu': nrm((L, D_S5), 0.01),
        'na_rpb': nrm((L, NA_HEADS, 2 * NA_KH - 1, 2 * NA_KW - 1), 0.1),
        'moe_w_router': nrm((L, D_MODEL, N_EXPERTS), D_MODEL ** -0.5),
        'moe_b_router': nrm((L, N_EXPERTS), 0.01),
        'moe_w_gu': nrm((L, N_EXPERTS, D_MODEL, 2 * D_FF), D_MODEL ** -0.5),
        'moe_b_gu': nrm((L, N_EXPERTS, 2 * D_FF), 0.01),
        'moe_w_down': nrm((L, N_EXPERTS, D_FF, D_MODEL), D_FF ** -0.5),
        'moe_b_down': nrm((L, N_EXPERTS, D_MODEL), 0.01),
    }


def reference(x, c, ctx, c_ctx, w_mod, b_mod, norm_g, w_in, w_out, lru_conv_w, lru_conv_b, lru_w_a, lru_b_a,
              lru_w_x, lru_b_x, lru_lambda, s5_a_re, s5_a_im, s5_log_dt, s5_b_re, s5_b_im, s5_c_re, s5_c_im,
              s5_d, s5_w_glu, s5_b_glu, na_rpb, moe_w_router, moe_b_router, moe_w_gu, moe_b_gu, moe_w_down,
              moe_b_down):
    b = x.shape[0]
    xc = ctx
    silu_c = jax.nn.silu(c)
    silu_cc = jax.nn.silu(c_ctx)
    split_at = [D_LRU, 2 * D_LRU, 2 * D_LRU + D_S5, 2 * D_LRU + D_S5 + D_ATT, 2 * D_LRU + D_S5 + 2 * D_ATT]
    for l in range(DEPTH):
        need_ctx = l < DEPTH - 1
        mod_lat = (silu_c @ w_mod[l] + b_mod[l]).reshape(b, N_MOD, 1, D_MODEL)
        mod_ctx = (silu_cc @ w_mod[l] + b_mod[l]).reshape(N_MOD, 1, D_MODEL)
        g = norm_g[l]
        h_lat = modulate(x, g[0], mod_lat[:, 0], mod_lat[:, 1])
        h_ctx = modulate(xc, g[0], mod_ctx[0], mod_ctx[1])
        lu_l, lg_l, su_l, q_l, k_l, v_l = jnp.split(h_lat @ w_in[l], split_at, axis=-1)
        lu_c, lg_c, su_c, q_c, k_c, v_c = jnp.split(h_ctx @ w_in[l], split_at, axis=-1)
        y_lru_l, y_lru_c = rglru_mixer(lu_l, lg_l, lu_c, lg_c, lru_conv_w[l], lru_conv_b[l], lru_w_a[l],
                                       lru_b_a[l], lru_w_x[l], lru_b_x[l], lru_lambda[l], need_ctx)
        y_s5_l, y_s5_c = s5_mixer(su_l, su_c, s5_a_re[l], s5_a_im[l], s5_log_dt[l], s5_b_re[l], s5_b_im[l],
                                  s5_c_re[l], s5_c_im[l], s5_d[l], s5_w_glu[l], s5_b_glu[l], need_ctx)
        y_na_l, y_na_c = neighbourhood_attention(q_l, k_l, v_l, q_c, k_c, v_c, na_rpb[l], need_ctx)
        mix_l = jnp.concatenate([y_lru_l, y_s5_l, y_na_l], axis=-1) @ w_out[l]
        x = x + mod_lat[:, 2] * rmsnorm(mix_l, g[1])
        if need_ctx:
            mix_c = jnp.concatenate([y_lru_c, y_s5_c, y_na_c], axis=-1) @ w_out[l]
            xc = xc + mod_ctx[2] * rmsnorm(mix_c, g[1])
        f_lat = modulate(x, g[2], mod_lat[:, 3], mod_lat[:, 4]).reshape(-1, D_MODEL)
        n_lat = f_lat.shape[0]
        if need_ctx:
            f_ctx = modulate(xc, g[2], mod_ctx[3], mod_ctx[4]).reshape(-1, D_MODEL)
            tokens = jnp.concatenate([f_lat, f_ctx], axis=0)
        else:
            tokens = f_lat
        y = moe_ffn(tokens, moe_w_router[l], moe_b_router[l], moe_w_gu[l], moe_b_gu[l], moe_w_down[l], moe_b_down[l])
        x = x + mod_lat[:, 5] * rmsnorm(y[:n_lat].reshape(x.shape), g[3])
        if need_ctx:
            xc = xc + mod_ctx[5] * rmsnorm(y[n_lat:].reshape(xc.shape), g[3])
    return x
```

```cpp
#include <hip/hip_runtime.h>
#include <hip/hip_cooperative_groups.h>
#include <cstdio>
#include <cstdint>
namespace cg = cooperative_groups;

#ifndef MK_PER_PHASE_LAUNCH
#define MK_PER_PHASE_LAUNCH 0
#endif

#define DEV __device__ __forceinline__
#define LAS __attribute__((address_space(3)))
typedef unsigned short bf16_t;
typedef short bf16x8 __attribute__((ext_vector_type(8)));
typedef short s16x4 __attribute__((ext_vector_type(4)));
typedef float f32x4 __attribute__((ext_vector_type(4)));
typedef float f32x2 __attribute__((ext_vector_type(2)));
typedef unsigned u32x4 __attribute__((ext_vector_type(4)));
typedef unsigned u32x2 __attribute__((ext_vector_type(2)));

constexpr int D = 1024, SEQ = 16384, NLAT = 32768, CTXL = 256, NCTX = 512, NTOK = 33280;
constexpr int LD7 = 1792, COL_LU = 0, COL_LG = 256, COL_Q = 768, COL_K = 1280;
constexpr int NCHK = 2080, NCHKP = 2304;
constexpr int LCH = 520;
constexpr int NE = 32, NBMAX = 552, CAPROWS = NBMAX * 256;
constexpr float EPS = 1e-6f;
constexpr int NTHREADS = 512, NWAVES = 8;

constexpr size_t MiB = 1u << 20;
constexpr size_t al1(size_t x) { return (x + MiB - 1) & ~(MiB - 1); }
constexpr size_t WS_CTL = 0, CTL_BYTES = 64 * 1024;
constexpr size_t WS_MOD = 1 * MiB;
constexpr size_t WS_ROPE = WS_MOD + 256 * 1024;
constexpr size_t WS_LAM16 = WS_ROPE + 64 * 1024;
constexpr size_t WS_WRT = WS_LAM16 + 64 * 1024;
constexpr size_t WS_WLRU = WS_WRT + 128 * 1024;
constexpr size_t WS_WGLU = WS_WLRU + 256 * 1024;
constexpr size_t WS_S5B1 = 2 * MiB;
constexpr size_t WS_S5B2 = WS_S5B1 + 4 * MiB;
constexpr size_t WS_WIN = WS_S5B2 + 8 * MiB;
constexpr size_t WS_WOUT = WS_WIN + 9 * MiB;
constexpr size_t WS_WGU = WS_WOUT + 4 * MiB;
constexpr size_t WS_WDN = WS_WGU + 256 * MiB;
constexpr size_t WS_XS = WS_WDN + 128 * MiB;
constexpr size_t WS_H = WS_XS + al1((size_t)NTOK * D * 4);
constexpr size_t WS_IN7 = WS_H + al1((size_t)NTOK * D * 2);
constexpr size_t WS_VT = WS_IN7 + al1((size_t)NTOK * LD7 * 2);
constexpr size_t WS_AX = WS_VT + al1((size_t)512 * NTOK * 2);
constexpr size_t WS_SL = WS_AX + al1((size_t)16 * NCHKP * 512 * 2);
constexpr size_t WS_Z = WS_SL + al1((size_t)16 * NCHKP * 256 * 4);
constexpr size_t WS_MIX = WS_Z + al1((size_t)NTOK * 256 * 2);
constexpr size_t WS_MIXO = WS_MIX + al1((size_t)NTOK * D * 2);
constexpr size_t WS_LAGG = WS_MIXO + al1((size_t)NTOK * D * 2);
constexpr size_t WS_LCIN = WS_LAGG + al1((size_t)2 * LCH * 256 * 8);
constexpr size_t WS_LTOK = WS_LCIN + al1((size_t)2 * LCH * 256 * 4);
constexpr size_t WS_INV = WS_LTOK + al1((size_t)NE * NTOK * 4);
constexpr size_t WS_GATE = WS_INV + al1((size_t)NTOK * 16);
constexpr size_t WS_ACT = WS_GATE + al1((size_t)NTOK * 16);
constexpr size_t WS_YB = WS_ACT + al1((size_t)CAPROWS * D * 2);
constexpr size_t WS_END = WS_YB + al1((size_t)CAPROWS * D * 2);
constexpr int CW_CNT = 0;
constexpr int CW_WQ = 256;
constexpr int CW_BAR = 12288;

constexpr int LDS_STAGE = 131072, LDS_MISC = LDS_STAGE, LDS_BYTES = 163840, LDS_XST = 163776;

struct Params { const float* in[33]; float* out; unsigned char* ws; int ph_lo, ph_hi; };
#define GAS __attribute__((address_space(1)))
#define PIN(k) ((const float*)(const GAS float*)P.in[k])
#define POUT ((float*)(GAS float*)P.out)
typedef __attribute__((address_space(4))) const Params KParams;

DEV int rfl(int v) { return __builtin_amdgcn_readfirstlane(v); }
DEV int lane_fresh() { int t; asm volatile("v_mbcnt_lo_u32_b32 %0, -1, 0\n\tv_mbcnt_hi_u32_b32 %0, -1, %0" : "=v"(t)); return t; }
DEV float bf2f(unsigned v) { return __uint_as_float(v << 16); }
DEV unsigned cvt_pk_bf16(float lo, float hi) { unsigned r; asm("v_cvt_pk_bf16_f32 %0, %1, %2" : "=v"(r) : "v"(lo), "v"(hi)); return r; }
DEV float blo(unsigned w) { return __uint_as_float(w << 16); }
DEV float bhi(unsigned w) { return __uint_as_float(w & 0xffff0000u); }
DEV float wave_sum(float v) {
#pragma unroll
    for (int o = 1; o < 64; o <<= 1) v += __shfl_xor(v, o);
    return v;
}
DEV float sigmoidf_(float x) { return __builtin_amdgcn_rcpf(1.0f + __expf(-x)); }
DEV float gelu_tanh(float x) { const float u = 1.5957691216057308f * (x + 0.044715f * x * x * x); return x * __builtin_amdgcn_rcpf(1.0f + __expf(-u)); }
DEV float silu_(float x) { return x * __builtin_amdgcn_rcpf(1.0f + __expf(-x)); }
DEV void sincos_red(float ang, float& c, float& s) {
    const float k = rintf(ang * 0.15915494309189535f);
    float r = fmaf(-k, 6.2831854820251465f, ang);
    r = fmaf(-k, -1.7484555e-7f, r);
    c = __cosf(r); s = __sinf(r);
}
#define LDS_WAIT() asm volatile("s_waitcnt lgkmcnt(0)" ::: "memory")

namespace g8 {
constexpr int BM = 256, BK = 64, HALF = 128, HTB = HALF * BK * 2;
DEV void stage_rc(int b, int& R, int& C) { const int st = b / 1024, sb = b % 1024, swz = sb ^ (((sb >> 9) & 1) << 5); R = (st >> 1) * 16 + swz / 64; C = (st & 1) * 32 + (swz % 64) / 2; }
DEV int lds_byte(int r, int c) { const int st = (r >> 4) * 2 + (c >> 5), rr = r & 15, cc = c & 31, ob = rr * 64 + cc * 2; return st * 1024 + (ob ^ (((ob >> 9) & 1) << 5)); }
DEV int f8_swz(int r) { return ((r >> 1) & 1) | (((r >> 3) & 1) << 2); }
DEV void stage_rc_f8(int b, int& R, int& C) { R = b >> 7; C = (((b >> 4) & 7) ^ f8_swz(R & 15)) * 8; }
DEV int lds_byte_f8(int r, int piece) { return r * 128 + ((piece ^ f8_swz(r & 15)) << 4); }
DEV int perm32(int rho) { const int n = rho >> 4, i = rho & 15; return 8 * (i >> 2) + 4 * n + (i & 3); }

struct Unit { int pm, pn, e, x; };
typedef int v8i __attribute__((ext_vector_type(8)));
DEV v8i cat8(const bf16x8& a, const bf16x8& b) { typedef int v4i __attribute__((ext_vector_type(4))); const v4i x = __builtin_bit_cast(v4i, a), y = __builtin_bit_cast(v4i, b); return __builtin_shufflevector(x, y, 0, 1, 2, 3, 4, 5, 6, 7); }

template <class T, class = void> struct PreOf { static constexpr bool v = false; static constexpr int nst = 0; };
template <class T> struct PreOf<T, decltype((void)T::NST)> { static constexpr bool v = true; static constexpr int nst = T::NST; };
constexpr int PRE_LTOK = 12288, PRE_BIAS = 13312;
template <class T>
DEV void gemm_phase(LAS unsigned char* lds, const T& tr, int tid) {
    const int wid = rfl(tid >> 6), lane = tid & 63, wr = wid >> 2, wc = wid & 3, fr = lane & 15, fq = lane >> 4;
    constexpr int K = T::K, nt = K / BK;
    unsigned voffB[2];
#pragma unroll
    for (int i = 0; i < 2; ++i) { int R_, C_; if constexpr (T::FP8) stage_rc_f8(tid * 16 + i * 8192, R_, C_); else stage_rc(tid * 16 + i * 8192, R_, C_); const int Rb = (R_ & ~31) + perm32(R_ & 31); voffB[i] = (unsigned)(Rb * K + C_) * 2u; }
    const size_t hstepB = (size_t)HALF * K * 2;
    const unsigned ldsw = (unsigned)wid * 1024u;
    constexpr bool F8 = T::FP8; constexpr int KOFF = F8 ? 16 : 1024;
    const int aoff = F8 ? lds_byte_f8(wr * 64 + fr, 2 * fq) : lds_byte(wr * 64 + fr, fq * 8), boff = F8 ? lds_byte_f8(wc * 32 + fr, 2 * fq) : lds_byte(wc * 32 + fr, fq * 8);
    const int aoff1 = aoff ^ 16, boff1 = boff ^ 16;
#define G8_SA(b, h) (((b) * 2 + (h)) * HTB)
#define G8_SB(b, h) ((4 + (b) * 2 + (h)) * HTB)
#define G8_STAGE(bufoff, gbase, voff) do { _Pragma("unroll") for (int _i = 0; _i < 2; ++_i) \
        __builtin_amdgcn_global_load_lds((const unsigned*)((const char*)(gbase) + (voff)[_i]), (LAS unsigned*)(lds + (bufoff) + ldsw + _i * 8192), 16, 0, 0); } while (0)
#define G8_LDA(dst, b, h) do { if constexpr (F8) { _Pragma("unroll") for (int m = 0; m < 4; ++m) { dst##8[m].lo = *(const LAS v4i*)(lds + G8_SA(b, h) + aoff + m * 2048); dst##8[m].hi = *(const LAS v4i*)(lds + G8_SA(b, h) + aoff1 + m * 2048); } } \
        else { _Pragma("unroll") for (int m = 0; m < 4; ++m) _Pragma("unroll") for (int k = 0; k < 2; ++k) dst[m][k] = *(const LAS bf16x8*)(lds + G8_SA(b, h) + aoff + m * 2048 + k * KOFF); } } while (0)
#define G8_LDB(dst, b, h) do { if constexpr (F8) { _Pragma("unroll") for (int n = 0; n < 2; ++n) { dst##8[n].lo = *(const LAS v4i*)(lds + G8_SB(b, h) + boff + n * 2048); dst##8[n].hi = *(const LAS v4i*)(lds + G8_SB(b, h) + boff1 + n * 2048); } } \
        else { _Pragma("unroll") for (int n = 0; n < 2; ++n) _Pragma("unroll") for (int k = 0; k < 2; ++k) dst[n][k] = *(const LAS bf16x8*)(lds + G8_SB(b, h) + boff + n * 2048 + k * KOFF); } } while (0)
#define G8_MMA(ai, bj, At, Bt) do { __builtin_amdgcn_s_setprio(1); _Pragma("unroll") for (int m = 0; m < 4; ++m) _Pragma("unroll") for (int n = 0; n < 2; ++n) { \
        if constexpr (F8) asm volatile("v_mfma_scale_f32_16x16x128_f8f6f4 %0, %1, %2, %0, %3, %3 op_sel_hi:[0,0,0]" : "+v"(acc[ai][bj][m][n]) : "v"(Bt##8[n]), "v"(At##8[m]), "v"(sc1)); \
        else { _Pragma("unroll") for (int k = 0; k < 2; ++k) acc[ai][bj][m][n] = __builtin_amdgcn_mfma_f32_16x16x32_bf16(Bt[n][k], At[m][k], acc[ai][bj][m][n], 0, 0, 0); } } __builtin_amdgcn_s_setprio(0); } while (0)
#define G8_WAIT_V(n) asm volatile("s_waitcnt vmcnt(" #n ")" ::: "memory")
#define G8_WAIT_L(n) asm volatile("s_waitcnt lgkmcnt(" #n ")" ::: "memory")
#define G8_BAR __builtin_amdgcn_s_barrier()
#define G8_SCHED __builtin_amdgcn_sched_barrier(0)
    Unit cur, nxt; int ui = 0;
    if (!tr.unit(0, cur)) return;
    f32x4 acc[2][2][4][2];
#pragma unroll
    for (int a = 0; a < 2; ++a)
#pragma unroll
        for (int b = 0; b < 2; ++b)
#pragma unroll
            for (int m = 0; m < 4; ++m)
#pragma unroll
                for (int n = 0; n < 2; ++n) acc[a][b][m][n] = (f32x4){0.f, 0.f, 0.f, 0.f};
    typedef int v4i __attribute__((ext_vector_type(4)));
    const int sc1 = 0x7f7f7f7f;
    bf16x8 At[F8 ? 1 : 4][2], B0[F8 ? 1 : 2][2], B1[F8 ? 1 : 2][2];
    v8i At8[F8 ? 4 : 1], B08[F8 ? 2 : 1], B18[F8 ? 2 : 1];
    unsigned ca0[2], ca1[2];
    constexpr bool PRE = PreOf<T>::v; constexpr int NST = PreOf<T>::nst;
#define G8_PRE(u, par) do { if constexpr (PRE) __builtin_amdgcn_global_load_lds(tr.pre_src(u, wid, lane), (LAS unsigned*)(lds + LDS_MISC + tr.pre_dst(wid, par)), 4, 0, 0); } while (0)
#define G8_WAIT_VN(n) asm volatile("s_waitcnt vmcnt(%0)" :: "n"(n) : "memory")
    { int tl_ = tid; asm volatile("" : "+v"(tl_)); int Rr[2], Cc[2]; if constexpr (T::FP8) { stage_rc_f8(tl_ * 16, Rr[0], Cc[0]); stage_rc_f8(tl_ * 16 + 8192, Rr[1], Cc[1]); } else { stage_rc(tl_ * 16, Rr[0], Cc[0]); stage_rc(tl_ * 16 + 8192, Rr[1], Cc[1]); } tr.aoffs(cur, Rr, Cc, ca0, ca1); }
    const char* cAb = tr.abase(cur); const char* cB = tr.bptr(cur);
    G8_PRE(cur, 0);
    G8_STAGE(G8_SB(0, 0), cB, voffB); G8_STAGE(G8_SB(0, 1), cB + hstepB, voffB); G8_STAGE(G8_SA(0, 0), cAb, ca0); G8_STAGE(G8_SA(0, 1), cAb, ca1);
    if (wr == 1) G8_BAR;
    G8_WAIT_V(2); G8_BAR;
    G8_STAGE(G8_SB(1, 0), cB + 128, voffB); G8_STAGE(G8_SA(1, 0), cAb + 128, ca0); G8_STAGE(G8_SB(1, 1), cB + hstepB + 128, voffB);
    G8_WAIT_V(6); G8_BAR;
    for (;;) {
        const bool has_next = tr.unit(ui + 1, nxt);
        const char* nAb = cAb; const char* nB = cB;
        if constexpr (PRE) { if (has_next) { nAb = tr.abase(nxt); nB = tr.bptr(nxt); G8_PRE(nxt, (ui + 1) & 1); } else G8_PRE(cur, (ui + 1) & 1); }
        else {
            unsigned na0[2], na1[2];
            if (has_next) { int tl_ = tid; asm volatile("" : "+v"(tl_)); int Rr[2], Cc[2]; if constexpr (T::FP8) { stage_rc_f8(tl_ * 16, Rr[0], Cc[0]); stage_rc_f8(tl_ * 16 + 8192, Rr[1], Cc[1]); } else { stage_rc(tl_ * 16, Rr[0], Cc[0]); stage_rc(tl_ * 16 + 8192, Rr[1], Cc[1]); } tr.aoffs(nxt, Rr, Cc, na0, na1); nAb = tr.abase(nxt); nB = tr.bptr(nxt); }
            else { na0[0] = ca0[0]; na0[1] = ca0[1]; na1[0] = ca1[0]; na1[1] = ca1[1]; }
            *(LAS u32x4*)(lds + LDS_MISC + 4096 + tid * 16) = (u32x4){na0[0], na0[1], na1[0], na1[1]};
        }
#pragma unroll 1
        for (int t = 0; t < nt; t += 2) {
            const bool last = (t == nt - 2);
            const bool relax = PRE && t == 0;
            const char* a1 = cAb + (size_t)(t + 1) * 128;
            const char* a2 = last ? nAb : cAb + (size_t)(t + 2) * 128; const char* b2 = last ? nB : cB + (size_t)(t + 2) * 128;
            const char* a3 = a2 + 128; const char* b3 = b2 + 128;
            G8_LDB(B0, 0, 0); G8_LDB(B1, 0, 1); G8_SCHED; G8_LDA(At, 0, 0); G8_STAGE(G8_SA(1, 1), a1, ca1);
            if (last) {
                if constexpr (PRE) { if (has_next) { int tl_ = tid; asm volatile("" : "+v"(tl_)); int Rr[2], Cc[2]; stage_rc_f8(tl_ * 16, Rr[0], Cc[0]); stage_rc_f8(tl_ * 16 + 8192, Rr[1], Cc[1]); tr.aoffs_lds(nxt, Rr, Cc, ca0, ca1, lds + LDS_MISC + PRE_LTOK); } }
                else { const u32x4 nx = *(const LAS u32x4*)(lds + LDS_MISC + 4096 + tid * 16); ca0[0] = nx.x; ca0[1] = nx.y; ca1[0] = nx.z; ca1[1] = nx.w; } }
            if (relax) { if (ui > 0) G8_WAIT_VN(9 + NST); else G8_WAIT_VN(9); } else G8_WAIT_V(8);
            G8_WAIT_L(0); G8_BAR; G8_MMA(0, 0, At, B0); G8_MMA(0, 1, At, B1); G8_BAR; G8_SCHED;
            G8_LDA(At, 0, 1); G8_STAGE(G8_SB(0, 0), b2, voffB); G8_STAGE(G8_SB(0, 1), b2 + hstepB, voffB); G8_STAGE(G8_SA(0, 0), a2, ca0);
            if (relax) { if (ui > 0) G8_WAIT_VN(9 + NST); else G8_WAIT_VN(9); } else G8_WAIT_V(8);
            G8_WAIT_L(0); G8_BAR; G8_MMA(1, 0, At, B0); G8_MMA(1, 1, At, B1); G8_BAR; G8_SCHED;
            G8_LDB(B0, 1, 0); G8_LDB(B1, 1, 1); G8_SCHED; G8_LDA(At, 1, 0); G8_STAGE(G8_SA(0, 1), a2, ca1);
            G8_WAIT_V(8); G8_WAIT_L(0); G8_BAR; G8_MMA(0, 0, At, B0); G8_MMA(0, 1, At, B1); G8_BAR; G8_SCHED;
            G8_LDA(At, 1, 1); G8_STAGE(G8_SB(1, 0), b3, voffB); G8_STAGE(G8_SB(1, 1), b3 + hstepB, voffB); G8_STAGE(G8_SA(1, 0), a3, ca0);
            G8_WAIT_V(8); G8_WAIT_L(0); G8_BAR; G8_MMA(1, 0, At, B0); G8_MMA(1, 1, At, B1); G8_BAR; G8_SCHED;
        }
        if (wr == 0) G8_BAR;
        if constexpr (F8) asm volatile("s_nop 15\n\ts_nop 15" ::: "memory");
        if constexpr (PRE) tr.epi(acc, cur, wr, wc, fr, fq, (const LAS float*)(lds + LDS_MISC + PRE_BIAS + (ui & 1) * 1024)); else tr.epi(acc, cur, wr, wc, fr, fq);
        if (!has_next) break;
#pragma unroll
        for (int a = 0; a < 2; ++a)
#pragma unroll
            for (int b = 0; b < 2; ++b)
#pragma unroll
                for (int m = 0; m < 4; ++m)
#pragma unroll
                    for (int n = 0; n < 2; ++n) acc[a][b][m][n] = (f32x4){0.f, 0.f, 0.f, 0.f};
        cur = nxt; cAb = nAb; cB = nB; ++ui;
        if (wr == 1) G8_BAR;
    }
    G8_WAIT_V(0);
    G8_BAR;
#undef G8_PRE
#undef G8_WAIT_VN
#undef G8_SA
#undef G8_SB
#undef G8_STAGE
#undef G8_LDA
#undef G8_LDB
#undef G8_MMA
#undef G8_WAIT_V
#undef G8_WAIT_L
#undef G8_BAR
#undef G8_SCHED
}

DEV bool dense_unit(int L, int nM, int nN, int& pm, int& pn) {
    const int nwg = nM * nN; if (L >= nwg) return false;
    int wgid = L; { const int q = nwg / 8, r = nwg % 8, xcd = wgid % 8, off = wgid / 8; wgid = (xcd < r ? xcd * (q + 1) : r * (q + 1) + (xcd - r) * q) + off; }
    const int nig = 8 * nN, gid = wgid / nig, fm = gid * 8, gsz = (nM - fm) < 8 ? (nM - fm) : 8;
    pm = fm + ((wgid % nig) % gsz); pn = (wgid % nig) / gsz; return true;
}
DEV void dense_aoffs(int pm, int lda, const int (&R)[2], const int (&C)[2], unsigned (&a0)[2], unsigned (&a1)[2]) {
#pragma unroll
    for (int i = 0; i < 2; ++i) { a0[i] = (unsigned)((pm * 256 + R[i]) * lda + C[i]) * 2u; a1[i] = (unsigned)((pm * 256 + 128 + R[i]) * lda + C[i]) * 2u; }
}
DEV unsigned pk_fp8x4(float a, float b, float c, float d) {
    a = fminf(fmaxf(a, -448.f), 448.f); b = fminf(fmaxf(b, -448.f), 448.f); c = fminf(fmaxf(c, -448.f), 448.f); d = fminf(fmaxf(d, -448.f), 448.f);
    unsigned w = 0; w = __builtin_amdgcn_cvt_pk_fp8_f32(a, b, w, false); w = __builtin_amdgcn_cvt_pk_fp8_f32(c, d, w, true); return w; }
DEV unsigned pk_fp8x4_nc(float a, float b, float c, float d) { unsigned w = 0; w = __builtin_amdgcn_cvt_pk_fp8_f32(a, b, w, false); w = __builtin_amdgcn_cvt_pk_fp8_f32(c, d, w, true); return w; }
DEV u32x4 pack8(const f32x4& v0, const f32x4& v1) { u32x4 w; w.x = cvt_pk_bf16(v0[0], v0[1]); w.y = cvt_pk_bf16(v0[2], v0[3]); w.z = cvt_pk_bf16(v1[0], v1[1]); w.w = cvt_pk_bf16(v1[2], v1[3]); return w; }

struct JobInProj {
    static constexpr int K = 1024; static constexpr bool FP8 = false;
    const bf16_t* H; const bf16_t* Win; bf16_t* IN7; bf16_t* AX; bf16_t* VT; const LAS unsigned* TC; const LAS unsigned* TR; int G, c;
    int lo = 0, hi = 1170;
    DEV bool unit(int i, Unit& u) const {
        const int L = lo + i * G + c;
        if (L >= hi) return false;
        if (L < 910) { u.x = 0; return dense_unit(L, 130, 7, u.pm, u.pn); }
        u.x = 1; return dense_unit(L - 910, 2, 130, u.pm, u.pn);
    }
    DEV void aoffs(const Unit& u, const int (&R)[2], const int (&C)[2], unsigned (&a0)[2], unsigned (&a1)[2]) const { dense_aoffs(u.pm, 1024, R, C, a0, a1); }
    DEV const char* abase(const Unit& u) const { return u.x ? (const char*)(Win + (size_t)1792 * 1024) : (const char*)H; }
    DEV const char* bptr(const Unit& u) const { return u.x ? (const char*)(H + (size_t)u.pn * 256 * 1024) : (const char*)(Win + (size_t)u.pn * 256 * 1024); }
    DEV void epi(const f32x4 (&acc)[2][2][4][2], const Unit& u, int wr, int wc, int fr, int fq) const {
        const bool isq = !u.x && (u.pn == 3 || u.pn == 4);
        const bool rope = !u.x && u.pn >= 3 && u.pm < 128;
#pragma unroll
        for (int ai = 0; ai < 2; ++ai)
#pragma unroll
            for (int m = 0; m < 4; ++m) {
                const int row = u.pm * 256 + ai * 128 + wr * 64 + m * 16 + fr;
                u32x4 csp[2];
                if (rope) { const int tl = row & (SEQ - 1); const LAS unsigned* t = ((wc & 1) ? TC + (tl & 63) * 16 : TR + (tl >> 6) * 16) + 8 * (fq & 1);
                    csp[0] = *(const LAS u32x4*)t; csp[1] = *(const LAS u32x4*)(t + 4); }
#pragma unroll
                for (int bj = 0; bj < 2; ++bj) {
                    const int cl = bj * 128 + wc * 32 + 8 * fq;
                    f32x4 v0 = acc[ai][bj][m][0], v1 = acc[ai][bj][m][1];
                    unsigned char* qdst = (unsigned char*)(IN7 + (size_t)row * LD7 + COL_Q + (u.pn - 3) * 256 + bj * 128 + (wc >> 1) * 64) + fq * 32 + (wc & 1) * 8;
                    if (isq) { u32x2 w8; w8.x = pk_fp8x4(v0[0], v0[1], v0[2], v0[3]); w8.y = pk_fp8x4(v1[0], v1[1], v1[2], v1[3]); *(u32x2*)qdst = w8; }
                    if (rope) {
#pragma unroll
                        for (int n = 0; n < 2; ++n) { f32x4& v = n ? v1 : v0; const u32x4 cp = csp[n]; const unsigned cw[4] = {cp.x, cp.y, cp.z, cp.w}; float c[4], s[4];
#pragma unroll
                            for (int j = 0; j < 4; ++j) { c[j] = (float)__builtin_bit_cast(_Float16, (unsigned short)(cw[j] & 0xffffu)); s[j] = (float)__builtin_bit_cast(_Float16, (unsigned short)(cw[j] >> 16)); }
#pragma unroll
                            for (int j = 0; j < 4; ++j) { const float pv = __shfl_xor(v[j], 32); v[j] = fq < 2 ? v[j] * c[j] - pv * s[j] : v[j] * c[j] + pv * s[j]; } } }
                    if (isq) { if (rope) { u32x2 w8; w8.x = pk_fp8x4(v0[0], v0[1], v0[2], v0[3]); w8.y = pk_fp8x4(v1[0], v1[1], v1[2], v1[3]); *(u32x2*)(qdst + 16) = w8; } continue; }
                    const u32x4 w = pack8(v0, v1);
                    bf16_t* dst;
                    if (u.x) dst = VT + ((size_t)((u.pn * 256 + cl) >> 3) * 512 + row) * 8;
                    else if (u.pn == 2) dst = AX + ((size_t)((cl >> 4) * NCHKP + (row >> 4)) * 512 + (row & 15) * 16 + (cl & 15));
                    else dst = IN7 + (size_t)row * LD7 + (u.pn < 2 ? u.pn * 256 : 768 + (u.pn - 3) * 256) + cl;
                    *(u32x4*)dst = w;
                }
            }
    }
};
template <int KK> struct JobS5 {
    static constexpr int K = KK; static constexpr bool FP8 = false;
    const bf16_t* AX; const bf16_t* Bt; float* SL; bf16_t* Z; int G, c;
    DEV bool unit(int i, Unit& u) const { const int L = i * G + c; if (L >= 144) return false; u.e = L / 9; u.pm = L % 9; u.pn = 0; u.x = 0; return true; }
    DEV void aoffs(const Unit& u, const int (&R)[2], const int (&C)[2], unsigned (&a0)[2], unsigned (&a1)[2]) const { dense_aoffs(u.pm, 512, R, C, a0, a1); }
    DEV const char* abase(const Unit& u) const { return (const char*)(AX + (size_t)u.e * NCHKP * 512); }
    DEV const char* bptr(const Unit& u) const { return (const char*)(Bt + (size_t)u.e * 256 * KK); }
    DEV void epi(const f32x4 (&acc)[2][2][4][2], const Unit& u, int wr, int wc, int fr, int fq) const {
#pragma unroll
        for (int ai = 0; ai < 2; ++ai)
#pragma unroll
            for (int m = 0; m < 4; ++m) {
                const int row = u.pm * 256 + ai * 128 + wr * 64 + m * 16 + fr;
#pragma unroll
                for (int bj = 0; bj < 2; ++bj) {
                    const int cl = bj * 128 + wc * 32 + 8 * fq;
                    if (KK == 256) {
                        float* dst = SL + ((size_t)(u.e * NCHKP + row) * 256 + cl);
                        *(f32x4*)dst = acc[ai][bj][m][0]; *(f32x4*)(dst + 4) = acc[ai][bj][m][1];
                    } else if (row < NCHK) {
                        f32x4 v0 = acc[ai][bj][m][0], v1 = acc[ai][bj][m][1];
#pragma unroll
                        for (int j = 0; j < 4; ++j) { v0[j] = gelu_tanh(v0[j]); v1[j] = gelu_tanh(v1[j]); }
                        bf16_t* dst = Z + ((size_t)(row * 16 + (cl >> 4)) * 256 + u.e * 16 + (cl & 15));
                        *(u32x4*)dst = pack8(v0, v1);
                    }
                }
            }
    }
};
struct JobGlu {
    static constexpr int K = 256; static constexpr bool FP8 = false;
    const bf16_t* Z; const bf16_t* Bt; const float* bias; bf16_t* MIX; int G, c;
    DEV bool unit(int i, Unit& u) const { u.x = 0; u.e = 0; return dense_unit(i * G + c, 130, 1, u.pm, u.pn); }
    DEV void aoffs(const Unit& u, const int (&R)[2], const int (&C)[2], unsigned (&a0)[2], unsigned (&a1)[2]) const { dense_aoffs(u.pm, 256, R, C, a0, a1); }
    DEV const char* abase(const Unit&) const { return (const char*)Z; }
    DEV const char* bptr(const Unit&) const { return (const char*)Bt; }
    DEV void epi(const f32x4 (&acc)[2][2][4][2], const Unit& u, int wr, int wc, int fr, int fq) const {
#pragma unroll
        for (int bj = 0; bj < 2; ++bj) {
            const int cl = bj * 128 + wc * 32 + 8 * fq;
            const f32x4 b0 = *(const f32x4*)(bias + cl), b1 = *(const f32x4*)(bias + cl + 4);
#pragma unroll
            for (int ai = 0; ai < 2; ++ai)
#pragma unroll
                for (int m = 0; m < 4; ++m) {
                    const int row = u.pm * 256 + ai * 128 + wr * 64 + m * 16 + fr;
                    const u32x4 zz = *(const u32x4*)(Z + (size_t)row * 256 + cl);
                    f32x4 v0 = acc[ai][bj][m][0] + b0, v1 = acc[ai][bj][m][1] + b1;
                    v0[0] = blo(zz.x) * sigmoidf_(v0[0]); v0[1] = bhi(zz.x) * sigmoidf_(v0[1]); v0[2] = blo(zz.y) * sigmoidf_(v0[2]); v0[3] = bhi(zz.y) * sigmoidf_(v0[3]);
                    v1[0] = blo(zz.z) * sigmoidf_(v1[0]); v1[1] = bhi(zz.z) * sigmoidf_(v1[1]); v1[2] = blo(zz.w) * sigmoidf_(v1[2]); v1[3] = bhi(zz.w) * sigmoidf_(v1[3]);
#ifdef DIAG_GLU_CONST
                    v0 = (f32x4){0.5f * blo(zz.x), 0.5f * bhi(zz.x), 0.5f * blo(zz.y), 0.5f * bhi(zz.y)}; v1 = (f32x4){0.5f * blo(zz.z), 0.5f * bhi(zz.z), 0.5f * blo(zz.w), 0.5f * bhi(zz.w)};
#endif
#ifdef DIAG_S5_ZERO
                    v0 = (f32x4){0.f, 0.f, 0.f, 0.f}; v1 = v0;
#endif
                    *(u32x4*)(MIX + (size_t)row * 1024 + 256 + cl) = pack8(v0, v1);
                }
        }
    }
};
struct JobOut {
    static constexpr int K = 1024; static constexpr bool FP8 = false;
    const bf16_t* MIX; const bf16_t* Bt; bf16_t* MIXO; int G, c, nM;
    DEV bool unit(int i, Unit& u) const { u.x = 0; u.e = 0; return dense_unit(i * G + c, nM, 4, u.pm, u.pn); }
    DEV void aoffs(const Unit& u, const int (&R)[2], const int (&C)[2], unsigned (&a0)[2], unsigned (&a1)[2]) const { dense_aoffs(u.pm, 1024, R, C, a0, a1); }
    DEV const char* abase(const Unit&) const { return (const char*)MIX; }
    DEV const char* bptr(const Unit& u) const { return (const char*)(Bt + (size_t)u.pn * 256 * 1024); }
    DEV void epi(const f32x4 (&acc)[2][2][4][2], const Unit& u, int wr, int wc, int fr, int fq) const {
#pragma unroll
        for (int ai = 0; ai < 2; ++ai)
#pragma unroll
            for (int m = 0; m < 4; ++m) {
                const int row = u.pm * 256 + ai * 128 + wr * 64 + m * 16 + fr;
#pragma unroll
                for (int bj = 0; bj < 2; ++bj) {
                    const int cl = u.pn * 256 + bj * 128 + wc * 32 + 8 * fq;
                    *(u32x4*)(MIXO + (size_t)row * 1024 + cl) = pack8(acc[ai][bj][m][0], acc[ai][bj][m][1]);
                }
            }
    }
};
template <int NT> DEV bool moe_unit(int i, int G, int c, const volatile LAS int* bs, int lane_unused, Unit& u) {
    const int lane = lane_fresh();
    const int total = bs[32] * NT, per = (total + 7) >> 3, j = i * (G >> 3) + (c >> 3);
    if (j >= per) return false;
    const int up = (c & 7) * per + j; if (up >= total) return false;
    const int rb = up / NT; u.pn = up % NT; u.pm = rb;
    const unsigned long long m = __ballot(lane < 32 && bs[(lane & 31) + 1] <= rb);
    u.e = __popcll(m); u.x = (rb - bs[u.e]) * 256;
    return true;
}
struct JobGu {
    static constexpr int K = 512; static constexpr bool FP8 = true;
    const unsigned char* F8; const unsigned char* Wgu; const float* bgu; const int* ltok; unsigned char* ACT; const volatile LAS int* bs; int G, c, lane;
    DEV bool unit(int i, Unit& u) const { return moe_unit<8>(i, G, c, bs, lane, u); }
    DEV void aoffs(const Unit& u, const int (&R)[2], const int (&C)[2], unsigned (&a0)[2], unsigned (&a1)[2]) const {
        const int cnt = bs[33 + u.e];
#pragma unroll
        for (int i = 0; i < 2; ++i) {
            const int p0 = u.x + R[i], p1 = p0 + 128;
            const int t0 = p0 < cnt ? ltok[(size_t)u.e * NTOK + p0] : 0, t1 = p1 < cnt ? ltok[(size_t)u.e * NTOK + p1] : 0;
            a0[i] = (unsigned)(t0 * 512 + C[i]) * 2u; a1[i] = (unsigned)(t1 * 512 + C[i]) * 2u;
        }
    }
    static constexpr int NST = 4;
    DEV const unsigned* pre_src(const Unit& u, int wid, int lane) const {
        if (wid < 4) return (const unsigned*)(ltok + (size_t)u.e * NTOK + u.x + wid * 64 + lane);
        const int i = (wid - 4) * 64 + lane; return (const unsigned*)(bgu + (size_t)u.e * 2048 + u.pn * 128 + (i < 128 ? i : 1024 + i - 128)); }
    DEV int pre_dst(int wid, int par) const { return wid < 4 ? PRE_LTOK + wid * 256 : PRE_BIAS + par * 1024 + (wid - 4) * 256; }
    DEV void aoffs_lds(const Unit& u, const int (&R)[2], const int (&C)[2], unsigned (&a0)[2], unsigned (&a1)[2], const LAS unsigned char* lt) const {
        const int cnt = bs[33 + u.e];
#pragma unroll
        for (int i = 0; i < 2; ++i) {
            const int p0 = u.x + R[i], p1 = p0 + 128;
            const int v0 = ((const LAS int*)lt)[R[i]], v1 = ((const LAS int*)lt)[R[i] + 128];
            const int t0 = p0 < cnt ? v0 : 0, t1 = p1 < cnt ? v1 : 0;
            a0[i] = (unsigned)(t0 * 512 + C[i]) * 2u; a1[i] = (unsigned)(t1 * 512 + C[i]) * 2u;
        }
    }
    DEV const char* abase(const Unit&) const { return (const char*)F8; }
    DEV const char* bptr(const Unit& u) const { return (const char*)(Wgu + ((size_t)u.e * 2048 + u.pn * 256) * 1024); }
    DEV void epi(const f32x4 (&acc)[2][2][4][2], const Unit& u, int wr, int wc, int fr, int fq, const LAS float* bias) const {
        const int cl = wc * 32 + 8 * fq;
        const LAS float* bg = bias + cl;
        const f32x4 g0 = *(const LAS f32x4*)bg, g1 = *(const LAS f32x4*)(bg + 4), l0 = *(const LAS f32x4*)(bg + 128), l1 = *(const LAS f32x4*)(bg + 132);
        constexpr float SC = 1.0f / 512.0f;
        const bool odd = fq & 1;
#pragma unroll
        for (int ai = 0; ai < 2; ++ai)
#pragma unroll
            for (int mp = 0; mp < 2; ++mp) {
                u32x2 w2[2];
#pragma unroll
                for (int mm = 0; mm < 2; ++mm) { const int m = 2 * mp + mm;
                    f32x4 a0 = acc[ai][0][m][0] * SC + g0, a1 = acc[ai][0][m][1] * SC + g1, b0 = acc[ai][1][m][0] * SC + l0, b1 = acc[ai][1][m][1] * SC + l1;
#pragma unroll
                    for (int j = 0; j < 4; ++j) {
                        float gl = fminf(a0[j], 7.0f), li = fminf(fmaxf(b0[j], -7.0f), 7.0f); a0[j] = (gl * __builtin_amdgcn_rcpf(1.0f + __builtin_amdgcn_exp2f(gl * -2.45546695959f))) * fmaf(li, 4.0f, 4.0f);
                        gl = fminf(a1[j], 7.0f); li = fminf(fmaxf(b1[j], -7.0f), 7.0f); a1[j] = (gl * __builtin_amdgcn_rcpf(1.0f + __builtin_amdgcn_exp2f(gl * -2.45546695959f))) * fmaf(li, 4.0f, 4.0f);
                    }
                    w2[mm].x = pk_fp8x4_nc(a0[0], a0[1], a0[2], a0[3]); w2[mm].y = pk_fp8x4_nc(a1[0], a1[1], a1[2], a1[3]); }
                const u32x2 snd = odd ? w2[0] : w2[1]; u32x2 rcv; rcv.x = (unsigned)__shfl_xor((int)snd.x, 16); rcv.y = (unsigned)__shfl_xor((int)snd.y, 16);
                const u32x2 own = odd ? w2[1] : w2[0];
                const u32x4 o = odd ? (u32x4){rcv.x, rcv.y, own.x, own.y} : (u32x4){own.x, own.y, rcv.x, rcv.y};
                const int row = u.pm * 256 + ai * 128 + wr * 64 + (2 * mp + (odd ? 1 : 0)) * 16 + fr;
                *(u32x4*)(ACT + (size_t)row * 1024 + u.pn * 128 + wc * 32 + 16 * (fq >> 1)) = o;
            }
    }
};
struct JobDown {
    static constexpr int K = 512; static constexpr bool FP8 = true;
    const unsigned char* ACT; const unsigned char* Wdn; const float* bdn; unsigned char* YB; const volatile LAS int* bs; int G, c, lane;
    DEV bool unit(int i, Unit& u) const { return moe_unit<4>(i, G, c, bs, lane, u); }
    DEV void aoffs(const Unit& u, const int (&R)[2], const int (&C)[2], unsigned (&a0)[2], unsigned (&a1)[2]) const { dense_aoffs(u.pm, 512, R, C, a0, a1); }
    DEV const char* abase(const Unit&) const { return (const char*)ACT; }
    DEV const char* bptr(const Unit& u) const { return (const char*)(Wdn + ((size_t)u.e * 1024 + u.pn * 256) * 1024); }
    static constexpr int NST = 8;
    DEV const unsigned* pre_src(const Unit& u, int wid, int lane) const { return (const unsigned*)(bdn + (size_t)u.e * 1024 + u.pn * 256 + (wid & 3) * 64 + lane); }
    DEV int pre_dst(int wid, int par) const { return wid < 4 ? PRE_LTOK + wid * 256 : PRE_BIAS + par * 1024 + (wid - 4) * 256; }
    DEV void aoffs_lds(const Unit& u, const int (&R)[2], const int (&C)[2], unsigned (&a0)[2], unsigned (&a1)[2], const LAS unsigned char*) const { dense_aoffs(u.pm, 512, R, C, a0, a1); }
    DEV void epi(const f32x4 (&acc)[2][2][4][2], const Unit& u, int wr, int wc, int fr, int fq, const LAS float* bias) const {
        constexpr float SC = 1.0f / 256.0f;
#pragma unroll
        for (int bj = 0; bj < 2; ++bj) {
            const int cl = u.pn * 256 + bj * 128 + wc * 32 + 8 * fq;
            const LAS float* bp = bias + bj * 128 + wc * 32 + 8 * fq;
            const f32x4 b0 = *(const LAS f32x4*)bp, b1 = *(const LAS f32x4*)(bp + 4);
            const bool odd = fq & 1;
#pragma unroll
            for (int ai = 0; ai < 2; ++ai)
#pragma unroll
                for (int mp = 0; mp < 2; ++mp) {
                    u32x2 w2[2];
#pragma unroll
                    for (int mm = 0; mm < 2; ++mm) { const int m = 2 * mp + mm;
                        const f32x4 y0 = (acc[ai][bj][m][0] * SC + b0) * 16.0f, y1 = (acc[ai][bj][m][1] * SC + b1) * 16.0f;
                        w2[mm].x = pk_fp8x4(y0[0], y0[1], y0[2], y0[3]); w2[mm].y = pk_fp8x4(y1[0], y1[1], y1[2], y1[3]); }
                    const u32x2 snd = odd ? w2[0] : w2[1]; u32x2 rcv; rcv.x = (unsigned)__shfl_xor((int)snd.x, 16); rcv.y = (unsigned)__shfl_xor((int)snd.y, 16);
                    const u32x2 own = odd ? w2[1] : w2[0];
                    const u32x4 o = odd ? (u32x4){rcv.x, rcv.y, own.x, own.y} : (u32x4){own.x, own.y, rcv.x, rcv.y};
                    const int row = u.pm * 256 + ai * 128 + wr * 64 + (2 * mp + (odd ? 1 : 0)) * 16 + fr;
                    *(u32x4*)(YB + (size_t)row * 1024 + u.pn * 256 + bj * 128 + wc * 32 + 16 * (fq >> 1)) = o;
                }
        }
    }
};
}

struct Ctx {
    LAS unsigned char* lds; int tid, lane, wave, G, bid;
    unsigned char* ws; unsigned* ctl;
};
DEV const float* row_src0(KParams& P, int r) { return r < NLAT ? PIN(0) + (size_t)r * D : PIN(2) + (size_t)(r - NLAT) * D; }
DEV int mod_sel(int r) { return r < SEQ ? 0 : (r < NLAT ? 1 : 2); }

DEV void p0_transpose_item(const float* W, int N, bf16_t* WT, int ldt, LAS float* scr, int k0, int n0, int drow0, int lane) {
#pragma unroll 8
    for (int i = 0; i < 32; ++i) { const int kk = 2 * i + (lane >> 5); scr[kk * 33 + (lane & 31)] = W[(size_t)(k0 + kk) * N + n0 + (lane & 31)]; }
    LDS_WAIT();
    const int c = lane & 7;
#pragma unroll
    for (int j = 0; j < 4; ++j) { const int n = (lane >> 3) + 8 * j; const LAS float* s = scr + (8 * c) * 33 + n;
        u32x4 o; o.x = cvt_pk_bf16(s[0 * 33], s[1 * 33]); o.y = cvt_pk_bf16(s[2 * 33], s[3 * 33]); o.z = cvt_pk_bf16(s[4 * 33], s[5 * 33]); o.w = cvt_pk_bf16(s[6 * 33], s[7 * 33]);
        *(u32x4*)(WT + (size_t)(drow0 + n) * ldt + k0 + 8 * c) = o; }
    LDS_WAIT();
}
struct F8Item { const float* src; unsigned char* dst; int N; };
DEV void p0_f8_load(const F8Item& d, f32x4 (&v)[16]) {
#pragma unroll
    for (int i = 0; i < 16; ++i) v[i] = *(const f32x4*)(d.src + (size_t)i * d.N);
}
DEV void p0_f8_finish(const F8Item& d, const f32x4 (&v)[16], float scale) {
    unsigned E[4][4];
#pragma unroll
    for (int kq = 0; kq < 4; ++kq) {
        unsigned Dw[4];
#pragma unroll
        for (int r = 0; r < 4; ++r) { const f32x4 x = v[4 * kq + r] * scale; Dw[r] = g8::pk_fp8x4(x[0], x[1], x[2], x[3]); }
        const unsigned a = __builtin_amdgcn_perm(Dw[1], Dw[0], 0x05010400u), bb = __builtin_amdgcn_perm(Dw[1], Dw[0], 0x07030602u);
        const unsigned c = __builtin_amdgcn_perm(Dw[3], Dw[2], 0x05010400u), dd = __builtin_amdgcn_perm(Dw[3], Dw[2], 0x07030602u);
        E[0][kq] = __builtin_amdgcn_perm(c, a, 0x05040100u); E[1][kq] = __builtin_amdgcn_perm(c, a, 0x07060302u);
        E[2][kq] = __builtin_amdgcn_perm(dd, bb, 0x05040100u); E[3][kq] = __builtin_amdgcn_perm(dd, bb, 0x07060302u);
    }
#pragma unroll
    for (int j = 0; j < 4; ++j) *(u32x4*)(d.dst + (size_t)j * 1024) = (u32x4){E[j][0], E[j][1], E[j][2], E[j][3]};
}
DEV F8Item p0_f8_desc(KParams& P, Ctx& X, int r) {
    const int lane = X.lane, kg = lane >> 3, n4 = lane & 7; F8Item d;
    if (r < 32768) { const int mtx = r >> 9, q = r & 511, kb = q >> 6, nb = q & 63, n0 = nb * 32, half = n0 >> 10, nn = n0 & 1023, drow = (nn >> 7) * 256 + half * 128 + (nn & 127);
        d.N = 2048; d.src = PIN(29) + (size_t)mtx * 1024 * 2048 + (size_t)(kb * 128 + 16 * kg) * 2048 + n0 + 4 * n4;
        d.dst = X.ws + WS_WGU + (size_t)mtx * 2048 * 1024 + (size_t)(drow + 4 * n4) * 1024 + kb * 128 + 16 * kg; }
    else { const int r2 = r - 32768, mtx = r2 >> 8, q = r2 & 255, kb = q >> 5, nb = q & 31;
        d.N = 1024; d.src = PIN(31) + (size_t)mtx * 1024 * 1024 + (size_t)(kb * 128 + 16 * kg) * 1024 + nb * 32 + 4 * n4;
        d.dst = X.ws + WS_WDN + (size_t)mtx * 1024 * 1024 + (size_t)(nb * 32 + 4 * n4) * 1024 + kb * 128 + 16 * kg; }
    return d;
}
DEV void p0_transpose_item_f8(const float* W, int N, unsigned char* WT, int k0, int n0, int drow0, int lane, float scale) {
    const int kg = lane >> 3, n4 = lane & 7; F8Item d; d.N = N; d.src = W + (size_t)(k0 + 16 * kg) * N + n0 + 4 * n4; d.dst = WT + (size_t)(drow0 + 4 * n4) * 1024 + k0 + 16 * kg;
    f32x4 v[16]; p0_f8_load(d, v); p0_f8_finish(d, v, scale);
}
DEV void p0_s5_setup(KParams& P, Ctx& X, int l, int g) {
    LAS f32x2* LAM = (LAS f32x2*)X.lds; LAS f32x2* BBAR = LAM + 2 * 64 * 17; LAS f32x2* CC = BBAR + 2 * 64 * 16; LAS float* KF = (LAS float*)(CC + 2 * 16 * 64);
    const int tid = X.tid;
    if (tid < 128) {
        const int d = tid >> 6, p = tid & 63; const size_t gi = ((size_t)(l * 2 + d) * 16 + g);
        const float are = PIN(16)[gi * 64 + p], aim = PIN(17)[gi * 64 + p], dt = __expf(PIN(18)[gi]);
        const float mag = __expf(are * dt); float cs, sn; sincos_red(aim * dt, cs, sn);
        const float ar = mag * cs, ai = mag * sn;
        float pr = 1.f, pi = 0.f;
        for (int t = 0; t <= 16; ++t) { LAM[(d * 64 + p) * 17 + t] = (f32x2){pr, pi}; const float nr = pr * ar - pi * ai, ni = pr * ai + pi * ar; pr = nr; pi = ni; }
        const float den = are * are + aim * aim, nr1 = ar - 1.0f;
        const float cr = (nr1 * are + ai * aim) / den, ci = (ai * are - nr1 * aim) / den;
        for (int h = 0; h < 16; ++h) { const float br = PIN(19)[(gi * 64 + p) * 16 + h], bi = PIN(20)[(gi * 64 + p) * 16 + h];
            BBAR[(d * 64 + p) * 16 + h] = (f32x2){cr * br - ci * bi, cr * bi + ci * br}; }
        ((f32x2*)(X.ws + WS_LAM16))[gi * 64 + p] = LAM[(d * 64 + p) * 17 + 16];
    }
    for (int i = tid; i < 2048; i += NTHREADS) { const int d = i >> 10, h = (i >> 6) & 15, p = i & 63; const size_t gi = ((size_t)(l * 2 + d) * 16 + g);
        CC[i] = (f32x2){PIN(21)[(gi * 16 + h) * 64 + p], PIN(22)[(gi * 16 + h) * 64 + p]}; }
    __syncthreads();
    for (int i = tid; i < 8192; i += NTHREADS) {
        const int d = i >> 12, tau = (i >> 8) & 15, h = (i >> 4) & 15, hp = i & 15; float s = 0.f;
        for (int p = 0; p < 64; ++p) { const f32x2 c = CC[(d * 16 + h) * 64 + p], lm = LAM[(d * 64 + p) * 17 + tau], b = BBAR[(d * 64 + p) * 16 + hp];
            const float gr = c.x * lm.x - c.y * lm.y, gi2 = c.x * lm.y + c.y * lm.x; s += gr * b.x - gi2 * b.y; }
        KF[i] = s;
    }
    __syncthreads();
    bf16_t* B1 = (bf16_t*)(X.ws + WS_S5B1) + (size_t)(l * 16 + g) * 256 * 256;
    bf16_t* B2 = (bf16_t*)(X.ws + WS_S5B2) + (size_t)(l * 16 + g) * 256 * 512;
    const float* dsk = PIN(23) + l * 256 + g * 16;
    for (int i = tid; i < 256 * 128; i += NTHREADS) {
        const int row = i >> 7, k = (i & 127) * 2;
        const int ii = row >> 4, h = row & 15, j = k >> 4; float v[2];
#pragma unroll
        for (int q = 0; q < 2; ++q) { const int hp = (k & 15) + q; float s = 0.f;
            if (j <= ii) s += KF[((0 * 16 + (ii - j)) * 16 + h) * 16 + hp];
            if (j >= ii) s += KF[((1 * 16 + (j - ii)) * 16 + h) * 16 + hp];
            if (j == ii && h == hp) s += dsk[h];
            v[q] = s; }
        *(unsigned*)(B2 + (size_t)row * 512 + k) = cvt_pk_bf16(v[0], v[1]);
        { const int n = k; const int d = n >> 7, part = (n >> 6) & 1, p = n & 63; float w[2];
#pragma unroll
          for (int q = 0; q < 2; ++q) { const f32x2 c = CC[(d * 16 + h) * 64 + p + q], lm = LAM[(d * 64 + p + q) * 17 + (d == 0 ? ii + 1 : 16 - ii)];
              const float zr = c.x * lm.x - c.y * lm.y, zi = c.x * lm.y + c.y * lm.x; w[q] = part ? -zi : zr; }
          *(unsigned*)(B2 + (size_t)row * 512 + 256 + k) = cvt_pk_bf16(w[0], w[1]); }
        { const int n = row; const int d = n >> 7, part = (n >> 6) & 1, p = n & 63; float w[2];
#pragma unroll
          for (int q = 0; q < 2; ++q) { const f32x2 lm = LAM[(d * 64 + p) * 17 + (d == 0 ? 15 - j : j)], b = BBAR[(d * 64 + p) * 16 + (k & 15) + q];
              const float zr = lm.x * b.x - lm.y * b.y, zi = lm.x * b.y + lm.y * b.x; w[q] = part ? zi : zr; }
          *(unsigned*)(B1 + (size_t)row * 256 + k) = cvt_pk_bf16(w[0], w[1]); }
    }
    __syncthreads();
}
DEV void p0_mod_item(KParams& P, Ctx& X, int item) {
    const int l = item / 192, j0 = (item % 192) * 32;
    const float* W = PIN(4) + (size_t)l * 1024 * 6144;
    const int col = X.lane & 31, kh = X.lane >> 5, kb = X.wave * 128;
    float s0 = 0.f, s1 = 0.f, s2 = 0.f;
#pragma unroll 8
    for (int i = 0; i < 64; ++i) { const int k = kb + 2 * i + kh; const float w = W[(size_t)k * 6144 + j0 + col];
        s0 += silu_(PIN(1)[k]) * w; s1 += silu_(PIN(1)[1024 + k]) * w; s2 += silu_(PIN(3)[k]) * w; }
    LAS float* red = (LAS float*)X.lds;
    red[((X.wave * 2 + kh) * 32 + col) * 3 + 0] = s0; red[((X.wave * 2 + kh) * 32 + col) * 3 + 1] = s1; red[((X.wave * 2 + kh) * 32 + col) * 3 + 2] = s2;
    __syncthreads();
    if (X.tid < 96) { const int r = X.tid / 32, cc = X.tid % 32; float s = PIN(5)[l * 6144 + j0 + cc];
        for (int q = 0; q < 16; ++q) s += red[(q * 32 + cc) * 3 + r];
        ((float*)(X.ws + WS_MOD))[(size_t)(l * 3 + r) * 6144 + j0 + cc] = s; }
    __syncthreads();
}
DEV void p0_prologue(KParams& P, Ctx& X) {
    if (X.bid < 32) p0_s5_setup(P, X, X.bid >> 4, X.bid & 15);
    if (X.tid < 4) { const int g16 = X.bid & 15, kb = X.bid >> 4, nb16 = (X.G - g16 + 15) >> 4;
        __hip_atomic_store(X.ctl + CW_WQ + 64 * (32 + X.tid * 16 + g16) + kb, (unsigned)((130 * kb) / nb16) | ((unsigned)((130 * (kb + 1)) / nb16) << 16), __ATOMIC_RELAXED, __HIP_MEMORY_SCOPE_AGENT); }
    for (int it = X.bid; it < 384; it += X.G) p0_mod_item(P, X, it);
    if (X.bid == X.G - 2) { for (int i = X.tid; i < 1024; i += NTHREADS) ((float*)(X.ws + WS_MOD + 160 * 1024))[i] = log1pf(__expf(-PIN(15)[i])); }
    if (X.bid == X.G - 1) {
        for (int i = X.tid; i < 4096; i += NTHREADS) { const int pos = i >> 4, f = i & 15; const float inv = powf(10000.0f, -(float)f / 16.0f); float c, s; sincos_red((float)pos * inv, c, s);
            ((f32x2*)(X.ws + WS_ROPE))[i] = (f32x2){c, s}; }
    }
    LAS float* scr = (LAS float*)(X.lds + X.wave * 16384);
    const int gw = X.bid * NWAVES + X.wave, NGW = X.G * NWAVES;
    constexpr int I_GU = 8 * 64, I_DN = 8 * 32, I_IN = 16 * 72, I_OUT = 16 * 32, I_GLU = 4 * 8, I_R = 16, I_LRU = 2;
    constexpr int N_GU = 64 * I_GU, N_DN = 64 * I_DN, N_IN = 2 * I_IN, N_OUT = 2 * I_OUT, N_GLU = 2 * I_GLU, N_R = 2 * I_R, N_LRU = 32 * I_LRU;
    constexpr int NITEMS = N_GU + N_DN + N_IN + N_OUT + N_GLU + N_R + N_LRU;
    for (;;) {
      int chunk = 0; if (X.lane == 0) chunk = (int)atomicAdd(X.ctl + CW_WQ + 64 * 30, 1u); chunk = rfl(chunk);
      if (chunk * 8 >= NITEMS) break;
      if (chunk * 8 + 8 <= N_GU + N_DN) {
          f32x4 va[16], vb[16]; F8Item da = p0_f8_desc(P, X, chunk * 8), db; p0_f8_load(da, va);
#pragma unroll 1
          for (int i = 0; i < 8; i += 2) {
              db = p0_f8_desc(P, X, chunk * 8 + i + 1); p0_f8_load(db, vb);
              p0_f8_finish(da, va, 64.0f);
              if (i + 2 < 8) { da = p0_f8_desc(P, X, chunk * 8 + i + 2); p0_f8_load(da, va); }
              p0_f8_finish(db, vb, 64.0f);
          }
          continue;
      }
      for (int it = chunk * 8; it < chunk * 8 + 8 && it < NITEMS; ++it) {
        int r = it;
        if (r < N_GU) { const int mtx = r / I_GU, q = r % I_GU, kb = q / 64, nb = q % 64, n0 = nb * 32;
            const int half = n0 >> 10, nn = n0 & 1023, drow = (nn >> 7) * 256 + half * 128 + (nn & 127);
            p0_transpose_item_f8(PIN(29) + (size_t)mtx * 1024 * 2048, 2048, X.ws + WS_WGU + (size_t)mtx * 2048 * 1024, kb * 128, n0, drow, X.lane, 64.0f); continue; } r -= N_GU;
        if (r < N_DN) { const int mtx = r / I_DN, q = r % I_DN, kb = q / 32, nb = q % 32;
            p0_transpose_item_f8(PIN(31) + (size_t)mtx * 1024 * 1024, 1024, X.ws + WS_WDN + (size_t)mtx * 1024 * 1024, kb * 128, nb * 32, nb * 32, X.lane, 64.0f); continue; } r -= N_DN;
        if (r < N_IN) { const int mtx = r / I_IN, q = r % I_IN, kb = q / 72, nb = q % 72;
            p0_transpose_item(PIN(7) + (size_t)mtx * 1024 * 2304, 2304, (bf16_t*)(X.ws + WS_WIN) + (size_t)mtx * 2304 * 1024, 1024, scr, kb * 64, nb * 32, nb * 32, X.lane); continue; } r -= N_IN;
        if (r < N_OUT) { const int mtx = r / I_OUT, q = r % I_OUT, kb = q / 32, nb = q % 32;
            p0_transpose_item(PIN(8) + (size_t)mtx * 1024 * 1024, 1024, (bf16_t*)(X.ws + WS_WOUT) + (size_t)mtx * 1024 * 1024, 1024, scr, kb * 64, nb * 32, nb * 32, X.lane); continue; } r -= N_OUT;
        if (r < N_GLU) { const int mtx = r / I_GLU, q = r % I_GLU, kb = q / 8, nb = q % 8;
            p0_transpose_item(PIN(24) + (size_t)mtx * 256 * 256, 256, (bf16_t*)(X.ws + WS_WGLU) + (size_t)mtx * 256 * 256, 256, scr, kb * 64, nb * 32, nb * 32, X.lane); continue; } r -= N_GLU;
        if (r < N_R) { const int mtx = r / I_R, kb = r % I_R;
            p0_transpose_item(PIN(27) + (size_t)mtx * 1024 * 32, 32, (bf16_t*)(X.ws + WS_WRT) + (size_t)mtx * 32 * 1024, 1024, scr, kb * 64, 0, 0, X.lane); continue; } r -= N_R;
        { const int mtx = r / I_LRU, nb = r % I_LRU;
          const int n = mtx & 3, dir = (mtx >> 2) & 1, which = (mtx >> 3) & 1, l = mtx >> 4;
          const float* src = (which ? PIN(13) : PIN(11)) + (size_t)((l * 2 + dir) * 4 + n) * 64 * 64;
          bf16_t* dst = (bf16_t*)(X.ws + WS_WLRU) + (size_t)(l * 4 + n) * 256 * 64;
          p0_transpose_item(src, 64, dst, 64, scr, 0, nb * 32, (dir * 2 + which) * 64 + nb * 32, X.lane); }
      }
    }
}

DEV void rowA_one(const float* src, const float* g, const float* shift, const float* scale, bf16_t* dst, int lane) {
    f32x4 v[4]; float ss = 0.f;
#pragma unroll
    for (int j = 0; j < 4; ++j) { v[j] = *(const f32x4*)(src + 4 * lane + 256 * j); ss += v[j][0] * v[j][0] + v[j][1] * v[j][1] + v[j][2] * v[j][2] + v[j][3] * v[j][3]; }
    const float rstd = rsqrtf(wave_sum(ss) * (1.0f / D) + EPS);
#pragma unroll
    for (int j = 0; j < 4; ++j) { const int c = 4 * lane + 256 * j; const f32x4 gg = *(const f32x4*)(g + c), sh = *(const f32x4*)(shift + c), sc = *(const f32x4*)(scale + c);
        f32x4 o;
#pragma unroll
        for (int q = 0; q < 4; ++q) o[q] = v[j][q] * rstd * gg[q] * (1.0f + sc[q]) + sh[q];
        u32x2 w; w.x = cvt_pk_bf16(o[0], o[1]); w.y = cvt_pk_bf16(o[2], o[3]); *(u32x2*)(dst + c) = w; }
}
DEV void phase_rowA(KParams& P, Ctx& X, int l) {
    const int gw = X.bid * NWAVES + X.wave, NGW = X.G * NWAVES, lane = X.lane;
    const float* mod = (const float*)(X.ws + WS_MOD) + (size_t)l * 3 * 6144; const float* g = PIN(6) + (size_t)l * 4 * 1024;
    for (int r0 = gw * 2; r0 < NTOK; r0 += NGW * 2) {
        f32x4 v[2][4]; float ss[2] = {0.f, 0.f};
#pragma unroll
        for (int q = 0; q < 2; ++q) { const float* src = row_src0(P, r0 + q);
#pragma unroll
            for (int j = 0; j < 4; ++j) v[q][j] = *(const f32x4*)(src + 4 * lane + 256 * j); }
#pragma unroll
        for (int q = 0; q < 2; ++q)
#pragma unroll
            for (int j = 0; j < 4; ++j) ss[q] += v[q][j][0] * v[q][j][0] + v[q][j][1] * v[q][j][1] + v[q][j][2] * v[q][j][2] + v[q][j][3] * v[q][j][3];
#pragma unroll
        for (int q = 0; q < 2; ++q) { const float rstd = rsqrtf(wave_sum(ss[q]) * (1.0f / D) + EPS); const float* m = mod + mod_sel(r0 + q) * 6144; bf16_t* dst = (bf16_t*)(X.ws + WS_H) + (size_t)(r0 + q) * D;
#pragma unroll
            for (int j = 0; j < 4; ++j) { const int c = 4 * lane + 256 * j; const f32x4 gg = *(const f32x4*)(g + c), sh = *(const f32x4*)(m + c), sc = *(const f32x4*)(m + 1024 + c); f32x4 o;
#pragma unroll
                for (int e = 0; e < 4; ++e) o[e] = v[q][j][e] * rstd * gg[e] * (1.0f + sc[e]) + sh[e];
                u32x2 w; w.x = cvt_pk_bf16(o[0], o[1]); w.y = cvt_pk_bf16(o[2], o[3]); *(u32x2*)(dst + c) = w; } }
    }
}

DEV void phase_krope(KParams& P, Ctx& X) {
    bf16_t* IN7 = (bf16_t*)(X.ws + WS_IN7); const f32x2* RT = (const f32x2*)(X.ws + WS_ROPE);
    const int nth = X.G * NTHREADS;
    for (int it = X.bid * NTHREADS + X.tid; it < NLAT * 32; it += nth) {
        const int tok = it >> 5, h = (it >> 2) & 7, s = (it >> 1) & 1, f8 = it & 1; const int tl = tok & (SEQ - 1), pos = s ? (tl & 63) : (tl >> 6);
        bf16_t* p = IN7 + (size_t)tok * LD7 + COL_K + h * 64 + s * 32 + f8 * 8;
        const u32x4 u1 = *(const u32x4*)p, u2 = *(const u32x4*)(p + 16);
        const unsigned a[4] = {u1.x, u1.y, u1.z, u1.w}, b[4] = {u2.x, u2.y, u2.z, u2.w}; unsigned o1[4], o2[4];
#pragma unroll
        for (int q = 0; q < 4; ++q) { const f32x2 t0 = RT[pos * 16 + f8 * 8 + 2 * q], t1 = RT[pos * 16 + f8 * 8 + 2 * q + 1];
            const float x0 = blo(a[q]), x1 = bhi(a[q]), y0 = blo(b[q]), y1 = bhi(b[q]);
            o1[q] = cvt_pk_bf16(x0 * t0.x - y0 * t0.y, x1 * t1.x - y1 * t1.y); o2[q] = cvt_pk_bf16(y0 * t0.x + x0 * t0.y, y1 * t1.x + x1 * t1.y); }
        *(u32x4*)p = (u32x4){o1[0], o1[1], o1[2], o1[3]}; *(u32x4*)(p + 16) = (u32x4){o2[0], o2[1], o2[2], o2[3]};
    }
}

DEV int wq_fetch_block(Ctx& X, int q) {
    volatile LAS int* slot = (volatile LAS int*)(X.lds + LDS_MISC + 1024);
    __syncthreads();
    if (X.tid == 0) slot[0] = (int)atomicAdd(X.ctl + CW_WQ + 64 * q, 1u);
    __syncthreads();
    return slot[0];
}
DEV void lru_load(Ctx& X, int c, int n, int pass, u32x4 (&cin)[4], u32x4& gv, float& hin) {
    const int tid = X.tid, ti = tid >> 3, c8 = tid & 7, ch0 = n * 64 + c8 * 8;
    const bf16_t* IN7 = (const bf16_t*)(X.ws + WS_IN7);
#pragma unroll
    for (int k = 0; k < 4; ++k) { int row = c * 64 + ti + k - 2; row = min(max(row, 0), NTOK - 1); cin[k] = *(const u32x4*)(IN7 + (size_t)row * LD7 + COL_LU + ch0); }
    if (pass == 2) {
        gv = *(const u32x4*)(IN7 + (size_t)(c * 64 + ti) * LD7 + COL_LG + ch0);
        hin = ((const float*)(X.ws + WS_LCIN))[((size_t)(tid >> 8) * LCH + c) * 256 + n * 64 + (tid & 63)]; }
}
constexpr int LRU_CONST = 10240;
DEV void lru_unit(KParams& P, Ctx& X, int l, int c, int n, int pass, const bf16x8 (&wf)[8][2], const u32x4 (&cin)[4], const u32x4& gvp, float hinp, int nn, volatile LAS int* slotw) {
    const int t0 = c * 64, tid = X.tid, lane = X.lane, wave = X.wave;
    const int tl0 = c < 512 ? (c & 255) * 64 : ((c - 512) & 3) * 64, seqlen = c < 512 ? SEQ : CTXL;
    const bf16_t* IN7 = (const bf16_t*)(X.ws + WS_IN7);
    LAS bf16_t* Cs = (LAS bf16_t*)X.lds;
    LAS f32x2* AB = (LAS f32x2*)(X.lds + 16384);
    LAS f32x2* SUB = (LAS f32x2*)(X.lds + 16384 + 65536);
    {
        const int ti = tid >> 3, c8 = tid & 7, ch0 = n * 64 + c8 * 8; float a[8];
        const LAS float* LC = (const LAS float*)(X.lds + LRU_CONST);
        { const f32x4 c0 = *(const LAS f32x4*)(LC + 256 + c8 * 8), c1 = *(const LAS f32x4*)(LC + 256 + c8 * 8 + 4); a[0] = c0[0]; a[1] = c0[1]; a[2] = c0[2]; a[3] = c0[3]; a[4] = c1[0]; a[5] = c1[1]; a[6] = c1[2]; a[7] = c1[3]; }
#pragma unroll
        for (int k = 0; k < 4; ++k) { const int tt = tl0 + ti + k - 2;
            if (tt >= 0 && tt < seqlen) { const u32x4 v = cin[k]; const f32x4 w0 = *(const LAS f32x4*)(LC + k * 64 + c8 * 8), w1 = *(const LAS f32x4*)(LC + k * 64 + c8 * 8 + 4); const float w[8] = {w0[0], w0[1], w0[2], w0[3], w1[0], w1[1], w1[2], w1[3]};
                a[0] += w[0] * blo(v.x); a[1] += w[1] * bhi(v.x); a[2] += w[2] * blo(v.y); a[3] += w[3] * bhi(v.y); a[4] += w[4] * blo(v.z); a[5] += w[5] * bhi(v.z); a[6] += w[6] * blo(v.w); a[7] += w[7] * bhi(v.w); } }
        u32x4 o; o.x = cvt_pk_bf16(a[0], a[1]); o.y = cvt_pk_bf16(a[2], a[3]); o.z = cvt_pk_bf16(a[4], a[5]); o.w = cvt_pk_bf16(a[6], a[7]);
        *(LAS u32x4*)(Cs + ti * 72 + c8 * 8) = o;
    }
    __syncthreads();
    {
        const int mt = wave & 3, dir = wave >> 2, fr = lane & 15, q4 = lane >> 4;
        bf16x8 af[2];
#pragma unroll
        for (int ks = 0; ks < 2; ++ks) af[ks] = *(const LAS bf16x8*)(Cs + (16 * mt + fr) * 72 + ks * 32 + q4 * 8);
        f32x4 acc[8];
#pragma unroll
        for (int t = 0; t < 8; ++t) { acc[t] = (f32x4){0.f, 0.f, 0.f, 0.f};
#pragma unroll
            for (int ks = 0; ks < 2; ++ks) acc[t] = __builtin_amdgcn_mfma_f32_16x16x32_bf16(af[ks], wf[t][ks], acc[t], 0, 0, 0); }
#pragma unroll
        for (int t = 0; t < 4; ++t) { const int chl = t * 16 + fr, ch = n * 64 + chl;
            const LAS float* GC = (const LAS float*)(X.lds + LRU_CONST) + 320 + dir * 192 + chl; (void)ch;
            const float ba = GC[0], bx = GC[64], sp = GC[128];
#pragma unroll
            for (int i = 0; i < 4; ++i) { const int tk = 16 * mt + 4 * q4 + i;
                const float r = __builtin_amdgcn_rcpf(1.0f + __builtin_amdgcn_exp2f(fmaf(acc[t][i], -1.44269504088896f, ba))), ig = __builtin_amdgcn_rcpf(1.0f + __builtin_amdgcn_exp2f(fmaf(acc[4 + t][i], -1.44269504088896f, bx)));
                const float a = __builtin_amdgcn_exp2f(r * sp);
                const float cv = bf2f(Cs[tk * 72 + chl]);
                AB[(dir * 64 + tk) * 64 + chl] = (f32x2){a, __builtin_amdgcn_sqrtf(fmaxf(1.0f - a * a, 0.0f)) * ig * cv}; } }
    }
    __syncthreads();
    const int sdir = tid >> 8, ssub = (tid >> 6) & 3, schl = tid & 63;
    {
        float A = 1.f, B = 0.f;
        if (sdir == 0) { for (int t = 16 * ssub; t < 16 * ssub + 16; ++t) { const f32x2 ab = AB[(0 * 64 + t) * 64 + schl]; A *= ab.x; B = ab.x * B + ab.y; } }
        else { for (int t = 16 * ssub + 15; t >= 16 * ssub; --t) { const f32x2 ab = AB[(1 * 64 + t) * 64 + schl]; A *= ab.x; B = ab.x * B + ab.y; } }
        SUB[(sdir * 4 + ssub) * 64 + schl] = (f32x2){A, B};
    }
    if (tid == 0) *slotw = nn;
    __syncthreads();
    if (pass == 1) {
        if (ssub == 0) { float A = 1.f, B = 0.f;
            for (int q = 0; q < 4; ++q) { const f32x2 s = SUB[(sdir * 4 + (sdir ? 3 - q : q)) * 64 + schl]; A *= s.x; B = s.x * B + s.y; }
            ((f32x2*)(X.ws + WS_LAGG))[((size_t)sdir * LCH + c) * 256 + n * 64 + schl] = (f32x2){A, B}; }
    } else {
        float h = hinp;
        if (sdir == 0) { for (int q = 0; q < ssub; ++q) { const f32x2 s = SUB[(0 * 4 + q) * 64 + schl]; h = s.x * h + s.y; }
            for (int t = 16 * ssub; t < 16 * ssub + 16; ++t) { const f32x2 ab = AB[(0 * 64 + t) * 64 + schl]; h = ab.x * h + ab.y; AB[(0 * 64 + t) * 64 + schl].x = h; } }
        else { for (int q = 3; q > ssub; --q) { const f32x2 s = SUB[(1 * 4 + q) * 64 + schl]; h = s.x * h + s.y; }
            for (int t = 16 * ssub + 15; t >= 16 * ssub; --t) { const f32x2 ab = AB[(1 * 64 + t) * 64 + schl]; h = ab.x * h + ab.y; AB[(1 * 64 + t) * 64 + schl].x = h; } }
        __syncthreads();
        const int ti = tid >> 3, c8 = tid & 7, ch0 = n * 64 + c8 * 8;
        const u32x4 gv = gvp; const unsigned gw[4] = {gv.x, gv.y, gv.z, gv.w}; unsigned o[4];
#pragma unroll
        for (int q = 0; q < 4; ++q) { const int cl = c8 * 8 + 2 * q;
            const float y0 = AB[(0 * 64 + ti) * 64 + cl].x + AB[(1 * 64 + ti) * 64 + cl].x, y1 = AB[(0 * 64 + ti) * 64 + cl + 1].x + AB[(1 * 64 + ti) * 64 + cl + 1].x;
            o[q] = cvt_pk_bf16(y0 * gelu_tanh(blo(gw[q])), y1 * gelu_tanh(bhi(gw[q]))); }
        *(u32x4*)((bf16_t*)(X.ws + WS_MIX) + (size_t)(t0 + ti) * 1024 + ch0) = (u32x4){o[0], o[1], o[2], o[3]};
    }
}
DEV void phase_lru(KParams& P, Ctx& X, int l, int pass, int q) {
    const int n = X.bid & 3, fr = X.lane & 15, q4 = X.lane >> 4, dir = X.wave >> 2;
    const bf16_t* Wt = (const bf16_t*)(X.ws + WS_WLRU) + (size_t)(l * 4 + n) * 256 * 64;
    bf16x8 wf[8][2];
#pragma unroll
    for (int t = 0; t < 8; ++t)
#pragma unroll
        for (int ks = 0; ks < 2; ++ks) wf[t][ks] = *(const bf16x8*)(Wt + (size_t)(dir * 128 + t * 16 + fr) * 64 + ks * 32 + q4 * 8);
    unsigned* head = X.ctl + CW_WQ + 64 * (100 + q * 4 + n);
    volatile LAS int* slot = (volatile LAS int*)(X.lds + LDS_MISC + 1024);
    { LAS float* LC = (LAS float*)(X.lds + LRU_CONST);
      for (int i = X.tid; i < 704; i += NTHREADS) { float v;
          if (i < 256) v = PIN(9)[(size_t)(l * 4 + (i >> 6)) * 256 + n * 64 + (i & 63)];
          else if (i < 320) v = PIN(10)[l * 256 + n * 64 + (i - 256)];
          else { const int j = i - 320, d = j / 192, wh = (j % 192) >> 6, ch = n * 64 + (j & 63);
              v = wh == 0 ? PIN(12)[(l * 2 + d) * 256 + ch] * -1.44269504088896f : wh == 1 ? PIN(14)[(l * 2 + d) * 256 + ch] * -1.44269504088896f
                          : ((const float*)(X.ws + WS_MOD + 160 * 1024))[(l * 2 + d) * 256 + ch] * (-8.0f * 1.44269504088896f); }
          LC[i] = v; } }
    __syncthreads();
    if (X.tid == 0) { slot[0] = (int)atomicAdd(head, 1u); slot[1] = (int)atomicAdd(head, 1u); }
    __syncthreads();
    int c = slot[0], cn = slot[1], par = 0;
    __syncthreads();
    u32x4 cin[4], cnx[4], gvc = (u32x4){0u, 0u, 0u, 0u}, gvn = (u32x4){0u, 0u, 0u, 0u}; float hc = 0.f, hn = 0.f;
    if (c < LCH) lru_load(X, c, n, pass, cin, gvc, hc);
    while (c < LCH) {
        int nn = 0; if (X.tid == 0) nn = (int)atomicAdd(head, 1u);
        if (cn < LCH) lru_load(X, cn, n, pass, cnx, gvn, hn);
        lru_unit(P, X, l, c, n, pass, wf, cin, gvc, hc, nn, slot + par);
        c = cn; cn = slot[par]; par ^= 1;
#pragma unroll
        for (int k = 0; k < 4; ++k) cin[k] = cnx[k];
        gvc = gvn; hc = hn;
    }
    __syncthreads();
}

DEV void lru_carry_block(Ctx& X, int wt) {
    const int b = wt >> 3, dir = (wt >> 2) & 1, ch = (wt & 3) * 64 + X.lane, w = X.wave;
    const f32x2* AGG = (const f32x2*)(X.ws + WS_LAGG) + (size_t)dir * LCH * 256 + ch; float* CIN = (float*)(X.ws + WS_LCIN) + (size_t)dir * LCH * 256 + ch;
    LAS f32x2* E = (LAS f32x2*)(X.lds + 65536);
    const int s0 = 33 * w, s1 = min(s0 + 33, 260);
    float A = 1.f, B = 0.f;
#pragma unroll 11
    for (int s = s0; s < s1; ++s) { const int cidx = dir == 0 ? (s < 4 ? 512 + b * 4 + s : b * 256 + (s - 4)) : (s < 4 ? 512 + b * 4 + (3 - s) : b * 256 + (259 - s));
        const f32x2 ab = AGG[(size_t)cidx * 256]; A *= ab.x; B = ab.x * B + ab.y; }
    E[w * 64 + X.lane] = (f32x2){A, B};
    __syncthreads();
    float h = 0.f;
    for (int j = 0; j < w; ++j) { const f32x2 e = E[j * 64 + X.lane]; h = e.x * h + e.y; }
#pragma unroll 11
    for (int s = s0; s < s1; ++s) { const int cidx = dir == 0 ? (s < 4 ? 512 + b * 4 + s : b * 256 + (s - 4)) : (s < 4 ? 512 + b * 4 + (3 - s) : b * 256 + (259 - s));
        const f32x2 ab = AGG[(size_t)cidx * 256]; CIN[(size_t)cidx * 256] = h; h = ab.x * h + ab.y; }
    __syncthreads();
}
DEV void s5_carry_block(Ctx& X, int l, int st) {
    const int b = st >> 5, dir = (st >> 4) & 1, g = st & 15, p = X.lane, w = X.wave;
    const f32x2 lm = ((const f32x2*)(X.ws + WS_LAM16))[((size_t)(l * 2 + dir) * 16 + g) * 64 + p];
    const float* SL = (const float*)(X.ws + WS_SL) + (size_t)g * NCHKP * 256 + dir * 128 + p; bf16_t* AX = (bf16_t*)(X.ws + WS_AX) + (size_t)g * NCHKP * 512 + 256 + dir * 128 + p;
    LAS f32x2* E = (LAS f32x2*)(X.lds + 65536);
    const int s0 = 130 * w;
    float xr = 0.f, xi = 0.f;
#pragma unroll 13
    for (int s = s0; s < s0 + 130; ++s) { const int cidx = dir == 0 ? (s < 16 ? 2048 + b * 16 + s : b * 1024 + (s - 16)) : (s < 16 ? 2048 + b * 16 + (15 - s) : b * 1024 + (1039 - s));
        const float sr = SL[(size_t)cidx * 256], si = SL[(size_t)cidx * 256 + 64];
        const float nr = lm.x * xr - lm.y * xi + sr, ni = lm.x * xi + lm.y * xr + si; xr = nr; xi = ni; }
    E[w * 64 + p] = (f32x2){xr, xi};
    float pr = 1.f, pi = 0.f;
    for (int k = 0; k < 130; ++k) { const float nr = pr * lm.x - pi * lm.y, ni = pr * lm.y + pi * lm.x; pr = nr; pi = ni; }
    __syncthreads();
    xr = 0.f; xi = 0.f;
    for (int j = 0; j < w; ++j) { const f32x2 e = E[j * 64 + p]; const float nr = pr * xr - pi * xi + e.x, ni = pr * xi + pi * xr + e.y; xr = nr; xi = ni; }
#pragma unroll 13
    for (int s = s0; s < s0 + 130; ++s) { const int cidx = dir == 0 ? (s < 16 ? 2048 + b * 16 + s : b * 1024 + (s - 16)) : (s < 16 ? 2048 + b * 16 + (15 - s) : b * 1024 + (1039 - s));
        const float sr = SL[(size_t)cidx * 256], si = SL[(size_t)cidx * 256 + 64];
        AX[(size_t)cidx * 512] = (bf16_t)(cvt_pk_bf16(xr, 0.f) & 0xffffu); AX[(size_t)cidx * 512 + 64] = (bf16_t)(cvt_pk_bf16(xi, 0.f) & 0xffffu);
        const float nr = lm.x * xr - lm.y * xi + sr, ni = lm.x * xi + lm.y * xr + si; xr = nr; xi = ni; }
    __syncthreads();
}

template <class T> DEV T ldg32(const void* base, unsigned off) { return *(const T*)((const char*)base + off); }
constexpr int A_CK = 2048, A_CV = A_CK + 256 * 80, A_LK = A_CV + 64 * 272, A_LV = A_LK + 576 * 80, A_NEG = A_LV + 64 * 880, A_END = A_NEG + 1024, A_SLOT = 160000;
static_assert(A_END <= A_SLOT, "attention LDS map");
DEV u32x2 cvt8_fp8(const u32x4& v) {
    u32x2 o; o.x = g8::pk_fp8x4_nc(blo(v.x), bhi(v.x), blo(v.y), bhi(v.y)); o.y = g8::pk_fp8x4_nc(blo(v.z), bhi(v.z), blo(v.w), bhi(v.w)); return o; }
typedef long i64_t;
DEV i64_t as_i64(const u32x2& v) { return __builtin_bit_cast(i64_t, v); }
DEV float max3f(float a, float b, float c) { float r; asm("v_max3_f32 %0, %1, %2, %3" : "=v"(r) : "v"(a), "v"(b), "v"(c)); return r; }
constexpr float ATT_C2 = 0.125f * 1.44269504088896f;
template <class HOOK> DEV void attn_tile(KParams& P, Ctx& X, int l, int b, int h, int r, int cb, bool lat, const u32x4& q0, const u32x4& q1, HOOK&& hook) {
    const int lane = X.lane, fr = lane & 15, q4 = lane >> 4;
    const LAS float* BIAS = (const LAS float*)(X.lds);
    const int tq = lat ? b * SEQ + r * 64 + cb * 16 + fr : NLAT + b * CTXL + cb * 16 + fr;
    hook();
    const i64_t qp[2] = {as_i64((u32x2){q0.x, q0.y}), as_i64((u32x2){q0.z, q0.w})}, qr[2] = {as_i64((u32x2){q1.x, q1.y}), as_i64((u32x2){q1.z, q1.w})};
    const int rs = min(max(r - 4, 0), 248), bs = min(max(cb * 16 - 8, 0), 32);
    f32x4 sc[16];
    f32x4 oacc[4];
#pragma unroll
    for (int dt = 0; dt < 4; ++dt) oacc[dt] = (f32x4){0.f, 0.f, 0.f, 0.f};
    float mrun = -3.0e38f, sum = 0.f;
    if (lat) {
        float mx = -3.0e38f;
        const int qc = cb * 16 + fr, ws0 = min(max(qc - 8, 0), 48);
        const LAS float* bptr[8];
#pragma unroll
        for (int e = 0; e < 8; ++e) { const int kc = bs + 16 * (e >> 2) + 4 * q4 + (e & 3); const bool ok = (kc >= ws0) && (kc < ws0 + 16);
            bptr[e] = ok ? BIAS + (rs - r + 7) * 31 + min(max(kc - qc + 15, 0), 30) : (const LAS float*)(X.lds + A_NEG); }
        const LAS unsigned char* klds = X.lds + A_LK + (bs + fr) * 80 + q4 * 8;
        const LAS unsigned char* vlds = X.lds + A_LV + fr * 880 + ((bs >> 2) + q4) * 8;
        const int s0 = rs % 9;
        i64_t kf[2][4];
#define ATT_LDK(buf, j) do { const int sl_ = s0 + (j) >= 9 ? s0 + (j) - 9 : s0 + (j); _Pragma("unroll") for (int c2 = 0; c2 < 2; ++c2) { const LAS unsigned char* kp = klds + (sl_ * 64 + 16 * c2) * 80; \
            kf[buf][2 * c2] = *(const LAS i64_t*)kp; kf[buf][2 * c2 + 1] = *(const LAS i64_t*)(kp + 32); } } while (0)
        ATT_LDK(0, 0);
        float bvn[8];
#pragma unroll
        for (int e = 0; e < 8; ++e) bvn[e] = bptr[e][0];
#pragma unroll
        for (int j = 0; j < 8; ++j) {
            if (j < 7) ATT_LDK((j + 1) & 1, j + 1);
            float bvv[8];
#pragma unroll
            for (int e = 0; e < 8; ++e) bvv[e] = bvn[e];
            if (j < 7) {
#pragma unroll
                for (int e = 0; e < 8; ++e) bvn[e] = bptr[e][(j + 1) * 31]; }
            f32x4 a[2];
#pragma unroll
            for (int c2 = 0; c2 < 2; ++c2) a[c2] = __builtin_amdgcn_mfma_f32_16x16x32_fp8_fp8(kf[j & 1][2 * c2], qr[0], (f32x4){0.f, 0.f, 0.f, 0.f}, 0, 0, 0);
#pragma unroll
            for (int c2 = 0; c2 < 2; ++c2) a[c2] = __builtin_amdgcn_mfma_f32_16x16x32_fp8_fp8(kf[j & 1][2 * c2 + 1], qr[1], a[c2], 0, 0, 0);
#pragma unroll
            for (int c2 = 0; c2 < 2; ++c2) {
#pragma unroll
                for (int i = 0; i < 4; ++i) a[c2][i] = fmaf(a[c2][i], ATT_C2, bvv[c2 * 4 + i]);
                mx = max3f(mx, a[c2][0], a[c2][1]); mx = max3f(mx, a[c2][2], a[c2][3]);
                sc[2 * j + c2] = a[c2]; }
        }
#undef ATT_LDK
        mx = fmaxf(mx, __shfl_xor(mx, 16)); mx = fmaxf(mx, __shfl_xor(mx, 32));
        const float mm = mx - 8.0f;
#pragma unroll
        for (int t = 0; t < 16; ++t)
#pragma unroll
            for (int i = 0; i < 4; ++i) { const float e = __builtin_amdgcn_exp2f(sc[t][i] - mm); sc[t][i] = e; sum += e; }
        i64_t vf[2][4];
#define ATT_LDV(buf, j) do { const int sl_ = s0 + (j) >= 9 ? s0 + (j) - 9 : s0 + (j); _Pragma("unroll") for (int dt = 0; dt < 4; ++dt) vf[buf][dt] = *(const LAS i64_t*)(vlds + dt * 16 * 880 + sl_ * 96); } while (0)
        ATT_LDV(0, 0);
#pragma unroll
        for (int j = 0; j < 8; ++j) {
            if (j < 7) ATT_LDV((j + 1) & 1, j + 1);
            const i64_t pb = as_i64((u32x2){g8::pk_fp8x4_nc(sc[2 * j][0], sc[2 * j][1], sc[2 * j][2], sc[2 * j][3]), g8::pk_fp8x4_nc(sc[2 * j + 1][0], sc[2 * j + 1][1], sc[2 * j + 1][2], sc[2 * j + 1][3])});
#pragma unroll
            for (int dt = 0; dt < 4; ++dt) oacc[dt] = __builtin_amdgcn_mfma_f32_16x16x32_fp8_fp8(vf[j & 1][dt], pb, oacc[dt], 0, 0, 0);
        }
#undef ATT_LDV
        mrun = mx;
    }
    {
        float mx = -3.0e38f;
        const LAS unsigned char* kcl = X.lds + A_CK + fr * 80 + q4 * 8;
        const LAS unsigned char* vcl = X.lds + A_CV + fr * 272 + q4 * 8;
        i64_t kc[2][4];
#define ATT_LDKC(buf, g) do { _Pragma("unroll") for (int t = 0; t < 2; ++t) { const LAS unsigned char* kp = kcl + (16 * (2 * (g) + t)) * 80; \
            kc[buf][2 * t] = *(const LAS i64_t*)kp; kc[buf][2 * t + 1] = *(const LAS i64_t*)(kp + 32); } } while (0)
        ATT_LDKC(0, 0);
#pragma unroll
        for (int g = 0; g < 8; ++g) {
            if (g < 7) ATT_LDKC((g + 1) & 1, g + 1);
            f32x4 a[2];
#pragma unroll
            for (int t = 0; t < 2; ++t) a[t] = __builtin_amdgcn_mfma_f32_16x16x32_fp8_fp8(kc[g & 1][2 * t], qp[0], (f32x4){0.f, 0.f, 0.f, 0.f}, 0, 0, 0);
#pragma unroll
            for (int t = 0; t < 2; ++t) a[t] = __builtin_amdgcn_mfma_f32_16x16x32_fp8_fp8(kc[g & 1][2 * t + 1], qp[1], a[t], 0, 0, 0);
#pragma unroll
            for (int t = 0; t < 2; ++t) { a[t] = a[t] * ATT_C2; mx = max3f(mx, a[t][0], a[t][1]); mx = max3f(mx, a[t][2], a[t][3]); sc[2 * g + t] = a[t]; }
        }
#undef ATT_LDKC
        mx = fmaxf(mx, __shfl_xor(mx, 16)); mx = fmaxf(mx, __shfl_xor(mx, 32));
        const float mnew = fmaxf(mrun, mx), alpha = __builtin_amdgcn_exp2f(mrun - mnew), mm = mnew - 8.0f;
        sum *= alpha;
#pragma unroll
        for (int dt = 0; dt < 4; ++dt) oacc[dt] = oacc[dt] * alpha;
#pragma unroll
        for (int t = 0; t < 16; ++t)
#pragma unroll
            for (int i = 0; i < 4; ++i) { const float e = __builtin_amdgcn_exp2f(sc[t][i] - mm); sc[t][i] = e; sum += e; }
        i64_t vc[2][4];
#define ATT_LDVC(buf, t2) do { _Pragma("unroll") for (int dt = 0; dt < 4; ++dt) vc[buf][dt] = *(const LAS i64_t*)(vcl + dt * 16 * 272 + 32 * (t2)); } while (0)
        ATT_LDVC(0, 0);
#pragma unroll
        for (int t2 = 0; t2 < 8; ++t2) {
            if (t2 < 7) ATT_LDVC((t2 + 1) & 1, t2 + 1);
            const i64_t pb = as_i64((u32x2){g8::pk_fp8x4_nc(sc[2 * t2][0], sc[2 * t2][1], sc[2 * t2][2], sc[2 * t2][3]), g8::pk_fp8x4_nc(sc[2 * t2 + 1][0], sc[2 * t2 + 1][1], sc[2 * t2 + 1][2], sc[2 * t2 + 1][3])});
#pragma unroll
            for (int dt = 0; dt < 4; ++dt) oacc[dt] = __builtin_amdgcn_mfma_f32_16x16x32_fp8_fp8(vc[t2 & 1][dt], pb, oacc[dt], 0, 0, 0);
        }
#undef ATT_LDVC
    }
    sum += __shfl_xor(sum, 16); sum += __shfl_xor(sum, 32);
    const float inv = 1.0f / sum;
    bf16_t* op = (bf16_t*)(X.ws + WS_MIX) + (size_t)tq * 1024 + 512 + h * 64 + 4 * q4;
#pragma unroll
    for (int dt = 0; dt < 4; ++dt) { u32x2 w; w.x = cvt_pk_bf16(oacc[dt][0] * inv, oacc[dt][1] * inv); w.y = cvt_pk_bf16(oacc[dt][2] * inv, oacc[dt][3] * inv); *(u32x2*)(op + 16 * dt) = w; }
}
DEV int mix2_take(Ctx& X, unsigned* wq, int nb16, int kb, unsigned old) {
    if ((int)(old & 0xffffu) < (int)(old >> 16)) return (int)(old & 0xffffu);
    for (;;) {
        unsigned v = 0; if (X.lane < nb16 && X.lane != kb) v = __hip_atomic_load(wq + X.lane, __ATOMIC_RELAXED, __HIP_MEMORY_SCOPE_AGENT);
        const int rem = max((int)(v >> 16) - (int)(v & 0xffffu), 0);
        int key = (rem << 8) | X.lane;
#pragma unroll
        for (int o = 32; o; o >>= 1) key = max(key, __shfl_xor(key, o));
        if ((key >> 8) == 0) return -1;
        const int V = key & 255; const unsigned vv = (unsigned)__shfl((int)v, V);
        const int vlo = (int)(vv & 0xffffu), vhi = (int)(vv >> 16), mid = vlo + ((vhi - vlo) >> 1);
        int ok = 0;
        if (X.lane == 0) { ok = atomicCAS(wq + V, vv, (unsigned)vlo | ((unsigned)mid << 16)) == vv;
            if (ok) __hip_atomic_store(wq + kb, (unsigned)(mid + 1) | ((unsigned)vhi << 16), __ATOMIC_RELAXED, __HIP_MEMORY_SCOPE_AGENT); }
        if (rfl(ok)) return mid;
    }
}
DEV void phase_mix2(KParams& P, Ctx& X, int l, int q) {
    if (X.bid < 64) s5_carry_block(X, l, X.bid); else if (X.bid < 80) lru_carry_block(X, X.bid - 64);
    const int g16 = X.bid & 15, b = g16 >> 3, h = g16 & 7;
    const bf16_t* IN7g = (const bf16_t*)(X.ws + WS_IN7); const bf16_t* VTg = (const bf16_t*)(X.ws + WS_VT);
    { LAS float* B = (LAS float*)X.lds; const float* src = PIN(26) + (size_t)(l * 8 + h) * 465; for (int i = X.tid; i < 465; i += NTHREADS) B[i] = src[i] * 1.44269504088896f;
      if (X.tid < 256) ((LAS float*)(X.lds + A_NEG))[X.tid] = -3.0e38f;
      for (int i = X.tid; i < 2048; i += NTHREADS) { const int key = i >> 3, pc = i & 7;
          *(LAS u32x2*)(X.lds + A_CK + key * 80 + pc * 8) = cvt8_fp8(*(const u32x4*)(IN7g + (size_t)(NLAT + b * CTXL + key) * LD7 + COL_K + h * 64 + pc * 8)); }
      for (int i = X.tid; i < 2048; i += NTHREADS) { const int dim = i >> 5, pc = i & 31;
          const u32x2 v = cvt8_fp8(*(const u32x4*)(VTg + ((size_t)((NLAT + b * CTXL) / 8 + pc) * 512 + h * 64 + dim) * 8));
          const int grp = pc >> 2, a = pc & 3, T = a >> 1, q0 = 2 * (a & 1);
          LAS unsigned char* row = X.lds + A_CV + dim * 272 + grp * 32;
          *(LAS unsigned*)(row + q0 * 8 + T * 4) = v.x; *(LAS unsigned*)(row + (q0 + 1) * 8 + T * 4) = v.y; } }
    __syncthreads();
    unsigned* wq = X.ctl + CW_WQ + 64 * (32 + q * 16 + g16);
    const int kb = X.bid >> 4, nb16 = (X.G - g16 + 15) >> 4;
    volatile LAS int* slot = (volatile LAS int*)(X.lds + A_SLOT);
#define MIX2_LDROW(KR, VR, row) do { int tz_ = X.tid; asm volatile("" : "+v"(tz_)); \
        KR = *(const u32x4*)(IN7g + (size_t)(b * SEQ + (row) * 64 + (tz_ >> 3)) * LD7 + COL_K + h * 64 + (tz_ & 7) * 8); \
        VR = *(const u32x4*)(VTg + ((size_t)((b * SEQ + (row) * 64) / 8 + (tz_ >> 6)) * 512 + h * 64 + (tz_ & 63)) * 8); } while (0)
#define MIX2_STROW(KR, VR, row) do { int tz_ = X.tid; asm volatile("" : "+v"(tz_)); const int sl_ = (row) % 9; \
        *(LAS u32x2*)(X.lds + A_LK + (sl_ * 64 + (tz_ >> 3)) * 80 + (tz_ & 7) * 8) = cvt8_fp8(KR); \
        const u32x2 v8 = cvt8_fp8(VR); const int u0 = 2 * X.wave;                   \
        LAS unsigned char* vrow = X.lds + A_LV + (tz_ & 63) * 880 + sl_ * 96; \
        if (u0 <= 11) *(LAS unsigned*)(vrow + u0 * 8) = v8.x;             \
        if (u0 >= 4) *(LAS unsigned*)(vrow + (u0 - 4) * 8 + 4) = v8.x;     \
        if (u0 + 1 <= 11) *(LAS unsigned*)(vrow + (u0 + 1) * 8) = v8.y; \
        if (u0 + 1 >= 4) *(LAS unsigned*)(vrow + (u0 - 3) * 8 + 4) = v8.y; } while (0)
    unsigned old = 0;
    if (X.wave == 0) { if (X.lane == 0) old = atomicAdd(wq + kb, 1u); const int t = mix2_take(X, wq, nb16, kb, (unsigned)rfl((int)old)); if (X.lane == 0) slot[0] = t; }
    __syncthreads();
    int it = slot[0], hb = -100;
    u32x4 qa, qb; bool haveq = false;
    const unsigned char* QB = X.ws + WS_IN7 + (size_t)(COL_Q + h * 64) * 2;
    while (it >= 0) {
        const bool loc = it < 128; const int rb = min(max(2 * it - 4, 0), 247);
        const int tq = loc ? b * SEQ + (2 * it + (X.wave >> 2)) * 64 + (X.wave & 3) * 16 + (X.lane & 15) : NLAT + b * CTXL + ((it - 128) * 8 + X.wave) * 16 + (X.lane & 15);
        if (!haveq) { const unsigned char* qsrc = QB + (size_t)tq * (LD7 * 2) + (X.lane >> 4) * 32; qa = *(const u32x4*)qsrc; qb = *(const u32x4*)(qsrc + 16); }
        if (loc && hb != rb) {
            u32x4 kk[9], vv[9];
#pragma unroll
            for (int i = 0; i < 9; ++i) MIX2_LDROW(kk[i], vv[i], rb + i);
#pragma unroll
            for (int i = 0; i < 9; ++i) MIX2_STROW(kk[i], vv[i], rb + i);
            hb = rb;
            __syncthreads();
        }
        int d = 0; if (loc && it + 1 < 128) d = min(max(2 * it - 2, 0), 247) - rb;
        u32x4 kreg[2], vreg[2], na, nb;
        auto hook = [&]() {
            if (loc && it + 1 < 128) { const unsigned char* qsrc = QB + (size_t)(tq + 128) * (LD7 * 2) + (X.lane >> 4) * 32; na = *(const u32x4*)qsrc; nb = *(const u32x4*)(qsrc + 16); }
            if (d > 0) MIX2_LDROW(kreg[0], vreg[0], rb + 9);
            if (d > 1) MIX2_LDROW(kreg[1], vreg[1], rb + 10);
            if (X.tid == 0) old = atomicAdd(wq + kb, 1u);
        };
        if (loc) attn_tile(P, X, l, b, h, 2 * it + (X.wave >> 2), X.wave & 3, true, qa, qb, hook);
        else attn_tile(P, X, l, b, h, 0, (it - 128) * 8 + X.wave, false, qa, qb, hook);
        if (X.wave == 0) { const int t = mix2_take(X, wq, nb16, kb, (unsigned)rfl((int)old)); if (X.lane == 0) slot[0] = t; }
        __syncthreads();
        const int itn = slot[0];
        if (loc && itn == it + 1 && itn < 128) {
            if (d > 0) MIX2_STROW(kreg[0], vreg[0], rb + 9);
            if (d > 1) MIX2_STROW(kreg[1], vreg[1], rb + 10);
            hb = rb + d; qa = na; qb = nb; haveq = true;
        } else haveq = false;
        __syncthreads();
        it = itn;
    }
#undef MIX2_LDROW
#undef MIX2_STROW
    __syncthreads();
}

DEV f32x4 ld_xrow(KParams& P, const bf16_t* XS, int l, int r, int c) {
    if (l == 0) return *(const f32x4*)(row_src0(P, r) + c);
    const u32x2 w = *(const u32x2*)(XS + (size_t)r * D + c); return (f32x4){blo(w.x), bhi(w.x), blo(w.y), bhi(w.y)};
}
DEV void st_xrow(bf16_t* XS, int r, int c, const f32x4& v) { u32x2 w; w.x = cvt_pk_bf16(v[0], v[1]); w.y = cvt_pk_bf16(v[2], v[3]); *(u32x2*)(XS + (size_t)r * D + c) = w; }
DEV void phase_rowB(KParams& P, Ctx& X, int l) {
    LAS unsigned char* FT = X.lds;
    LAS float* PART = (LAS float*)(X.lds + 36864);
    LAS int* ENT = (LAS int*)(X.lds + 36864 + 16384 + 2048);
    LAS int* CNTT = (LAS int*)(X.lds + 36864 + 16384 + 2048 + 8192);
    const float* mod = (const float*)(X.ws + WS_MOD) + (size_t)l * 3 * 6144; const float* g1 = PIN(6) + (size_t)(l * 4 + 1) * 1024; const float* g2 = g1 + 1024;
    const bf16_t* MIXO = (const bf16_t*)(X.ws + WS_MIXO); bf16_t* XS = (bf16_t*)(X.ws + WS_XS); unsigned char* F8 = X.ws + WS_H;
    const bf16_t* WrT = (const bf16_t*)(X.ws + WS_WRT) + (size_t)l * 32 * 1024;
    const int lane = X.lane, wave = X.wave, tid = X.tid;
    const int fr = lane & 15, q4 = lane >> 4;
    bf16x8 wb0[4], wb1[4];
#pragma unroll
    for (int ks = 0; ks < 4; ++ks) { const int k0 = wave * 128 + ks * 32 + q4 * 8; wb0[ks] = *(const bf16x8*)(WrT + (size_t)fr * 1024 + k0); wb1[ks] = *(const bf16x8*)(WrT + (size_t)(16 + fr) * 1024 + k0); }
    const float brv = PIN(28)[l * 32 + (tid & 31)];
    LAS float* LG = (LAS float*)(X.lds + 65536);
    for (int i = tid; i < 11 * 256; i += NTHREADS) { const int v = i >> 8, c4 = (i & 255) * 4;
        const float* s = v < 2 ? g1 + v * 1024 : mod + ((v - 2) / 3) * 6144 + (2 + (v - 2) % 3) * 1024;
        *(LAS f32x4*)(LG + v * 1024 + c4) = *(const f32x4*)(s + c4); }
    __syncthreads();
    int nent = 0;
    u32x2 mraw[2][4], mnx[2][4]; f32x4 xv[2][4], xnx[2][4];
    int grp = X.bid;
    if (grp < NTOK / 16) {
#pragma unroll
        for (int q = 0; q < 2; ++q) { const int r = grp * 16 + wave * 2 + q;
#pragma unroll
            for (int j = 0; j < 4; ++j) { const int c = 4 * lane + 256 * j; mnx[q][j] = *(const u32x2*)(MIXO + (size_t)r * D + c); xnx[q][j] = ld_xrow(P, XS, l, r, c); } }
    }
    for (; grp < NTOK / 16; grp += X.G) {
#pragma unroll
        for (int q = 0; q < 2; ++q)
#pragma unroll
            for (int j = 0; j < 4; ++j) { mraw[q][j] = mnx[q][j]; xv[q][j] = xnx[q][j]; }
        {
            const int gn = grp + X.G;
            if (gn < NTOK / 16) {
#pragma unroll
                for (int q = 0; q < 2; ++q) { const int r = gn * 16 + wave * 2 + q;
#pragma unroll
                    for (int j = 0; j < 4; ++j) { const int c = 4 * lane + 256 * j; mnx[q][j] = *(const u32x2*)(MIXO + (size_t)r * D + c); xnx[q][j] = ld_xrow(P, XS, l, r, c); } }
            }
        }
        {
            f32x4 mo[2][4]; float ss[2] = {0.f, 0.f}, ss2[2] = {0.f, 0.f};
#pragma unroll
            for (int q = 0; q < 2; ++q)
#pragma unroll
                for (int j = 0; j < 4; ++j) { const u32x2 w = mraw[q][j]; mo[q][j] = (f32x4){blo(w.x), bhi(w.x), blo(w.y), bhi(w.y)};
                    ss[q] += mo[q][j][0] * mo[q][j][0] + mo[q][j][1] * mo[q][j][1] + mo[q][j][2] * mo[q][j][2] + mo[q][j][3] * mo[q][j][3]; }
#pragma unroll
            for (int q = 0; q < 2; ++q) { const int r = grp * 16 + wave * 2 + q; const LAS float* m = LG + 2048 + mod_sel(r) * 3072;
                const float rstd1 = rsqrtf(wave_sum(ss[q]) * (1.0f / D) + EPS);
#pragma unroll
                for (int j = 0; j < 4; ++j) { const int c = 4 * lane + 256 * j; const f32x4 gg = *(const LAS f32x4*)(LG + c), m2 = *(const LAS f32x4*)(m + c);
#pragma unroll
                    for (int e = 0; e < 4; ++e) { xv[q][j][e] += m2[e] * (mo[q][j][e] * rstd1 * gg[e]); ss2[q] += xv[q][j][e] * xv[q][j][e]; }
                    st_xrow(XS, r, c, xv[q][j]); } }
#pragma unroll
            for (int q = 0; q < 2; ++q) { const int lr = wave * 2 + q, r = grp * 16 + lr; const LAS float* m = LG + 2048 + mod_sel(r) * 3072;
                const float rstd2 = rsqrtf(wave_sum(ss2[q]) * (1.0f / D) + EPS);
#pragma unroll
                for (int j = 0; j < 4; ++j) { const int c = 4 * lane + 256 * j; const f32x4 gg = *(const LAS f32x4*)(LG + 1024 + c), sh = *(const LAS f32x4*)(m + 1024 + c), sc = *(const LAS f32x4*)(m + 2048 + c);
                    f32x4 o;
#pragma unroll
                    for (int e = 0; e < 4; ++e) o[e] = xv[q][j][e] * rstd2 * gg[e] * (1.0f + sc[e]) + sh[e];
                    u32x2 w; w.x = cvt_pk_bf16(o[0], o[1]); w.y = cvt_pk_bf16(o[2], o[3]);
                    *(unsigned*)(F8 + (size_t)r * D + c) = g8::pk_fp8x4(o[0] * 8.0f, o[1] * 8.0f, o[2] * 8.0f, o[3] * 8.0f); *(LAS u32x2*)(FT + lr * 2064 + c * 2) = w; } }
        }
        __syncthreads();
        {
            f32x4 a0 = (f32x4){0.f, 0.f, 0.f, 0.f}, a1 = a0;
#pragma unroll
            for (int ks = 0; ks < 4; ++ks) { const int k0 = wave * 128 + ks * 32 + q4 * 8;
                const bf16x8 af = *(const LAS bf16x8*)(FT + fr * 2064 + k0 * 2);
                a0 = __builtin_amdgcn_mfma_f32_16x16x32_bf16(af, wb0[ks], a0, 0, 0, 0); a1 = __builtin_amdgcn_mfma_f32_16x16x32_bf16(af, wb1[ks], a1, 0, 0, 0); }
#pragma unroll
            for (int i = 0; i < 4; ++i) { PART[(wave * 16 + 4 * q4 + i) * 32 + fr] = a0[i]; PART[(wave * 16 + 4 * q4 + i) * 32 + 16 + fr] = a1[i]; }
        }
        __syncthreads();
        {
            const int row = tid >> 5, e = tid & 31; float v = brv;
#pragma unroll
            for (int w = 0; w < 8; ++w) v += PART[(w * 16 + row) * 32 + e];
            float tv[4]; int ti[4];
#pragma unroll
            for (int k = 0; k < 4; ++k) { float m = v; int mi = e;
#pragma unroll
                for (int o = 16; o >= 1; o >>= 1) { const float ov = __shfl_xor(m, o); const int oi = __shfl_xor(mi, o); const bool take = (ov > m) || (ov == m && oi < mi); m = take ? ov : m; mi = take ? oi : mi; }
                tv[k] = m; ti[k] = mi; v = (e == mi) ? -3.0e38f : v; }
            if (e == 0) { const int r = grp * 16 + row;
                const float e1 = __expf(tv[1] - tv[0]), e2 = __expf(tv[2] - tv[0]), e3 = __expf(tv[3] - tv[0]), is = 1.0f / (1.0f + e1 + e2 + e3);
                *(f32x4*)((float*)(X.ws + WS_GATE) + (size_t)r * 4) = (f32x4){is, e1 * is, e2 * is, e3 * is};
#pragma unroll
                for (int k = 0; k < 4; ++k) { ENT[nent * 64 + row * 4 + k] = ti[k]; ENT[640 + nent * 64 + row * 4 + k] = r * 4 + k; } }
        }
        ++nent;
    }
    __syncthreads();
    int myrank[2] = {0, 0}, mye[2] = {-1, -1};
#pragma unroll
    for (int t = 0; t < 2; ++t) { const int c = wave + 8 * t;
        if (c < nent) { const int e = ENT[c * 64 + lane]; mye[t] = e; int cnt_mine = 0;
            for (int x = 0; x < 32; ++x) { const unsigned long long mk = __ballot(e == x); if (e == x) myrank[t] = __popcll(mk & ((1ull << lane) - 1ull)); if (lane == x) cnt_mine = __popcll(mk); }
            if (lane < 32) CNTT[c * 32 + lane] = cnt_mine; } }
    __syncthreads();
    if (tid < 32) { int tot = 0; for (int c = 0; c < nent; ++c) tot += CNTT[c * 32 + tid];
        int base = tot ? (int)atomicAdd(X.ctl + CW_CNT + l * 32 + tid, (unsigned)tot) : 0;
        for (int c = 0; c < nent; ++c) { const int n = CNTT[c * 32 + tid]; CNTT[c * 32 + tid] = base; base += n; } }
    __syncthreads();
    { int* inv = (int*)(X.ws + WS_INV);
#pragma unroll
      for (int t = 0; t < 2; ++t) { const int c = wave + 8 * t;
        if (c < nent) { const int e = mye[t], pos = CNTT[c * 32 + e] + myrank[t], rk = ENT[640 + c * 64 + lane];
            ((int*)(X.ws + WS_LTOK))[(size_t)e * NTOK + pos] = rk >> 2; inv[rk] = (e << 20) | pos; } } }
    __syncthreads();
}

DEV void moe_table(Ctx& X, int l) {
    volatile LAS int* bs = (volatile LAS int*)(X.lds + LDS_MISC);
    if (X.tid < 64) { const int e = X.lane & 31; const int cnt = (int)X.ctl[CW_CNT + l * 32 + e]; int nb = (cnt + 255) >> 8; int inc = nb;
#pragma unroll
        for (int o = 1; o < 32; o <<= 1) { const int v = __shfl_up(inc, o); if ((X.lane & 31) >= o) inc += v; }
        if (X.lane < 32) { bs[e] = inc - nb; bs[33 + e] = cnt; if (e == 31) bs[32] = inc; } }
    __syncthreads();
}

DEV void phase_rowC(KParams& P, Ctx& X, int l, bool dry = false) {
    const int gw = X.bid * NWAVES + X.wave, NGW = X.G * NWAVES, lane = X.lane;
    const float* mod = (const float*)(X.ws + WS_MOD) + (size_t)l * 3 * 6144; const float* g3 = PIN(6) + (size_t)(l * 4 + 3) * 1024;
    const unsigned char* YB = X.ws + WS_YB; bf16_t* XS = (bf16_t*)(X.ws + WS_XS);
    const int* INV = (const int*)(X.ws + WS_INV); const float* GATE = (const float*)(X.ws + WS_GATE);
    bf16_t* XSW = XS; bf16_t* HW = (bf16_t*)(X.ws + WS_H);
    LAS float* LG = (LAS float*)X.lds;
    { const float* mod1 = (const float*)(X.ws + WS_MOD) + (size_t)3 * 6144; const float* g0 = PIN(6) + (size_t)4 * 1024;
      for (int i = X.tid; i < 11 * 256; i += NTHREADS) { const int v = i >> 8, c4 = (i & 255) * 4; const int cl = (v - 2) / 3, wh = (v - 2) % 3;
          const float* s = v == 0 ? g3 : v == 1 ? g0 : wh == 0 ? mod + cl * 6144 + 5 * 1024 : mod1 + cl * 6144 + (wh - 1) * 1024;
          *(LAS f32x4*)(LG + v * 1024 + c4) = *(const f32x4*)(s + c4); } }
    int bsl; { const int e = lane & 31; const int cnt = (int)X.ctl[CW_CNT + l * 32 + e]; const int nb = (cnt + 255) >> 8; int inc = nb;
#pragma unroll
        for (int o = 1; o < 32; o <<= 1) { const int v = __shfl_up(inc, o); if ((lane & 31) >= o) inc += v; }
        bsl = inc - nb; }
    __syncthreads();
    const int ST = NGW * 2;
    int r0 = gw * 2; int ivc = 0, ivn = 0; float gtc = 0.f, gtn = 0.f;
    if (r0 < NTOK && lane < 8) { ivc = INV[r0 * 4 + lane]; gtc = GATE[r0 * 4 + lane]; }
    if (r0 + ST < NTOK && lane < 8) { ivn = INV[(r0 + ST) * 4 + lane]; gtn = GATE[(r0 + ST) * 4 + lane]; }
    unsigned yb[2][4][4], ybn[2][4][4]; u32x2 xr[2][4], xrn[2][4];
#define ROWC_GATHER(dst, dstx, ivw, rr) do { _Pragma("unroll") for (int q = 0; q < 2; ++q) { _Pragma("unroll") for (int k = 0; k < 4; ++k) { const int iv = __shfl(ivw, q * 4 + k); const int e = iv >> 20, pos = iv & 0xfffff; \
        const size_t dest = (size_t)__shfl(bsl, e) * 256 + pos; _Pragma("unroll") for (int j = 0; j < 4; ++j) dst[q][k][j] = *(const unsigned*)(YB + dest * D + 4 * lane + 256 * j); } \
        _Pragma("unroll") for (int j = 0; j < 4; ++j) dstx[q][j] = *(const u32x2*)(XS + (size_t)((rr) + q) * D + 4 * lane + 256 * j); } } while (0)
    if (r0 < NTOK) ROWC_GATHER(yb, xr, ivc, r0);
    for (; r0 < NTOK; r0 += ST) {
        int iv2 = 0; float gt2 = 0.f;
        if (r0 + ST < NTOK) ROWC_GATHER(ybn, xrn, ivn, r0 + ST);
        if (r0 + 2 * ST < NTOK && lane < 8) { iv2 = INV[(r0 + 2 * ST) * 4 + lane]; gt2 = GATE[(r0 + 2 * ST) * 4 + lane]; }
        f32x4 y[2][4], xv[2][4]; float gk[2][4];
#pragma unroll
        for (int q = 0; q < 2; ++q)
#pragma unroll
            for (int k = 0; k < 4; ++k) gk[q][k] = __shfl(gtc, q * 4 + k);
#pragma unroll
        for (int q = 0; q < 2; ++q)
#pragma unroll
            for (int j = 0; j < 4; ++j) { const u32x2 w = xr[q][j]; xv[q][j] = (f32x4){blo(w.x), bhi(w.x), blo(w.y), bhi(w.y)}; }
#pragma unroll
        for (int q = 0; q < 2; ++q) {
#pragma unroll
            for (int j = 0; j < 4; ++j) { y[q][j] = (f32x4){0.f, 0.f, 0.f, 0.f};
#pragma unroll
                for (int k = 0; k < 4; ++k) { const unsigned w = yb[q][k][j]; const f32x2 lo = __builtin_amdgcn_cvt_pk_f32_fp8(w, false), hi = __builtin_amdgcn_cvt_pk_f32_fp8(w, true); const float gq = gk[q][k] * (1.0f / 16.0f);
                    y[q][j][0] += gq * lo.x; y[q][j][1] += gq * lo.y; y[q][j][2] += gq * hi.x; y[q][j][3] += gq * hi.y; } } }
#pragma unroll
        for (int q = 0; q < 2; ++q) { const int r = r0 + q; const LAS float* m = LG + 2048 + mod_sel(r) * 3072;
            float ss = 0.f;
#pragma unroll
            for (int j = 0; j < 4; ++j) ss += y[q][j][0] * y[q][j][0] + y[q][j][1] * y[q][j][1] + y[q][j][2] * y[q][j][2] + y[q][j][3] * y[q][j][3];
            const float rstd = rsqrtf(wave_sum(ss) * (1.0f / D) + EPS); float ss2 = 0.f;
#pragma unroll
            for (int j = 0; j < 4; ++j) { const int c = 4 * lane + 256 * j; const f32x4 gg = *(const LAS f32x4*)(LG + c), m5 = *(const LAS f32x4*)(m + c);
#pragma unroll
                for (int e = 0; e < 4; ++e) { xv[q][j][e] += m5[e] * (y[q][j][e] * rstd * gg[e]); ss2 += xv[q][j][e] * xv[q][j][e]; } }
            if (l == 0) {
                const float rstd2 = rsqrtf(wave_sum(ss2) * (1.0f / D) + EPS);
#pragma unroll
                for (int j = 0; j < 4; ++j) { const int c = 4 * lane + 256 * j; st_xrow(XSW, r, c, xv[q][j]);
                    const f32x4 gg = *(const LAS f32x4*)(LG + 1024 + c), sh = *(const LAS f32x4*)(m + 1024 + c), sc = *(const LAS f32x4*)(m + 2048 + c); f32x4 o;
#pragma unroll
                    for (int e = 0; e < 4; ++e) o[e] = xv[q][j][e] * rstd2 * gg[e] * (1.0f + sc[e]) + sh[e];
                    u32x2 w; w.x = cvt_pk_bf16(o[0], o[1]); w.y = cvt_pk_bf16(o[2], o[3]); *(u32x2*)(HW + (size_t)r * D + c) = w; }
            } else if (r < NLAT) {
#pragma unroll
                for (int j = 0; j < 4; ++j) *(f32x4*)(POUT + (size_t)r * D + 4 * lane + 256 * j) = xv[q][j];
            }
        }
#pragma unroll
        for (int q = 0; q < 2; ++q) {
#pragma unroll
            for (int k = 0; k < 4; ++k)
#pragma unroll
                for (int j = 0; j < 4; ++j) yb[q][k][j] = ybn[q][k][j];
#pragma unroll
            for (int j = 0; j < 4; ++j) xr[q][j] = xrn[q][j]; }
        ivc = ivn; gtc = gtn; ivn = iv2; gtn = gt2;
    }
#undef ROWC_GATHER
    __syncthreads();
}

#define XB_TMO      128
#define XB_XCNT(j)  (256  + 64 * (j))
#define XB_XSUB(j)  (1280 + 64 * (j))
#define XB_XGEN(j)  (2304 + 64 * (j))
#define XB_TOP      3328
#define XB_TOPGEN   3392
#define XB_SPIN_CAP (1u << 22)
DEV unsigned xb_ld(unsigned* p)              { return __hip_atomic_load(p, __ATOMIC_RELAXED, __HIP_MEMORY_SCOPE_AGENT); }
DEV unsigned xb_add(unsigned* p, unsigned v) { return __hip_atomic_fetch_add(p, v, __ATOMIC_RELAXED, __HIP_MEMORY_SCOPE_AGENT); }
DEV unsigned xb_xcc_id() { return (unsigned)__builtin_amdgcn_s_getreg((3 << 11) | 20) & 0xFu; }
#define XB_SPIN(cond, bar) do { unsigned _sp = 0; while (cond) { __builtin_amdgcn_s_sleep(1); \
    if ((++_sp & 255u) == 0u) { if (xb_ld(&(bar)[XB_TMO])) break; if (_sp > XB_SPIN_CAP) { atomicAdd(&(bar)[XB_TMO], 1u); break; } } } } while (0)
DEV void xcd_barrier_complete(unsigned* bar, unsigned x, unsigned& nloc, unsigned& nx) {
    const unsigned G = gridDim.x;
    unsigned sum, cnt, mine, sp = 0u;
    for (;;) {
        sum = 0u; cnt = 0u; mine = 0u;
#pragma unroll
        for (unsigned j = 0; j < 16; ++j) { const unsigned c = xb_ld(&bar[XB_XCNT(j)]); sum += c; cnt += (c > 0u) ? 1u : 0u; mine = (j == x) ? c : mine; }
        if (sum == G) break;
        __builtin_amdgcn_s_sleep(1);
        if ((++sp & 255u) == 0u) { if (xb_ld(&bar[XB_TMO])) break; if (sp > XB_SPIN_CAP) { atomicAdd(&bar[XB_TMO], 1u); break; } }
    }
    nloc = mine > 0u ? mine : 1u; nx = cnt > 0u ? cnt : 1u;
}
DEV void xcd_barrier(unsigned* bar, unsigned x, volatile LAS unsigned* st, int tid) {
    asm volatile("" : "+s"(bar), "+s"(x));
    asm volatile("s_waitcnt vmcnt(0)" ::: "memory");
    __syncthreads();
    if (tid == 0) {
        __builtin_amdgcn_s_waitcnt(0);
        unsigned nloc = st[0], nx = st[1];
        if (nloc == 0u) { xcd_barrier_complete(bar, x, nloc, nx); st[0] = nloc; st[1] = nx; }
        const unsigned old = xb_add(&bar[XB_XSUB(x)], 1u);
        const unsigned gen = old / nloc;
        if (old + 1u == (gen + 1u) * nloc) {
            __builtin_amdgcn_fence(__ATOMIC_RELEASE, "agent");
            asm volatile("s_waitcnt vmcnt(0)" ::: "memory");
            const unsigned og = xb_add(&bar[XB_TOP], 1u);
            const unsigned tg = og / nx;
            if (og + 1u == (tg + 1u) * nx) xb_add(&bar[XB_TOPGEN], 1u);
            else XB_SPIN(xb_ld(&bar[XB_TOPGEN]) == tg, bar);
            __builtin_amdgcn_fence(__ATOMIC_ACQUIRE, "agent");
            xb_add(&bar[XB_XGEN(x)], 1u);
            asm volatile("s_waitcnt vmcnt(0)" ::: "memory");
        } else {
            XB_SPIN(xb_ld(&bar[XB_XGEN(x)]) == gen, bar);
            __builtin_amdgcn_fence(__ATOMIC_ACQUIRE, "agent");
            asm volatile("s_waitcnt vmcnt(0)" ::: "memory");
        }
    }
    __syncthreads();
}

DEV void relaunder(Ctx& X, int wave0, unsigned char* wsp) {
    int wv_ = wave0; asm volatile("" : "+s"(wv_)); int t_ = (wv_ << 6) | lane_fresh(); asm volatile("" : "+v"(t_)); X.tid = t_; X.lane = t_ & 63; X.wave = wv_;
    int g_ = gridDim.x, b_ = blockIdx.x; asm volatile("" : "+s"(g_), "+s"(b_)); X.G = g_; X.bid = b_;
    GAS unsigned char* w_ = (GAS unsigned char*)wsp; asm volatile("" : "+s"(w_)); X.ws = (unsigned char*)w_; X.ctl = (unsigned*)(X.ws + WS_CTL);
}

__global__ void __launch_bounds__(NTHREADS, 2) mega_fwd(Params P_) {
    extern __shared__ __attribute__((aligned(16))) unsigned char lds_raw[];
    const int wave0_ = rfl((int)threadIdx.x >> 6);
    Ctx X; X.lds = (LAS unsigned char*)lds_raw; X.tid = 0; X.lane = 0; X.wave = 0; X.G = gridDim.x; X.bid = blockIdx.x;
    X.ws = P_.ws; X.ctl = (unsigned*)(P_.ws + WS_CTL);
    cg::grid_group grid = cg::this_grid();
    unsigned* xbar = (unsigned*)(P_.ws + WS_CTL) + CW_BAR;
    volatile LAS unsigned* xst = (volatile LAS unsigned*)(X.lds + LDS_XST);
    const unsigned xcc = xb_xcc_id();
    { const int t0_ = (wave0_ << 6) | lane_fresh();
      if (t0_ < 2) xst[t0_] = 0u;
      if (t0_ == 0) (void)xb_add(&xbar[XB_XCNT(xcc)], 1u);
      __syncthreads(); }
    const int lo = P_.ph_lo, hi = P_.ph_hi;
    int ph = 0;
#ifdef DBG_ONLY
#define DBGSEL(k) if (DBG_ONLY == (k))
#else
#define DBGSEL(k)
#endif
#ifdef DBG_SUB
#define DSUB(k) if (DBG_SUB == (k))
#else
#define DSUB(k)
#endif
#define PH_BEGIN if (lo <= ph && ph < hi) { KParams* pp_ = (KParams*)__builtin_amdgcn_kernarg_segment_ptr(); asm volatile("" : "+s"(pp_)); KParams& P = *pp_; relaunder(X, wave0_, P.ws); ws = X.ws;
#ifndef PROBE_DUP
#define PROBE_DUP 0
#endif
#define REP(bit) for (int rep = 0; rep < (((PROBE_DUP) & (bit)) ? 2 : 1); ++rep) if (relaunder(X, wave0_, P.ws), true)
#define PH_END   if (ph + 1 < hi) { if (lo < 0) grid.sync();   xcd_barrier(xbar, xcc, xst, X.tid); if ((PROBE_DUP) & 512) xcd_barrier(xbar, xcc, xst, X.tid); } } ++ph;
    unsigned char* ws = P_.ws;
    PH_BEGIN DBGSEL(0) REP(1) { p0_prologue(P, X); __syncthreads(); } PH_END
    for (int l = 0; l < 2; ++l) {
        if (l == 0) { PH_BEGIN DBGSEL(1) REP(256) phase_rowA(P, X, 0); PH_END }
        PH_BEGIN DBGSEL(2) { g8::JobInProj J{(const bf16_t*)(ws + WS_H), (const bf16_t*)(ws + WS_WIN) + (size_t)l * 2304 * 1024, (bf16_t*)(ws + WS_IN7), (bf16_t*)(ws + WS_AX), (bf16_t*)(ws + WS_VT), (const LAS unsigned*)(X.lds + LDS_MISC), (const LAS unsigned*)(X.lds + LDS_MISC + 12288), X.G, X.bid};
                   { const f32x2* RT = (const f32x2*)(ws + WS_ROPE); LAS unsigned* TC = (LAS unsigned*)(X.lds + LDS_MISC); LAS unsigned* TR = (LAS unsigned*)(X.lds + LDS_MISC + 12288);
                     for (int i = X.tid; i < 320 * 16; i += NTHREADS) { const int k = i < 1024 ? i : i - 1024; const f32x2 cs = RT[k];
                         const unsigned pk = (unsigned)__builtin_bit_cast(unsigned short, (_Float16)cs.x) | ((unsigned)__builtin_bit_cast(unsigned short, (_Float16)cs.y) << 16);
                         if (i < 1024) TC[k] = pk; else TR[k] = pk; }
                     __syncthreads(); }
                   { const int full = (1170 / X.G) * X.G; if (full >= 910) J.hi = full; }
                   REP(2) g8::gemm_phase(X.lds, J, X.tid); } PH_END
        PH_BEGIN DBGSEL(3) { g8::JobS5<256> J{(const bf16_t*)(ws + WS_AX), (const bf16_t*)(ws + WS_S5B1) + (size_t)l * 16 * 256 * 256, (float*)(ws + WS_SL), nullptr, X.G, X.bid};
                   REP(4) { DSUB(1) g8::gemm_phase(X.lds, J, X.tid);
                            { const int full = (1170 / X.G) * X.G; const int j = X.G - 1 - X.bid;
                              if (full >= 910 && j < 1170 - full) { g8::JobInProj JV{(const bf16_t*)(ws + WS_H), (const bf16_t*)(ws + WS_WIN) + (size_t)l * 2304 * 1024, (bf16_t*)(ws + WS_IN7), (bf16_t*)(ws + WS_AX), (bf16_t*)(ws + WS_VT), nullptr, nullptr, 1 << 20, j, full, 1170};
                                  g8::gemm_phase(X.lds, JV, X.tid); relaunder(X, wave0_, P.ws); } }
                            DSUB(2) phase_lru(P, X, l, 1, (l * 2 + 0) * 2 + rep); } } PH_END
        PH_BEGIN DBGSEL(4) REP(8) phase_mix2(P, X, l, l * 2 + rep); PH_END
        PH_BEGIN DBGSEL(5) { g8::JobS5<512> J{(const bf16_t*)(ws + WS_AX), (const bf16_t*)(ws + WS_S5B2) + (size_t)l * 16 * 256 * 512, nullptr, (bf16_t*)(ws + WS_Z), X.G, X.bid};
                   g8::gemm_phase(X.lds, J, X.tid);
                   unsigned* dep = X.ctl + 9216 + 64 * (l * 9);
                   if (X.bid < 144 && X.tid == 0) { __builtin_amdgcn_fence(__ATOMIC_RELEASE, "agent"); asm volatile("s_waitcnt vmcnt(0)" ::: "memory");
                       __hip_atomic_fetch_add(dep + 64 * (X.bid % 9), 1u, __ATOMIC_RELAXED, __HIP_MEMORY_SCOPE_AGENT); }
                   if (X.bid < 130) { int pm_, pn_; (void)g8::dense_unit(X.bid, 130, 1, pm_, pn_);
                       if (X.tid == 0) { unsigned sp = 0; while (__hip_atomic_load(dep + 64 * (pm_ >> 4), __ATOMIC_RELAXED, __HIP_MEMORY_SCOPE_AGENT) < 16u && ++sp < (1u << 22)) __builtin_amdgcn_s_sleep(2);
                           __builtin_amdgcn_fence(__ATOMIC_ACQUIRE, "agent"); asm volatile("s_waitcnt vmcnt(0)" ::: "memory"); }
                       __syncthreads();
                       g8::JobGlu JG{(const bf16_t*)(ws + WS_Z), (const bf16_t*)(ws + WS_WGLU) + (size_t)l * 256 * 256, PIN(25) + l * 256, (bf16_t*)(ws + WS_MIX), X.G, X.bid};
                       g8::gemm_phase(X.lds, JG, X.tid); }
                   phase_lru(P, X, l, 2, (l * 2 + 1) * 2); } PH_END
        PH_BEGIN DBGSEL(7) { g8::JobOut J{(const bf16_t*)(ws + WS_MIX), (const bf16_t*)(ws + WS_WOUT) + (size_t)l * 1024 * 1024, (bf16_t*)(ws + WS_MIXO), X.G, X.bid, l == 0 ? 130 : 128};
                   REP(32) g8::gemm_phase(X.lds, J, X.tid); } PH_END
        PH_BEGIN DBGSEL(8) phase_rowB(P, X, l); PH_END
        PH_BEGIN DBGSEL(9) { moe_table(X, l);
                   g8::JobGu J{ws + WS_H, ws + WS_WGU + (size_t)l * 32 * 2048 * 1024, PIN(30) + (size_t)l * 32 * 2048, (const int*)(ws + WS_LTOK), ws + WS_ACT,
                               (const volatile LAS int*)(X.lds + LDS_MISC), X.G, X.bid, X.lane};
                   REP(64) g8::gemm_phase(X.lds, J, X.tid); } PH_END
        PH_BEGIN DBGSEL(10) { moe_table(X, l);
                   g8::JobDown J{ws + WS_ACT, ws + WS_WDN + (size_t)l * 32 * 1024 * 1024, PIN(32) + (size_t)l * 32 * 1024, ws + WS_YB,
                                 (const volatile LAS int*)(X.lds + LDS_MISC), X.G, X.bid, X.lane};
                   REP(128) g8::gemm_phase(X.lds, J, X.tid); } PH_END
        PH_BEGIN DBGSEL(11) { if ((PROBE_DUP) & 2048) { phase_rowC(P, X, l, true); relaunder(X, wave0_, P.ws); } phase_rowC(P, X, l); } PH_END
    }
}
constexpr int N_PHASES = 20;

extern "C" void kernel_launch(void* const* d_in, const int* in_sizes, int n_in, void* d_out, int out_size, void* d_ws, size_t ws_size, hipStream_t stream) {
    static int grid = 0;
    if (grid == 0) {
        if (n_in != 33 || out_size != NLAT * D || ws_size < WS_END) { fprintf(stderr, "kernel_launch: unexpected shapes (n_in %d, out %d, ws %zu, need %zu)\n", n_in, out_size, ws_size, (size_t)WS_END); grid = -1; return; }
        int dev = 0, cus = 0, per_cu = 0;
        hipGetDevice(&dev); hipDeviceGetAttribute(&cus, hipDeviceAttributeMultiprocessorCount, dev);
        if (hipFuncSetAttribute((const void*)mega_fwd, hipFuncAttributeMaxDynamicSharedMemorySize, LDS_BYTES) != hipSuccess) { fprintf(stderr, "kernel_launch: hipFuncSetAttribute failed\n"); grid = -1; return; }
        hipOccupancyMaxActiveBlocksPerMultiprocessor(&per_cu, (const void*)mega_fwd, NTHREADS, LDS_BYTES);
        (void)hipGetLastError();
        if (per_cu < 1) { fprintf(stderr, "kernel_launch: occupancy query says %d blocks per CU\n", per_cu); }
        grid = cus;
        if (grid % 8 != 0) grid -= grid % 8;
    }
    if (grid < 0) return;
    hipMemsetAsync((char*)d_ws + WS_CTL, 0, CTL_BYTES, stream);
    Params p{};
    for (int i = 0; i < 33; ++i) p.in[i] = (const float*)d_in[i];
    p.out = (float*)d_out; p.ws = (unsigned char*)d_ws;
#if MK_PER_PHASE_LAUNCH
    for (int k = 0; k < N_PHASES; ++k) { p.ph_lo = k; p.ph_hi = k + 1; hipLaunchKernelGGL(mega_fwd, dim3(grid), dim3(NTHREADS), LDS_BYTES, stream, p); }
#else
    p.ph_lo = 0; p.ph_hi = N_PHASES;
    void* args[] = {&p};
    hipError_t e = hipLaunchCooperativeKernel((const void*)mega_fwd, dim3(grid), dim3(NTHREADS), args, LDS_BYTES, stream);
    if (e != hipSuccess) fprintf(stderr, "kernel_launch: cooperative launch failed: %s (grid %d)\n", hipGetErrorString(e), grid);
#endif
}
```

```cpp
#include <hip/hip_runtime.h>
#include <hip/hip_cooperative_groups.h>
#include <cstdio>
#include <cstdint>
namespace cg = cooperative_groups;

#ifndef MK_PER_PHASE_LAUNCH
#define MK_PER_PHASE_LAUNCH 0
#endif

#define DEV __device__ __forceinline__
#define LAS __attribute__((address_space(3)))
typedef unsigned short bf16_t;
typedef short bf16x8 __attribute__((ext_vector_type(8)));
typedef short s16x4 __attribute__((ext_vector_type(4)));
typedef float f32x4 __attribute__((ext_vector_type(4)));
typedef float f32x2 __attribute__((ext_vector_type(2)));
typedef unsigned u32x4 __attribute__((ext_vector_type(4)));
typedef unsigned u32x2 __attribute__((ext_vector_type(2)));

constexpr int D = 1024, SEQ = 16384, NLAT = 32768, CTXL = 256, NCTX = 512, NTOK = 33280;
constexpr int LD7 = 1792, COL_LU = 0, COL_LG = 256, COL_Q = 768, COL_K = 1280;
constexpr int NCHK = 2080, NCHKP = 2304;
constexpr int LCH = 520;
constexpr int NE = 32, NBMAX = 552, CAPROWS = NBMAX * 256;
constexpr float EPS = 1e-6f;
constexpr int NTHREADS = 512, NWAVES = 8;

constexpr size_t MiB = 1u << 20;
constexpr size_t al1(size_t x) { return (x + MiB - 1) & ~(MiB - 1); }
constexpr size_t WS_CTL = 0, CTL_BYTES = 64 * 1024;
constexpr size_t WS_MOD = 1 * MiB;
constexpr size_t WS_ROPE = WS_MOD + 256 * 1024;
constexpr size_t WS_LAM16 = WS_ROPE + 64 * 1024;
constexpr size_t WS_WRT = WS_LAM16 + 64 * 1024;
constexpr size_t WS_WLRU = WS_WRT + 128 * 1024;
constexpr size_t WS_WGLU = WS_WLRU + 256 * 1024;
constexpr size_t WS_S5B1 = 2 * MiB;
constexpr size_t WS_S5B2 = WS_S5B1 + 4 * MiB;
constexpr size_t WS_WIN = WS_S5B2 + 8 * MiB;
constexpr size_t WS_WOUT = WS_WIN + 9 * MiB;
constexpr size_t WS_WGU = WS_WOUT + 4 * MiB;
constexpr size_t WS_WDN = WS_WGU + 256 * MiB;
constexpr size_t WS_XS = WS_WDN + 128 * MiB;
constexpr size_t WS_H = WS_XS + al1((size_t)NTOK * D * 4);
constexpr size_t WS_IN7 = WS_H + al1((size_t)NTOK * D * 2);
constexpr size_t WS_VT = WS_IN7 + al1((size_t)NTOK * LD7 * 2);
constexpr size_t WS_AX = WS_VT + al1((size_t)512 * NTOK * 2);
constexpr size_t WS_SL = WS_AX + al1((size_t)16 * NCHKP * 512 * 2);
constexpr size_t WS_Z = WS_SL + al1((size_t)16 * NCHKP * 256 * 4);
constexpr size_t WS_MIX = WS_Z + al1((size_t)NTOK * 256 * 2);
constexpr size_t WS_MIXO = WS_MIX + al1((size_t)NTOK * D * 2);
constexpr size_t WS_LAGG = WS_MIXO + al1((size_t)NTOK * D * 2);
constexpr size_t WS_LCIN = WS_LAGG + al1((size_t)2 * LCH * 256 * 8);
constexpr size_t WS_LTOK = WS_LCIN + al1((size_t)2 * LCH * 256 * 4);
constexpr size_t WS_INV = WS_LTOK + al1((size_t)NE * NTOK * 4);
constexpr size_t WS_GATE = WS_INV + al1((size_t)NTOK * 16);
constexpr size_t WS_ACT = WS_GATE + al1((size_t)NTOK * 16);
constexpr size_t WS_YB = WS_ACT + al1((size_t)CAPROWS * D * 2);
constexpr size_t WS_END = WS_YB + al1((size_t)CAPROWS * D * 2);
constexpr int CW_CNT = 0;
constexpr int CW_WQ = 256;
constexpr int CW_BAR = 12288;

constexpr int LDS_STAGE = 131072, LDS_MISC = LDS_STAGE, LDS_BYTES = 163840, LDS_XST = 163776;

struct Params { const float* in[33]; float* out; unsigned char* ws; int ph_lo, ph_hi; };
#define GAS __attribute__((address_space(1)))
#define PIN(k) ((const float*)(const GAS float*)P.in[k])
#define POUT ((float*)(GAS float*)P.out)
typedef __attribute__((address_space(4))) const Params KParams;

DEV int rfl(int v) { return __builtin_amdgcn_readfirstlane(v); }
DEV int lane_fresh() { int t; asm volatile("v_mbcnt_lo_u32_b32 %0, -1, 0\n\tv_mbcnt_hi_u32_b32 %0, -1, %0" : "=v"(t)); return t; }
DEV float bf2f(unsigned v) { return __uint_as_float(v << 16); }
DEV unsigned cvt_pk_bf16(float lo, float hi) { unsigned r; asm("v_cvt_pk_bf16_f32 %0, %1, %2" : "=v"(r) : "v"(lo), "v"(hi)); return r; }
DEV float blo(unsigned w) { return __uint_as_float(w << 16); }
DEV float bhi(unsigned w) { return __uint_as_float(w & 0xffff0000u); }
DEV float wave_sum(float v) {
#pragma unroll
    for (int o = 1; o < 64; o <<= 1) v += __shfl_xor(v, o);
    return v;
}
DEV float sigmoidf_(float x) { return __builtin_amdgcn_rcpf(1.0f + __expf(-x)); }
DEV float gelu_tanh(float x) { const float u = 1.5957691216057308f * (x + 0.044715f * x * x * x); return x * __builtin_amdgcn_rcpf(1.0f + __expf(-u)); }
DEV float silu_(float x) { return x * __builtin_amdgcn_rcpf(1.0f + __expf(-x)); }
DEV void sincos_red(float ang, float& c, float& s) {
    const float k = rintf(ang * 0.15915494309189535f);
    float r = fmaf(-k, 6.2831854820251465f, ang);
    r = fmaf(-k, -1.7484555e-7f, r);
    c = __cosf(r); s = __sinf(r);
}
#define LDS_WAIT() asm volatile("s_waitcnt lgkmcnt(0)" ::: "memory")

namespace g8 {
constexpr int BM = 256, BK = 64, HALF = 128, HTB = HALF * BK * 2;
DEV void stage_rc(int b, int& R, int& C) { const int st = b / 1024, sb = b % 1024, swz = sb ^ (((sb >> 9) & 1) << 5); R = (st >> 1) * 16 + swz / 64; C = (st & 1) * 32 + (swz % 64) / 2; }
DEV int lds_byte(int r, int c) { const int st = (r >> 4) * 2 + (c >> 5), rr = r & 15, cc = c & 31, ob = rr * 64 + cc * 2; return st * 1024 + (ob ^ (((ob >> 9) & 1) << 5)); }
DEV int f8_swz(int r) { return ((r >> 1) & 1) | (((r >> 3) & 1) << 2); }
DEV void stage_rc_f8(int b, int& R, int& C) { R = b >> 7; C = (((b >> 4) & 7) ^ f8_swz(R & 15)) * 8; }
DEV int lds_byte_f8(int r, int piece) { return r * 128 + ((piece ^ f8_swz(r & 15)) << 4); }
DEV int perm32(int rho) { const int n = rho >> 4, i = rho & 15; return 8 * (i >> 2) + 4 * n + (i & 3); }

struct Unit { int pm, pn, e, x; };
typedef int v8i __attribute__((ext_vector_type(8)));
DEV v8i cat8(const bf16x8& a, const bf16x8& b) { typedef int v4i __attribute__((ext_vector_type(4))); const v4i x = __builtin_bit_cast(v4i, a), y = __builtin_bit_cast(v4i, b); return __builtin_shufflevector(x, y, 0, 1, 2, 3, 4, 5, 6, 7); }

template <class T, class = void> struct NtOf { static constexpr int v = T::K / 64; };
template <class T> struct NtOf<T, decltype((void)T::NT)> { static constexpr int v = T::NT; };
template <class T, class = void> struct PreOf { static constexpr bool v = false; static constexpr int nst = 0; };
template <class T> struct PreOf<T, decltype((void)T::NST)> { static constexpr bool v = true; static constexpr int nst = T::NST; };
constexpr int PRE_LTOK = 12288, PRE_BIAS = 13312;
template <class T>
DEV void gemm_phase(LAS unsigned char* lds, const T& tr, int tid) {
    const int wid = rfl(tid >> 6), lane = tid & 63, wr = wid >> 2, wc = wid & 3, fr = lane & 15, fq = lane >> 4;
    constexpr int K = T::K, nt = NtOf<T>::v;
    unsigned voffB[2];
#pragma unroll
    for (int i = 0; i < 2; ++i) { int R_, C_; if constexpr (T::FP8) stage_rc_f8(tid * 16 + i * 8192, R_, C_); else stage_rc(tid * 16 + i * 8192, R_, C_); const int Rb = (R_ & ~31) + perm32(R_ & 31); voffB[i] = (unsigned)(Rb * K + C_) * 2u; }
    const size_t hstepB = (size_t)HALF * K * 2;
    const unsigned ldsw = (unsigned)wid * 1024u;
    constexpr bool F8 = T::FP8; constexpr int KOFF = F8 ? 16 : 1024;
    const int aoff = F8 ? lds_byte_f8(wr * 64 + fr, 2 * fq) : lds_byte(wr * 64 + fr, fq * 8), boff = F8 ? lds_byte_f8(wc * 32 + fr, 2 * fq) : lds_byte(wc * 32 + fr, fq * 8);
    const int aoff1 = aoff ^ 16, boff1 = boff ^ 16;
#define G8_SA(b, h) (((b) * 2 + (h)) * HTB)
#define G8_SB(b, h) ((4 + (b) * 2 + (h)) * HTB)
#define G8_STAGE(bufoff, gbase, voff) do { _Pragma("unroll") for (int _i = 0; _i < 2; ++_i) \
        __builtin_amdgcn_global_load_lds((const unsigned*)((const char*)(gbase) + (voff)[_i]), (LAS unsigned*)(lds + (bufoff) + ldsw + _i * 8192), 16, 0, 0); } while (0)
#define G8_LDA(dst, b, h) do { if constexpr (F8) { _Pragma("unroll") for (int m = 0; m < 4; ++m) { dst##8[m].lo = *(const LAS v4i*)(lds + G8_SA(b, h) + aoff + m * 2048); dst##8[m].hi = *(const LAS v4i*)(lds + G8_SA(b, h) + aoff1 + m * 2048); } } \
        else { _Pragma("unroll") for (int m = 0; m < 4; ++m) _Pragma("unroll") for (int k = 0; k < 2; ++k) dst[m][k] = *(const LAS bf16x8*)(lds + G8_SA(b, h) + aoff + m * 2048 + k * KOFF); } } while (0)
#define G8_LDB(dst, b, h) do { if constexpr (F8) { _Pragma("unroll") for (int n = 0; n < 2; ++n) { dst##8[n].lo = *(const LAS v4i*)(lds + G8_SB(b, h) + boff + n * 2048); dst##8[n].hi = *(const LAS v4i*)(lds + G8_SB(b, h) + boff1 + n * 2048); } } \
        else { _Pragma("unroll") for (int n = 0; n < 2; ++n) _Pragma("unroll") for (int k = 0; k < 2; ++k) dst[n][k] = *(const LAS bf16x8*)(lds + G8_SB(b, h) + boff + n * 2048 + k * KOFF); } } while (0)
#define G8_MMA(ai, bj, At, Bt) do { __builtin_amdgcn_s_setprio(1); _Pragma("unroll") for (int m = 0; m < 4; ++m) _Pragma("unroll") for (int n = 0; n < 2; ++n) { \
        if constexpr (F8) asm volatile("v_mfma_scale_f32_16x16x128_f8f6f4 %0, %1, %2, %0, %3, %3 op_sel_hi:[0,0,0]" : "+v"(acc[ai][bj][m][n]) : "v"(Bt##8[n]), "v"(At##8[m]), "v"(sc1)); \
        else { _Pragma("unroll") for (int k = 0; k < 2; ++k) acc[ai][bj][m][n] = __builtin_amdgcn_mfma_f32_16x16x32_bf16(Bt[n][k], At[m][k], acc[ai][bj][m][n], 0, 0, 0); } } __builtin_amdgcn_s_setprio(0); } while (0)
#define G8_WAIT_V(n) asm volatile("s_waitcnt vmcnt(" #n ")" ::: "memory")
#define G8_WAIT_L(n) asm volatile("s_waitcnt lgkmcnt(" #n ")" ::: "memory")
#define G8_BAR __builtin_amdgcn_s_barrier()
#define G8_SCHED __builtin_amdgcn_sched_barrier(0)
    Unit cur, nxt; int ui = 0;
    if (!tr.unit(0, cur)) return;
    f32x4 acc[2][2][4][2];
#pragma unroll
    for (int a = 0; a < 2; ++a)
#pragma unroll
        for (int b = 0; b < 2; ++b)
#pragma unroll
            for (int m = 0; m < 4; ++m)
#pragma unroll
                for (int n = 0; n < 2; ++n) acc[a][b][m][n] = (f32x4){0.f, 0.f, 0.f, 0.f};
    typedef int v4i __attribute__((ext_vector_type(4)));
    const int sc1 = 0x7f7f7f7f;
    bf16x8 At[F8 ? 1 : 4][2], B0[F8 ? 1 : 2][2], B1[F8 ? 1 : 2][2];
    v8i At8[F8 ? 4 : 1], B08[F8 ? 2 : 1], B18[F8 ? 2 : 1];
    unsigned ca0[2], ca1[2];
    constexpr bool PRE = PreOf<T>::v; constexpr int NST = PreOf<T>::nst;
#define G8_PRE(u, par) do { if constexpr (PRE) __builtin_amdgcn_global_load_lds(tr.pre_src(u, wid, lane), (LAS unsigned*)(lds + LDS_MISC + tr.pre_dst(wid, par)), 4, 0, 0); } while (0)
#define G8_WAIT_VN(n) asm volatile("s_waitcnt vmcnt(%0)" :: "n"(n) : "memory")
    { int tl_ = tid; asm volatile("" : "+v"(tl_)); int Rr[2], Cc[2]; if constexpr (T::FP8) { stage_rc_f8(tl_ * 16, Rr[0], Cc[0]); stage_rc_f8(tl_ * 16 + 8192, Rr[1], Cc[1]); } else { stage_rc(tl_ * 16, Rr[0], Cc[0]); stage_rc(tl_ * 16 + 8192, Rr[1], Cc[1]); } tr.aoffs(cur, Rr, Cc, ca0, ca1); }
    const char* cAb = tr.abase(cur); const char* cB = tr.bptr(cur);
    G8_PRE(cur, 0);
    G8_STAGE(G8_SB(0, 0), cB, voffB); G8_STAGE(G8_SB(0, 1), cB + hstepB, voffB); G8_STAGE(G8_SA(0, 0), cAb, ca0); G8_STAGE(G8_SA(0, 1), cAb, ca1);
    if (wr == 1) G8_BAR;
    G8_WAIT_V(2); G8_BAR;
    G8_STAGE(G8_SB(1, 0), cB + 128, voffB); G8_STAGE(G8_SA(1, 0), cAb + 128, ca0); G8_STAGE(G8_SB(1, 1), cB + hstepB + 128, voffB);
    G8_WAIT_V(6); G8_BAR;
    for (;;) {
        const bool has_next = tr.unit(ui + 1, nxt);
        const char* nAb = cAb; const char* nB = cB;
        if constexpr (PRE) { if (has_next) { nAb = tr.abase(nxt); nB = tr.bptr(nxt); G8_PRE(nxt, (ui + 1) & 1); } else G8_PRE(cur, (ui + 1) & 1); }
        else {
            unsigned na0[2], na1[2];
            if (has_next) { int tl_ = tid; asm volatile("" : "+v"(tl_)); int Rr[2], Cc[2]; if constexpr (T::FP8) { stage_rc_f8(tl_ * 16, Rr[0], Cc[0]); stage_rc_f8(tl_ * 16 + 8192, Rr[1], Cc[1]); } else { stage_rc(tl_ * 16, Rr[0], Cc[0]); stage_rc(tl_ * 16 + 8192, Rr[1], Cc[1]); } tr.aoffs(nxt, Rr, Cc, na0, na1); nAb = tr.abase(nxt); nB = tr.bptr(nxt); }
            else { na0[0] = ca0[0]; na0[1] = ca0[1]; na1[0] = ca1[0]; na1[1] = ca1[1]; }
            *(LAS u32x4*)(lds + LDS_MISC + 4096 + tid * 16) = (u32x4){na0[0], na0[1], na1[0], na1[1]};
        }
#pragma unroll 1
        for (int t = 0; t < nt; t += 2) {
            const bool last = (t == nt - 2);
            const bool relax = PRE && t == 0;
            const char* a1 = cAb + (size_t)(t + 1) * 128;
            const char* a2 = last ? nAb : cAb + (size_t)(t + 2) * 128; const char* b2 = last ? nB : cB + (size_t)(t + 2) * 128;
            const char* a3 = a2 + 128; const char* b3 = b2 + 128;
            G8_LDB(B0, 0, 0); G8_LDB(B1, 0, 1); G8_SCHED; G8_LDA(At, 0, 0); G8_STAGE(G8_SA(1, 1), a1, ca1);
            if (last) {
                if constexpr (PRE) { if (has_next) { int tl_ = tid; asm volatile("" : "+v"(tl_)); int Rr[2], Cc[2]; stage_rc_f8(tl_ * 16, Rr[0], Cc[0]); stage_rc_f8(tl_ * 16 + 8192, Rr[1], Cc[1]); tr.aoffs_lds(nxt, Rr, Cc, ca0, ca1, lds + LDS_MISC + PRE_LTOK); } }
                else { const u32x4 nx = *(const LAS u32x4*)(lds + LDS_MISC + 4096 + tid * 16); ca0[0] = nx.x; ca0[1] = nx.y; ca1[0] = nx.z; ca1[1] = nx.w; } }
            if (relax) { if (ui > 0) G8_WAIT_VN(9 + NST); else G8_WAIT_VN(9); } else G8_WAIT_V(8);
            G8_WAIT_L(0); G8_BAR; G8_MMA(0, 0, At, B0); G8_MMA(0, 1, At, B1); G8_BAR; G8_SCHED;
            G8_LDA(At, 0, 1); G8_STAGE(G8_SB(0, 0), b2, voffB); G8_STAGE(G8_SB(0, 1), b2 + hstepB, voffB); G8_STAGE(G8_SA(0, 0), a2, ca0);
            if (relax) { if (ui > 0) G8_WAIT_VN(9 + NST); else G8_WAIT_VN(9); } else G8_WAIT_V(8);
            G8_WAIT_L(0); G8_BAR; G8_MMA(1, 0, At, B0); G8_MMA(1, 1, At, B1); G8_BAR; G8_SCHED;
            G8_LDB(B0, 1, 0); G8_LDB(B1, 1, 1); G8_SCHED; G8_LDA(At, 1, 0); G8_STAGE(G8_SA(0, 1), a2, ca1);
            G8_WAIT_V(8); G8_WAIT_L(0); G8_BAR; G8_MMA(0, 0, At, B0); G8_MMA(0, 1, At, B1); G8_BAR; G8_SCHED;
            G8_LDA(At, 1, 1); G8_STAGE(G8_SB(1, 0), b3, voffB); G8_STAGE(G8_SB(1, 1), b3 + hstepB, voffB); G8_STAGE(G8_SA(1, 0), a3, ca0);
            G8_WAIT_V(8); G8_WAIT_L(0); G8_BAR; G8_MMA(1, 0, At, B0); G8_MMA(1, 1, At, B1); G8_BAR; G8_SCHED;
        }
        if (wr == 0) G8_BAR;
        if constexpr (F8) asm volatile("s_nop 15\n\ts_nop 15" ::: "memory");
        if constexpr (PRE) tr.epi(acc, cur, wr, wc, fr, fq, (const LAS float*)(lds + LDS_MISC + PRE_BIAS + (ui & 1) * 1024)); else tr.epi(acc, cur, wr, wc, fr, fq);
        if (!has_next) break;
#pragma unroll
        for (int a = 0; a < 2; ++a)
#pragma unroll
            for (int b = 0; b < 2; ++b)
#pragma unroll
                for (int m = 0; m < 4; ++m)
#pragma unroll
                    for (int n = 0; n < 2; ++n) acc[a][b][m][n] = (f32x4){0.f, 0.f, 0.f, 0.f};
        cur = nxt; cAb = nAb; cB = nB; ++ui;
        if (wr == 1) G8_BAR;
    }
    G8_WAIT_V(0);
    G8_BAR;
#undef G8_PRE
#undef G8_WAIT_VN
#undef G8_SA
#undef G8_SB
#undef G8_STAGE
#undef G8_LDA
#undef G8_LDB
#undef G8_MMA
#undef G8_WAIT_V
#undef G8_WAIT_L
#undef G8_BAR
#undef G8_SCHED
}

DEV bool dense_unit(int L, int nM, int nN, int& pm, int& pn) {
    const int nwg = nM * nN; if (L >= nwg) return false;
    int wgid = L; { const int q = nwg / 8, r = nwg % 8, xcd = wgid % 8, off = wgid / 8; wgid = (xcd < r ? xcd * (q + 1) : r * (q + 1) + (xcd - r) * q) + off; }
    const int nig = 8 * nN, gid = wgid / nig, fm = gid * 8, gsz = (nM - fm) < 8 ? (nM - fm) : 8;
    pm = fm + ((wgid % nig) % gsz); pn = (wgid % nig) / gsz; return true;
}
DEV void dense_aoffs(int pm, int lda, const int (&R)[2], const int (&C)[2], unsigned (&a0)[2], unsigned (&a1)[2]) {
#pragma unroll
    for (int i = 0; i < 2; ++i) { a0[i] = (unsigned)((pm * 256 + R[i]) * lda + C[i]) * 2u; a1[i] = (unsigned)((pm * 256 + 128 + R[i]) * lda + C[i]) * 2u; }
}
DEV unsigned pk_fp8x4(float a, float b, float c, float d) {
    a = fminf(fmaxf(a, -448.f), 448.f); b = fminf(fmaxf(b, -448.f), 448.f); c = fminf(fmaxf(c, -448.f), 448.f); d = fminf(fmaxf(d, -448.f), 448.f);
    unsigned w = 0; w = __builtin_amdgcn_cvt_pk_fp8_f32(a, b, w, false); w = __builtin_amdgcn_cvt_pk_fp8_f32(c, d, w, true); return w; }
DEV unsigned pk_fp8x4_nc(float a, float b, float c, float d) { unsigned w = 0; w = __builtin_amdgcn_cvt_pk_fp8_f32(a, b, w, false); w = __builtin_amdgcn_cvt_pk_fp8_f32(c, d, w, true); return w; }
DEV u32x4 pack8(const f32x4& v0, const f32x4& v1) { u32x4 w; w.x = cvt_pk_bf16(v0[0], v0[1]); w.y = cvt_pk_bf16(v0[2], v0[3]); w.z = cvt_pk_bf16(v1[0], v1[1]); w.w = cvt_pk_bf16(v1[2], v1[3]); return w; }

struct JobInProj {
    static constexpr int K = 1024; static constexpr bool FP8 = false;
    const bf16_t* H; const bf16_t* Win; bf16_t* IN7; bf16_t* AX; bf16_t* VT; const LAS unsigned* TC; const LAS unsigned* TR; int G, c;
    int lo = 0, hi = 1170;
    DEV bool unit(int i, Unit& u) const {
        const int L = lo + i * G + c;
        if (L >= hi) return false;
        if (L < 910) { u.x = 0; return dense_unit(L, 130, 7, u.pm, u.pn); }
        u.x = 1; return dense_unit(L - 910, 2, 130, u.pm, u.pn);
    }
    DEV void aoffs(const Unit& u, const int (&R)[2], const int (&C)[2], unsigned (&a0)[2], unsigned (&a1)[2]) const { dense_aoffs(u.pm, 1024, R, C, a0, a1); }
    DEV const char* abase(const Unit& u) const { return u.x ? (const char*)(Win + (size_t)1792 * 1024) : (const char*)H; }
    DEV const char* bptr(const Unit& u) const { return u.x ? (const char*)(H + (size_t)u.pn * 256 * 1024) : (const char*)(Win + (size_t)u.pn * 256 * 1024); }
    DEV void epi(const f32x4 (&acc)[2][2][4][2], const Unit& u, int wr, int wc, int fr, int fq) const {
        const bool isq = !u.x && (u.pn == 3 || u.pn == 4);
        const bool rope = !u.x && u.pn >= 3 && u.pm < 128;
#pragma unroll
        for (int ai = 0; ai < 2; ++ai)
#pragma unroll
            for (int m = 0; m < 4; ++m) {
                const int row = u.pm * 256 + ai * 128 + wr * 64 + m * 16 + fr;
                u32x4 csp[2];
                if (rope) { const int tl = row & (SEQ - 1); const LAS unsigned* t = ((wc & 1) ? TC + (tl & 63) * 16 : TR + (tl >> 6) * 16) + 8 * (fq & 1);
                    csp[0] = *(const LAS u32x4*)t; csp[1] = *(const LAS u32x4*)(t + 4); }
#pragma unroll
                for (int bj = 0; bj < 2; ++bj) {
                    const int cl = bj * 128 + wc * 32 + 8 * fq;
                    f32x4 v0 = acc[ai][bj][m][0], v1 = acc[ai][bj][m][1];
                    unsigned char* qdst = (unsigned char*)(IN7 + (size_t)row * LD7 + COL_Q + (u.pn - 3) * 256 + bj * 128 + (wc >> 1) * 64) + fq * 32 + (wc & 1) * 8;
                    if (isq) { u32x2 w8; w8.x = pk_fp8x4(v0[0], v0[1], v0[2], v0[3]); w8.y = pk_fp8x4(v1[0], v1[1], v1[2], v1[3]); *(u32x2*)qdst = w8; }
                    if (rope) {
#pragma unroll
                        for (int n = 0; n < 2; ++n) { f32x4& v = n ? v1 : v0; const u32x4 cp = csp[n]; const unsigned cw[4] = {cp.x, cp.y, cp.z, cp.w}; float c[4], s[4];
#pragma unroll
                            for (int j = 0; j < 4; ++j) { c[j] = (float)__builtin_bit_cast(_Float16, (unsigned short)(cw[j] & 0xffffu)); s[j] = (float)__builtin_bit_cast(_Float16, (unsigned short)(cw[j] >> 16)); }
#pragma unroll
                            for (int j = 0; j < 4; ++j) { const float pv = __shfl_xor(v[j], 32); v[j] = fq < 2 ? v[j] * c[j] - pv * s[j] : v[j] * c[j] + pv * s[j]; } } }
                    if (isq) { if (rope) { u32x2 w8; w8.x = pk_fp8x4(v0[0], v0[1], v0[2], v0[3]); w8.y = pk_fp8x4(v1[0], v1[1], v1[2], v1[3]); *(u32x2*)(qdst + 16) = w8; } continue; }
                    const u32x4 w = pack8(v0, v1);
                    bf16_t* dst;
                    if (u.x) dst = VT + ((size_t)((u.pn * 256 + cl) >> 3) * 512 + row) * 8;
                    else if (u.pn == 2) dst = AX + ((size_t)((cl >> 4) * NCHKP + (row >> 4)) * 512 + (row & 15) * 16 + (cl & 15));
                    else dst = IN7 + (size_t)row * LD7 + (u.pn < 2 ? u.pn * 256 : 768 + (u.pn - 3) * 256) + cl;
                    *(u32x4*)dst = w;
                }
            }
    }
};
template <int KK> struct JobS5 {
    static constexpr int K = KK; static constexpr bool FP8 = false;
    const bf16_t* AX; const bf16_t* Bt; float* SL; bf16_t* Z; int G, c;
    DEV bool unit(int i, Unit& u) const { const int L = i * G + c; if (L >= 144) return false; u.e = L / 9; u.pm = L % 9; u.pn = 0; u.x = 0; return true; }
    DEV void aoffs(const Unit& u, const int (&R)[2], const int (&C)[2], unsigned (&a0)[2], unsigned (&a1)[2]) const { dense_aoffs(u.pm, 512, R, C, a0, a1); }
    DEV const char* abase(const Unit& u) const { return (const char*)(AX + (size_t)u.e * NCHKP * 512); }
    DEV const char* bptr(const Unit& u) const { return (const char*)(Bt + (size_t)u.e * 256 * KK); }
    DEV void epi(const f32x4 (&acc)[2][2][4][2], const Unit& u, int wr, int wc, int fr, int fq) const {
#pragma unroll
        for (int ai = 0; ai < 2; ++ai)
#pragma unroll
            for (int m = 0; m < 4; ++m) {
                const int row = u.pm * 256 + ai * 128 + wr * 64 + m * 16 + fr;
#pragma unroll
                for (int bj = 0; bj < 2; ++bj) {
                    const int cl = bj * 128 + wc * 32 + 8 * fq;
                    if (KK == 256) {
                        float* dst = SL + ((size_t)(u.e * NCHKP + row) * 256 + cl);
                        *(f32x4*)dst = acc[ai][bj][m][0]; *(f32x4*)(dst + 4) = acc[ai][bj][m][1];
                    } else if (row < NCHK) {
                        f32x4 v0 = acc[ai][bj][m][0], v1 = acc[ai][bj][m][1];
#pragma unroll
                        for (int j = 0; j < 4; ++j) { v0[j] = gelu_tanh(v0[j]); v1[j] = gelu_tanh(v1[j]); }
                        bf16_t* dst = Z + ((size_t)(row * 16 + (cl >> 4)) * 256 + u.e * 16 + (cl & 15));
                        *(u32x4*)dst = pack8(v0, v1);
                    }
                }
            }
    }
};
struct JobGlu {
    static constexpr int K = 256; static constexpr bool FP8 = false;
    const bf16_t* Z; const bf16_t* Bt; const float* bias; bf16_t* MIX; int G, c;
    DEV bool unit(int i, Unit& u) const { u.x = 0; u.e = 0; return dense_unit(i * G + c, 130, 1, u.pm, u.pn); }
    DEV void aoffs(const Unit& u, const int (&R)[2], const int (&C)[2], unsigned (&a0)[2], unsigned (&a1)[2]) const { dense_aoffs(u.pm, 256, R, C, a0, a1); }
    DEV const char* abase(const Unit&) const { return (const char*)Z; }
    DEV const char* bptr(const Unit&) const { return (const char*)Bt; }
    DEV void epi(const f32x4 (&acc)[2][2][4][2], const Unit& u, int wr, int wc, int fr, int fq) const {
#pragma unroll
        for (int bj = 0; bj < 2; ++bj) {
            const int cl = bj * 128 + wc * 32 + 8 * fq;
            const f32x4 b0 = *(const f32x4*)(bias + cl), b1 = *(const f32x4*)(bias + cl + 4);
#pragma unroll
            for (int ai = 0; ai < 2; ++ai)
#pragma unroll
                for (int m = 0; m < 4; ++m) {
                    const int row = u.pm * 256 + ai * 128 + wr * 64 + m * 16 + fr;
                    const u32x4 zz = *(const u32x4*)(Z + (size_t)row * 256 + cl);
                    f32x4 v0 = acc[ai][bj][m][0] + b0, v1 = acc[ai][bj][m][1] + b1;
                    v0[0] = blo(zz.x) * sigmoidf_(v0[0]); v0[1] = bhi(zz.x) * sigmoidf_(v0[1]); v0[2] = blo(zz.y) * sigmoidf_(v0[2]); v0[3] = bhi(zz.y) * sigmoidf_(v0[3]);
                    v1[0] = blo(zz.z) * sigmoidf_(v1[0]); v1[1] = bhi(zz.z) * sigmoidf_(v1[1]); v1[2] = blo(zz.w) * sigmoidf_(v1[2]); v1[3] = bhi(zz.w) * sigmoidf_(v1[3]);
#ifdef DIAG_GLU_CONST
                    v0 = (f32x4){0.5f * blo(zz.x), 0.5f * bhi(zz.x), 0.5f * blo(zz.y), 0.5f * bhi(zz.y)}; v1 = (f32x4){0.5f * blo(zz.z), 0.5f * bhi(zz.z), 0.5f * blo(zz.w), 0.5f * bhi(zz.w)};
#endif
#ifdef DIAG_S5_ZERO
                    v0 = (f32x4){0.f, 0.f, 0.f, 0.f}; v1 = v0;
#endif
                    *(u32x4*)(MIX + (size_t)row * 1024 + 256 + cl) = pack8(v0, v1);
                }
        }
    }
};
struct JobOut {
    static constexpr int K = 1024; static constexpr bool FP8 = false;
    const bf16_t* MIX; const bf16_t* Bt; bf16_t* MIXO; int G, c, nM;
    DEV bool unit(int i, Unit& u) const { u.x = 0; u.e = 0; return dense_unit(i * G + c, nM, 4, u.pm, u.pn); }
    DEV void aoffs(const Unit& u, const int (&R)[2], const int (&C)[2], unsigned (&a0)[2], unsigned (&a1)[2]) const { dense_aoffs(u.pm, 1024, R, C, a0, a1); }
    DEV const char* abase(const Unit&) const { return (const char*)MIX; }
    DEV const char* bptr(const Unit& u) const { return (const char*)(Bt + (size_t)u.pn * 256 * 1024); }
    DEV void epi(const f32x4 (&acc)[2][2][4][2], const Unit& u, int wr, int wc, int fr, int fq) const {
#pragma unroll
        for (int ai = 0; ai < 2; ++ai)
#pragma unroll
            for (int m = 0; m < 4; ++m) {
                const int row = u.pm * 256 + ai * 128 + wr * 64 + m * 16 + fr;
#pragma unroll
                for (int bj = 0; bj < 2; ++bj) {
                    const int cl = u.pn * 256 + bj * 128 + wc * 32 + 8 * fq;
                    *(u32x4*)(MIXO + (size_t)row * 1024 + cl) = pack8(acc[ai][bj][m][0], acc[ai][bj][m][1]);
                }
            }
    }
};
struct JobOutQ {
    static constexpr int K = 1024; static constexpr bool FP8 = false; static constexpr int NT = 4;
    const bf16_t* MIX; const bf16_t* Bt; bf16_t* PART; int c;
    DEV bool unit(int i, Unit& u) const { u.x = 0; u.e = c & 3; u.pm = 128 + (c >> 4); u.pn = (c >> 2) & 3; return i == 0; }
    DEV void aoffs(const Unit& u, const int (&R)[2], const int (&C)[2], unsigned (&a0)[2], unsigned (&a1)[2]) const { dense_aoffs(u.pm, 1024, R, C, a0, a1); }
    DEV const char* abase(const Unit& u) const { return (const char*)(MIX + u.e * 256); }
    DEV const char* bptr(const Unit& u) const { return (const char*)(Bt + (size_t)u.pn * 256 * 1024 + u.e * 256); }
    DEV void epi(const f32x4 (&acc)[2][2][4][2], const Unit& u, int wr, int wc, int fr, int fq) const {
#pragma unroll
        for (int ai = 0; ai < 2; ++ai)
#pragma unroll
            for (int m = 0; m < 4; ++m) {
                const int row = (u.pm - 128) * 256 + ai * 128 + wr * 64 + m * 16 + fr;
#pragma unroll
                for (int bj = 0; bj < 2; ++bj) {
                    const int cl = u.pn * 256 + bj * 128 + wc * 32 + 8 * fq;
                    *(u32x4*)(PART + ((size_t)u.e * 512 + row) * 1024 + cl) = pack8(acc[ai][bj][m][0], acc[ai][bj][m][1]);
                }
            }
    }
};
template <int NT> DEV bool moe_unit(int i, int G, int c, const volatile LAS int* bs, int lane_unused, Unit& u) {
    const int lane = lane_fresh();
    const int total = bs[32] * NT, per = (total + 7) >> 3, j = i * (G >> 3) + (c >> 3);
    if (j >= per) return false;
    const int up = (c & 7) * per + j; if (up >= total) return false;
    const int rb = up / NT; u.pn = up % NT; u.pm = rb;
    const unsigned long long m = __ballot(lane < 32 && bs[(lane & 31) + 1] <= rb);
    u.e = __popcll(m); u.x = (rb - bs[u.e]) * 256;
    return true;
}
struct JobGu {
    static constexpr int K = 512; static constexpr bool FP8 = true;
    const unsigned char* F8; const unsigned char* Wgu; const float* bgu; const int* ltok; unsigned char* ACT; const volatile LAS int* bs; int G, c, lane;
    DEV bool unit(int i, Unit& u) const { return moe_unit<8>(i, G, c, bs, lane, u); }
    DEV void aoffs(const Unit& u, const int (&R)[2], const int (&C)[2], unsigned (&a0)[2], unsigned (&a1)[2]) const {
        const int cnt = bs[33 + u.e];
#pragma unroll
        for (int i = 0; i < 2; ++i) {
            const int p0 = u.x + R[i], p1 = p0 + 128;
            const int t0 = p0 < cnt ? ltok[(size_t)u.e * NTOK + p0] : 0, t1 = p1 < cnt ? ltok[(size_t)u.e * NTOK + p1] : 0;
            a0[i] = (unsigned)(t0 * 512 + C[i]) * 2u; a1[i] = (unsigned)(t1 * 512 + C[i]) * 2u;
        }
    }
    static constexpr int NST = 4;
    DEV const unsigned* pre_src(const Unit& u, int wid, int lane) const {
        if (wid < 4) return (const unsigned*)(ltok + (size_t)u.e * NTOK + u.x + wid * 64 + lane);
        const int i = (wid - 4) * 64 + lane; return (const unsigned*)(bgu + (size_t)u.e * 2048 + u.pn * 128 + (i < 128 ? i : 1024 + i - 128)); }
    DEV int pre_dst(int wid, int par) const { return wid < 4 ? PRE_LTOK + wid * 256 : PRE_BIAS + par * 1024 + (wid - 4) * 256; }
    DEV void aoffs_lds(const Unit& u, const int (&R)[2], const int (&C)[2], unsigned (&a0)[2], unsigned (&a1)[2], const LAS unsigned char* lt) const {
        const int cnt = bs[33 + u.e];
#pragma unroll
        for (int i = 0; i < 2; ++i) {
            const int p0 = u.x + R[i], p1 = p0 + 128;
            const int v0 = ((const LAS int*)lt)[R[i]], v1 = ((const LAS int*)lt)[R[i] + 128];
            const int t0 = p0 < cnt ? v0 : 0, t1 = p1 < cnt ? v1 : 0;
            a0[i] = (unsigned)(t0 * 512 + C[i]) * 2u; a1[i] = (unsigned)(t1 * 512 + C[i]) * 2u;
        }
    }
    DEV const char* abase(const Unit&) const { return (const char*)F8; }
    DEV const char* bptr(const Unit& u) const { return (const char*)(Wgu + ((size_t)u.e * 2048 + u.pn * 256) * 1024); }
    DEV void epi(const f32x4 (&acc)[2][2][4][2], const Unit& u, int wr, int wc, int fr, int fq, const LAS float* bias) const {
        const int cl = wc * 32 + 8 * fq;
        const LAS float* bg = bias + cl;
        const f32x4 g0 = *(const LAS f32x4*)bg, g1 = *(const LAS f32x4*)(bg + 4), l0 = *(const LAS f32x4*)(bg + 128), l1 = *(const LAS f32x4*)(bg + 132);
        constexpr float SC = 1.0f / 512.0f;
        const bool odd = fq & 1;
#pragma unroll
        for (int ai = 0; ai < 2; ++ai)
#pragma unroll
            for (int mp = 0; mp < 2; ++mp) {
                u32x2 w2[2];
#pragma unroll
                for (int mm = 0; mm < 2; ++mm) { const int m = 2 * mp + mm;
                    f32x4 a0 = acc[ai][0][m][0] * SC + g0, a1 = acc[ai][0][m][1] * SC + g1, b0 = acc[ai][1][m][0] * SC + l0, b1 = acc[ai][1][m][1] * SC + l1;
#pragma unroll
                    for (int j = 0; j < 4; ++j) {
                        float gl = fminf(a0[j], 7.0f), li = fminf(fmaxf(b0[j], -7.0f), 7.0f); a0[j] = (gl * __builtin_amdgcn_rcpf(1.0f + __builtin_amdgcn_exp2f(gl * -2.45546695959f))) * fmaf(li, 4.0f, 4.0f);
                        gl = fminf(a1[j], 7.0f); li = fminf(fmaxf(b1[j], -7.0f), 7.0f); a1[j] = (gl * __builtin_amdgcn_rcpf(1.0f + __builtin_amdgcn_exp2f(gl * -2.45546695959f))) * fmaf(li, 4.0f, 4.0f);
                    }
                    w2[mm].x = pk_fp8x4_nc(a0[0], a0[1], a0[2], a0[3]); w2[mm].y = pk_fp8x4_nc(a1[0], a1[1], a1[2], a1[3]); }
                const u32x2 snd = odd ? w2[0] : w2[1]; u32x2 rcv; rcv.x = (unsigned)__shfl_xor((int)snd.x, 16); rcv.y = (unsigned)__shfl_xor((int)snd.y, 16);
                const u32x2 own = odd ? w2[1] : w2[0];
                const u32x4 o = odd ? (u32x4){rcv.x, rcv.y, own.x, own.y} : (u32x4){own.x, own.y, rcv.x, rcv.y};
                const int row = u.pm * 256 + ai * 128 + wr * 64 + (2 * mp + (odd ? 1 : 0)) * 16 + fr;
                *(u32x4*)(ACT + (size_t)row * 1024 + u.pn * 128 + wc * 32 + 16 * (fq >> 1)) = o;
            }
    }
};
struct JobDown {
    static constexpr int K = 512; static constexpr bool FP8 = true;
    const unsigned char* ACT; const unsigned char* Wdn; const float* bdn; unsigned char* YB; const volatile LAS int* bs; int G, c, lane;
    DEV bool unit(int i, Unit& u) const { return moe_unit<4>(i, G, c, bs, lane, u); }
    DEV void aoffs(const Unit& u, const int (&R)[2], const int (&C)[2], unsigned (&a0)[2], unsigned (&a1)[2]) const { dense_aoffs(u.pm, 512, R, C, a0, a1); }
    DEV const char* abase(const Unit&) const { return (const char*)ACT; }
    DEV const char* bptr(const Unit& u) const { return (const char*)(Wdn + ((size_t)u.e * 1024 + u.pn * 256) * 1024); }
    static constexpr int NST = 8;
    DEV const unsigned* pre_src(const Unit& u, int wid, int lane) const { return (const unsigned*)(bdn + (size_t)u.e * 1024 + u.pn * 256 + (wid & 3) * 64 + lane); }
    DEV int pre_dst(int wid, int par) const { return wid < 4 ? PRE_LTOK + wid * 256 : PRE_BIAS + par * 1024 + (wid - 4) * 256; }
    DEV void aoffs_lds(const Unit& u, const int (&R)[2], const int (&C)[2], unsigned (&a0)[2], unsigned (&a1)[2], const LAS unsigned char*) const { dense_aoffs(u.pm, 512, R, C, a0, a1); }
    DEV void epi(const f32x4 (&acc)[2][2][4][2], const Unit& u, int wr, int wc, int fr, int fq, const LAS float* bias) const {
        constexpr float SC = 1.0f / 256.0f;
#pragma unroll
        for (int bj = 0; bj < 2; ++bj) {
            const int cl = u.pn * 256 + bj * 128 + wc * 32 + 8 * fq;
            const LAS float* bp = bias + bj * 128 + wc * 32 + 8 * fq;
            const f32x4 b0 = *(const LAS f32x4*)bp, b1 = *(const LAS f32x4*)(bp + 4);
            const bool odd = fq & 1;
#pragma unroll
            for (int ai = 0; ai < 2; ++ai)
#pragma unroll
                for (int mp = 0; mp < 2; ++mp) {
                    u32x2 w2[2];
#pragma unroll
                    for (int mm = 0; mm < 2; ++mm) { const int m = 2 * mp + mm;
                        const f32x4 y0 = (acc[ai][bj][m][0] * SC + b0) * 16.0f, y1 = (acc[ai][bj][m][1] * SC + b1) * 16.0f;
                        w2[mm].x = pk_fp8x4(y0[0], y0[1], y0[2], y0[3]); w2[mm].y = pk_fp8x4(y1[0], y1[1], y1[2], y1[3]); }
                    const u32x2 snd = odd ? w2[0] : w2[1]; u32x2 rcv; rcv.x = (unsigned)__shfl_xor((int)snd.x, 16); rcv.y = (unsigned)__shfl_xor((int)snd.y, 16);
                    const u32x2 own = odd ? w2[1] : w2[0];
                    const u32x4 o = odd ? (u32x4){rcv.x, rcv.y, own.x, own.y} : (u32x4){own.x, own.y, rcv.x, rcv.y};
                    const int row = u.pm * 256 + ai * 128 + wr * 64 + (2 * mp + (odd ? 1 : 0)) * 16 + fr;
                    *(u32x4*)(YB + (size_t)row * 1024 + u.pn * 256 + bj * 128 + wc * 32 + 16 * (fq >> 1)) = o;
                }
        }
    }
};
}

struct Ctx {
    LAS unsigned char* lds; int tid, lane, wave, G, bid;
    unsigned char* ws; unsigned* ctl;
};
DEV const float* row_src0(KParams& P, int r) { return r < NLAT ? PIN(0) + (size_t)r * D : PIN(2) + (size_t)(r - NLAT) * D; }
DEV int mod_sel(int r) { return r < SEQ ? 0 : (r < NLAT ? 1 : 2); }

DEV void p0_transpose_item(const float* W, int N, bf16_t* WT, int ldt, LAS float* scr, int k0, int n0, int drow0, int lane) {
#pragma unroll 8
    for (int i = 0; i < 32; ++i) { const int kk = 2 * i + (lane >> 5); scr[kk * 33 + (lane & 31)] = W[(size_t)(k0 + kk) * N + n0 + (lane & 31)]; }
    LDS_WAIT();
    const int c = lane & 7;
#pragma unroll
    for (int j = 0; j < 4; ++j) { const int n = (lane >> 3) + 8 * j; const LAS float* s = scr + (8 * c) * 33 + n;
        u32x4 o; o.x = cvt_pk_bf16(s[0 * 33], s[1 * 33]); o.y = cvt_pk_bf16(s[2 * 33], s[3 * 33]); o.z = cvt_pk_bf16(s[4 * 33], s[5 * 33]); o.w = cvt_pk_bf16(s[6 * 33], s[7 * 33]);
        *(u32x4*)(WT + (size_t)(drow0 + n) * ldt + k0 + 8 * c) = o; }
    LDS_WAIT();
}
struct F8Item { const float* src; unsigned char* dst; int N; };
DEV void p0_f8_load(const F8Item& d, f32x4 (&v)[16]) {
#pragma unroll
    for (int i = 0; i < 16; ++i) v[i] = *(const f32x4*)(d.src + (size_t)i * d.N);
}
DEV void p0_f8_finish(const F8Item& d, const f32x4 (&v)[16], float scale) {
    unsigned E[4][4];
#pragma unroll
    for (int kq = 0; kq < 4; ++kq) {
        unsigned Dw[4];
#pragma unroll
        for (int r = 0; r < 4; ++r) { const f32x4 x = v[4 * kq + r] * scale; Dw[r] = g8::pk_fp8x4(x[0], x[1], x[2], x[3]); }
        const unsigned a = __builtin_amdgcn_perm(Dw[1], Dw[0], 0x05010400u), bb = __builtin_amdgcn_perm(Dw[1], Dw[0], 0x07030602u);
        const unsigned c = __builtin_amdgcn_perm(Dw[3], Dw[2], 0x05010400u), dd = __builtin_amdgcn_perm(Dw[3], Dw[2], 0x07030602u);
        E[0][kq] = __builtin_amdgcn_perm(c, a, 0x05040100u); E[1][kq] = __builtin_amdgcn_perm(c, a, 0x07060302u);
        E[2][kq] = __builtin_amdgcn_perm(dd, bb, 0x05040100u); E[3][kq] = __builtin_amdgcn_perm(dd, bb, 0x07060302u);
    }
#pragma unroll
    for (int j = 0; j < 4; ++j) *(u32x4*)(d.dst + (size_t)j * 1024) = (u32x4){E[j][0], E[j][1], E[j][2], E[j][3]};
}
DEV F8Item p0_f8_desc(KParams& P, Ctx& X, int r) {
    const int lane = X.lane, kg = lane >> 3, n4 = lane & 7; F8Item d;
    if (r < 32768) { const int mtx = r >> 9, q = r & 511, kb = q >> 6, nb = q & 63, n0 = nb * 32, half = n0 >> 10, nn = n0 & 1023, drow = (nn >> 7) * 256 + half * 128 + (nn & 127);
        d.N = 2048; d.src = PIN(29) + (size_t)mtx * 1024 * 2048 + (size_t)(kb * 128 + 16 * kg) * 2048 + n0 + 4 * n4;
        d.dst = X.ws + WS_WGU + (size_t)mtx * 2048 * 1024 + (size_t)(drow + 4 * n4) * 1024 + kb * 128 + 16 * kg; }
    else { const int r2 = r - 32768, mtx = r2 >> 8, q = r2 & 255, kb = q >> 5, nb = q & 31;
        d.N = 1024; d.src = PIN(31) + (size_t)mtx * 1024 * 1024 + (size_t)(kb * 128 + 16 * kg) * 1024 + nb * 32 + 4 * n4;
        d.dst = X.ws + WS_WDN + (size_t)mtx * 1024 * 1024 + (size_t)(nb * 32 + 4 * n4) * 1024 + kb * 128 + 16 * kg; }
    return d;
}
DEV void p0_transpose_item_f8(const float* W, int N, unsigned char* WT, int k0, int n0, int drow0, int lane, float scale) {
    const int kg = lane >> 3, n4 = lane & 7; F8Item d; d.N = N; d.src = W + (size_t)(k0 + 16 * kg) * N + n0 + 4 * n4; d.dst = WT + (size_t)(drow0 + 4 * n4) * 1024 + k0 + 16 * kg;
    f32x4 v[16]; p0_f8_load(d, v); p0_f8_finish(d, v, scale);
}
DEV void p0_s5_setup(KParams& P, Ctx& X, int l, int g) {
    LAS f32x2* LAM = (LAS f32x2*)X.lds; LAS f32x2* BBAR = LAM + 2 * 64 * 17; LAS f32x2* CC = BBAR + 2 * 64 * 16; LAS float* KF = (LAS float*)(CC + 2 * 16 * 64);
    const int tid = X.tid;
    if (tid < 128) {
        const int d = tid >> 6, p = tid & 63; const size_t gi = ((size_t)(l * 2 + d) * 16 + g);
        const float are = PIN(16)[gi * 64 + p], aim = PIN(17)[gi * 64 + p], dt = __expf(PIN(18)[gi]);
        const float mag = __expf(are * dt); float cs, sn; sincos_red(aim * dt, cs, sn);
        const float ar = mag * cs, ai = mag * sn;
        float pr = 1.f, pi = 0.f;
        for (int t = 0; t <= 16; ++t) { LAM[(d * 64 + p) * 17 + t] = (f32x2){pr, pi}; const float nr = pr * ar - pi * ai, ni = pr * ai + pi * ar; pr = nr; pi = ni; }
        const float den = are * are + aim * aim, nr1 = ar - 1.0f;
        const float cr = (nr1 * are + ai * aim) / den, ci = (ai * are - nr1 * aim) / den;
        for (int h = 0; h < 16; ++h) { const float br = PIN(19)[(gi * 64 + p) * 16 + h], bi = PIN(20)[(gi * 64 + p) * 16 + h];
            BBAR[(d * 64 + p) * 16 + h] = (f32x2){cr * br - ci * bi, cr * bi + ci * br}; }
        ((f32x2*)(X.ws + WS_LAM16))[gi * 64 + p] = LAM[(d * 64 + p) * 17 + 16];
    }
    for (int i = tid; i < 2048; i += NTHREADS) { const int d = i >> 10, h = (i >> 6) & 15, p = i & 63; const size_t gi = ((size_t)(l * 2 + d) * 16 + g);
        CC[i] = (f32x2){PIN(21)[(gi * 16 + h) * 64 + p], PIN(22)[(gi * 16 + h) * 64 + p]}; }
    __syncthreads();
    for (int i = tid; i < 8192; i += NTHREADS) {
        const int d = i >> 12, tau = (i >> 8) & 15, h = (i >> 4) & 15, hp = i & 15; float s = 0.f;
        for (int p = 0; p < 64; ++p) { const f32x2 c = CC[(d * 16 + h) * 64 + p], lm = LAM[(d * 64 + p) * 17 + tau], b = BBAR[(d * 64 + p) * 16 + hp];
            const float gr = c.x * lm.x - c.y * lm.y, gi2 = c.x * lm.y + c.y * lm.x; s += gr * b.x - gi2 * b.y; }
        KF[i] = s;
    }
    __syncthreads();
    bf16_t* B1 = (bf16_t*)(X.ws + WS_S5B1) + (size_t)(l * 16 + g) * 256 * 256;
    bf16_t* B2 = (bf16_t*)(X.ws + WS_S5B2) + (size_t)(l * 16 + g) * 256 * 512;
    const float* dsk = PIN(23) + l * 256 + g * 16;
    for (int i = tid; i < 256 * 128; i += NTHREADS) {
        const int row = i >> 7, k = (i & 127) * 2;
        const int ii = row >> 4, h = row & 15, j = k >> 4; float v[2];
#pragma unroll
        for (int q = 0; q < 2; ++q) { const int hp = (k & 15) + q; float s = 0.f;
            if (j <= ii) s += KF[((0 * 16 + (ii - j)) * 16 + h) * 16 + hp];
            if (j >= ii) s += KF[((1 * 16 + (j - ii)) * 16 + h) * 16 + hp];
            if (j == ii && h == hp) s += dsk[h];
            v[q] = s; }
        *(unsigned*)(B2 + (size_t)row * 512 + k) = cvt_pk_bf16(v[0], v[1]);
        { const int n = k; const int d = n >> 7, part = (n >> 6) & 1, p = n & 63; float w[2];
#pragma unroll
          for (int q = 0; q < 2; ++q) { const f32x2 c = CC[(d * 16 + h) * 64 + p + q], lm = LAM[(d * 64 + p + q) * 17 + (d == 0 ? ii + 1 : 16 - ii)];
              const float zr = c.x * lm.x - c.y * lm.y, zi = c.x * lm.y + c.y * lm.x; w[q] = part ? -zi : zr; }
          *(unsigned*)(B2 + (size_t)row * 512 + 256 + k) = cvt_pk_bf16(w[0], w[1]); }
        { const int n = row; const int d = n >> 7, part = (n >> 6) & 1, p = n & 63; float w[2];
#pragma unroll
          for (int q = 0; q < 2; ++q) { const f32x2 lm = LAM[(d * 64 + p) * 17 + (d == 0 ? 15 - j : j)], b = BBAR[(d * 64 + p) * 16 + (k & 15) + q];
              const float zr = lm.x * b.x - lm.y * b.y, zi = lm.x * b.y + lm.y * b.x; w[q] = part ? zi : zr; }
          *(unsigned*)(B1 + (size_t)row * 256 + k) = cvt_pk_bf16(w[0], w[1]); }
    }
    __syncthreads();
}
DEV void p0_mod_item(KParams& P, Ctx& X, int item) {
    const int l = item / 192, j0 = (item % 192) * 32;
    const float* W = PIN(4) + (size_t)l * 1024 * 6144;
    const int col = X.lane & 31, kh = X.lane >> 5, kb = X.wave * 128;
    float s0 = 0.f, s1 = 0.f, s2 = 0.f;
#pragma unroll 8
    for (int i = 0; i < 64; ++i) { const int k = kb + 2 * i + kh; const float w = W[(size_t)k * 6144 + j0 + col];
        s0 += silu_(PIN(1)[k]) * w; s1 += silu_(PIN(1)[1024 + k]) * w; s2 += silu_(PIN(3)[k]) * w; }
    LAS float* red = (LAS float*)X.lds;
    red[((X.wave * 2 + kh) * 32 + col) * 3 + 0] = s0; red[((X.wave * 2 + kh) * 32 + col) * 3 + 1] = s1; red[((X.wave * 2 + kh) * 32 + col) * 3 + 2] = s2;
    __syncthreads();
    if (X.tid < 96) { const int r = X.tid / 32, cc = X.tid % 32; float s = PIN(5)[l * 6144 + j0 + cc];
        for (int q = 0; q < 16; ++q) s += red[(q * 32 + cc) * 3 + r];
        ((float*)(X.ws + WS_MOD))[(size_t)(l * 3 + r) * 6144 + j0 + cc] = s; }
    __syncthreads();
}
DEV void p0_prologue(KParams& P, Ctx& X) {
    if (X.bid < 32) p0_s5_setup(P, X, X.bid >> 4, X.bid & 15);
    if (X.tid < 4) { const int g16 = X.bid & 15, kb = X.bid >> 4, nb16 = (X.G - g16 + 15) >> 4;
        __hip_atomic_store(X.ctl + CW_WQ + 64 * (32 + X.tid * 16 + g16) + kb, (unsigned)((130 * kb) / nb16) | ((unsigned)((130 * (kb + 1)) / nb16) << 16), __ATOMIC_RELAXED, __HIP_MEMORY_SCOPE_AGENT); }
    for (int it = X.bid; it < 384; it += X.G) p0_mod_item(P, X, it);
    if (X.bid == X.G - 2) { for (int i = X.tid; i < 1024; i += NTHREADS) ((float*)(X.ws + WS_MOD + 160 * 1024))[i] = log1pf(__expf(-PIN(15)[i])); }
    if (X.bid == X.G - 1) {
        for (int i = X.tid; i < 4096; i += NTHREADS) { const int pos = i >> 4, f = i & 15; const float inv = powf(10000.0f, -(float)f / 16.0f); float c, s; sincos_red((float)pos * inv, c, s);
            ((f32x2*)(X.ws + WS_ROPE))[i] = (f32x2){c, s}; }
    }
    LAS float* scr = (LAS float*)(X.lds + X.wave * 16384);
    const int gw = X.bid * NWAVES + X.wave, NGW = X.G * NWAVES;
    constexpr int I_GU = 8 * 64, I_DN = 8 * 32, I_IN = 16 * 72, I_OUT = 16 * 32, I_GLU = 4 * 8, I_R = 16, I_LRU = 2;
    constexpr int N_GU = 64 * I_GU, N_DN = 64 * I_DN, N_IN = 2 * I_IN, N_OUT = 2 * I_OUT, N_GLU = 2 * I_GLU, N_R = 2 * I_R, N_LRU = 32 * I_LRU;
    constexpr int NITEMS = N_GU + N_DN + N_IN + N_OUT + N_GLU + N_R + N_LRU;
    for (;;) {
      int chunk = 0; if (X.lane == 0) chunk = (int)atomicAdd(X.ctl + CW_WQ + 64 * 30, 1u); chunk = rfl(chunk);
      if (chunk * 8 >= NITEMS) break;
      if (chunk * 8 + 8 <= N_GU + N_DN) {
          f32x4 va[16], vb[16]; F8Item da = p0_f8_desc(P, X, chunk * 8), db; p0_f8_load(da, va);
#pragma unroll 1
          for (int i = 0; i < 8; i += 2) {
              db = p0_f8_desc(P, X, chunk * 8 + i + 1); p0_f8_load(db, vb);
              p0_f8_finish(da, va, 64.0f);
              if (i + 2 < 8) { da = p0_f8_desc(P, X, chunk * 8 + i + 2); p0_f8_load(da, va); }
              p0_f8_finish(db, vb, 64.0f);
          }
          continue;
      }
      for (int it = chunk * 8; it < chunk * 8 + 8 && it < NITEMS; ++it) {
        int r = it;
        if (r < N_GU) { const int mtx = r / I_GU, q = r % I_GU, kb = q / 64, nb = q % 64, n0 = nb * 32;
            const int half = n0 >> 10, nn = n0 & 1023, drow = (nn >> 7) * 256 + half * 128 + (nn & 127);
            p0_transpose_item_f8(PIN(29) + (size_t)mtx * 1024 * 2048, 2048, X.ws + WS_WGU + (size_t)mtx * 2048 * 1024, kb * 128, n0, drow, X.lane, 64.0f); continue; } r -= N_GU;
        if (r < N_DN) { const int mtx = r / I_DN, q = r % I_DN, kb = q / 32, nb = q % 32;
            p0_transpose_item_f8(PIN(31) + (size_t)mtx * 1024 * 1024, 1024, X.ws + WS_WDN + (size_t)mtx * 1024 * 1024, kb * 128, nb * 32, nb * 32, X.lane, 64.0f); continue; } r -= N_DN;
        if (r < N_IN) { const int mtx = r / I_IN, q = r % I_IN, kb = q / 72, nb = q % 72;
            p0_transpose_item(PIN(7) + (size_t)mtx * 1024 * 2304, 2304, (bf16_t*)(X.ws + WS_WIN) + (size_t)mtx * 2304 * 1024, 1024, scr, kb * 64, nb * 32, nb * 32, X.lane); continue; } r -= N_IN;
        if (r < N_OUT) { const int mtx = r / I_OUT, q = r % I_OUT, kb = q / 32, nb = q % 32;
            p0_transpose_item(PIN(8) + (size_t)mtx * 1024 * 1024, 1024, (bf16_t*)(X.ws + WS_WOUT) + (size_t)mtx * 1024 * 1024, 1024, scr, kb * 64, nb * 32, nb * 32, X.lane); continue; } r -= N_OUT;
        if (r < N_GLU) { const int mtx = r / I_GLU, q = r % I_GLU, kb = q / 8, nb = q % 8;
            p0_transpose_item(PIN(24) + (size_t)mtx * 256 * 256, 256, (bf16_t*)(X.ws + WS_WGLU) + (size_t)mtx * 256 * 256, 256, scr, kb * 64, nb * 32, nb * 32, X.lane); continue; } r -= N_GLU;
        if (r < N_R) { const int mtx = r / I_R, kb = r % I_R;
            p0_transpose_item(PIN(27) + (size_t)mtx * 1024 * 32, 32, (bf16_t*)(X.ws + WS_WRT) + (size_t)mtx * 32 * 1024, 1024, scr, kb * 64, 0, 0, X.lane); continue; } r -= N_R;
        { const int mtx = r / I_LRU, nb = r % I_LRU;
          const int n = mtx & 3, dir = (mtx >> 2) & 1, which = (mtx >> 3) & 1, l = mtx >> 4;
          const float* src = (which ? PIN(13) : PIN(11)) + (size_t)((l * 2 + dir) * 4 + n) * 64 * 64;
          bf16_t* dst = (bf16_t*)(X.ws + WS_WLRU) + (size_t)(l * 4 + n) * 256 * 64;
          p0_transpose_item(src, 64, dst, 64, scr, 0, nb * 32, (dir * 2 + which) * 64 + nb * 32, X.lane); }
      }
    }
}

DEV void rowA_one(const float* src, const float* g, const float* shift, const float* scale, bf16_t* dst, int lane) {
    f32x4 v[4]; float ss = 0.f;
#pragma unroll
    for (int j = 0; j < 4; ++j) { v[j] = *(const f32x4*)(src + 4 * lane + 256 * j); ss += v[j][0] * v[j][0] + v[j][1] * v[j][1] + v[j][2] * v[j][2] + v[j][3] * v[j][3]; }
    const float rstd = rsqrtf(wave_sum(ss) * (1.0f / D) + EPS);
#pragma unroll
    for (int j = 0; j < 4; ++j) { const int c = 4 * lane + 256 * j; const f32x4 gg = *(const f32x4*)(g + c), sh = *(const f32x4*)(shift + c), sc = *(const f32x4*)(scale + c);
        f32x4 o;
#pragma unroll
        for (int q = 0; q < 4; ++q) o[q] = v[j][q] * rstd * gg[q] * (1.0f + sc[q]) + sh[q];
        u32x2 w; w.x = cvt_pk_bf16(o[0], o[1]); w.y = cvt_pk_bf16(o[2], o[3]); *(u32x2*)(dst + c) = w; }
}
DEV void phase_rowA(KParams& P, Ctx& X, int l) {
    const int gw = X.bid * NWAVES + X.wave, NGW = X.G * NWAVES, lane = X.lane;
    const float* mod = (const float*)(X.ws + WS_MOD) + (size_t)l * 3 * 6144; const float* g = PIN(6) + (size_t)l * 4 * 1024;
    for (int r0 = gw * 2; r0 < NTOK; r0 += NGW * 2) {
        f32x4 v[2][4]; float ss[2] = {0.f, 0.f};
#pragma unroll
        for (int q = 0; q < 2; ++q) { const float* src = row_src0(P, r0 + q);
#pragma unroll
            for (int j = 0; j < 4; ++j) v[q][j] = *(const f32x4*)(src + 4 * lane + 256 * j); }
#pragma unroll
        for (int q = 0; q < 2; ++q)
#pragma unroll
            for (int j = 0; j < 4; ++j) ss[q] += v[q][j][0] * v[q][j][0] + v[q][j][1] * v[q][j][1] + v[q][j][2] * v[q][j][2] + v[q][j][3] * v[q][j][3];
#pragma unroll
        for (int q = 0; q < 2; ++q) { const float rstd = rsqrtf(wave_sum(ss[q]) * (1.0f / D) + EPS); const float* m = mod + mod_sel(r0 + q) * 6144; bf16_t* dst = (bf16_t*)(X.ws + WS_H) + (size_t)(r0 + q) * D;
#pragma unroll
            for (int j = 0; j < 4; ++j) { const int c = 4 * lane + 256 * j; const f32x4 gg = *(const f32x4*)(g + c), sh = *(const f32x4*)(m + c), sc = *(const f32x4*)(m + 1024 + c); f32x4 o;
#pragma unroll
                for (int e = 0; e < 4; ++e) o[e] = v[q][j][e] * rstd * gg[e] * (1.0f + sc[e]) + sh[e];
                u32x2 w; w.x = cvt_pk_bf16(o[0], o[1]); w.y = cvt_pk_bf16(o[2], o[3]); *(u32x2*)(dst + c) = w; } }
    }
}

DEV void phase_krope(KParams& P, Ctx& X) {
    bf16_t* IN7 = (bf16_t*)(X.ws + WS_IN7); const f32x2* RT = (const f32x2*)(X.ws + WS_ROPE);
    const int nth = X.G * NTHREADS;
    for (int it = X.bid * NTHREADS + X.tid; it < NLAT * 32; it += nth) {
        const int tok = it >> 5, h = (it >> 2) & 7, s = (it >> 1) & 1, f8 = it & 1; const int tl = tok & (SEQ - 1), pos = s ? (tl & 63) : (tl >> 6);
        bf16_t* p = IN7 + (size_t)tok * LD7 + COL_K + h * 64 + s * 32 + f8 * 8;
        const u32x4 u1 = *(const u32x4*)p, u2 = *(const u32x4*)(p + 16);
        const unsigned a[4] = {u1.x, u1.y, u1.z, u1.w}, b[4] = {u2.x, u2.y, u2.z, u2.w}; unsigned o1[4], o2[4];
#pragma unroll
        for (int q = 0; q < 4; ++q) { const f32x2 t0 = RT[pos * 16 + f8 * 8 + 2 * q], t1 = RT[pos * 16 + f8 * 8 + 2 * q + 1];
            const float x0 = blo(a[q]), x1 = bhi(a[q]), y0 = blo(b[q]), y1 = bhi(b[q]);
            o1[q] = cvt_pk_bf16(x0 * t0.x - y0 * t0.y, x1 * t1.x - y1 * t1.y); o2[q] = cvt_pk_bf16(y0 * t0.x + x0 * t0.y, y1 * t1.x + x1 * t1.y); }
        *(u32x4*)p = (u32x4){o1[0], o1[1], o1[2], o1[3]}; *(u32x4*)(p + 16) = (u32x4){o2[0], o2[1], o2[2], o2[3]};
    }
}

DEV int wq_fetch_block(Ctx& X, int q) {
    volatile LAS int* slot = (volatile LAS int*)(X.lds + LDS_MISC + 1024);
    __syncthreads();
    if (X.tid == 0) slot[0] = (int)atomicAdd(X.ctl + CW_WQ + 64 * q, 1u);
    __syncthreads();
    return slot[0];
}
DEV void lru_load(Ctx& X, int c, int n, int pass, u32x4 (&cin)[4], u32x4& gv, float& hin) {
    const int tid = X.tid, ti = tid >> 3, c8 = tid & 7, ch0 = n * 64 + c8 * 8;
    const bf16_t* IN7 = (const bf16_t*)(X.ws + WS_IN7);
#pragma unroll
    for (int k = 0; k < 4; ++k) { int row = c * 64 + ti + k - 2; row = min(max(row, 0), NTOK - 1); cin[k] = *(const u32x4*)(IN7 + (size_t)row * LD7 + COL_LU + ch0); }
    if (pass == 2) {
        gv = *(const u32x4*)(IN7 + (size_t)(c * 64 + ti) * LD7 + COL_LG + ch0);
        hin = ((const float*)(X.ws + WS_LCIN))[((size_t)(tid >> 8) * LCH + c) * 256 + n * 64 + (tid & 63)]; }
}
constexpr int LRU_CONST = 10240;
DEV void lru_unit(KParams& P, Ctx& X, int l, int c, int n, int pass, const bf16x8 (&wf)[8][2], const u32x4 (&cin)[4], const u32x4& gvp, float hinp, int nn, volatile LAS int* slotw) {
    const int t0 = c * 64, tid = X.tid, lane = X.lane, wave = X.wave;
    const int tl0 = c < 512 ? (c & 255) * 64 : ((c - 512) & 3) * 64, seqlen = c < 512 ? SEQ : CTXL;
    const bf16_t* IN7 = (const bf16_t*)(X.ws + WS_IN7);
    LAS bf16_t* Cs = (LAS bf16_t*)X.lds;
    LAS f32x2* AB = (LAS f32x2*)(X.lds + 16384);
    LAS f32x2* SUB = (LAS f32x2*)(X.lds + 16384 + 65536);
    {
        const int ti = tid >> 3, c8 = tid & 7, ch0 = n * 64 + c8 * 8; float a[8];
        const LAS float* LC = (const LAS float*)(X.lds + LRU_CONST);
        { const f32x4 c0 = *(const LAS f32x4*)(LC + 256 + c8 * 8), c1 = *(const LAS f32x4*)(LC + 256 + c8 * 8 + 4); a[0] = c0[0]; a[1] = c0[1]; a[2] = c0[2]; a[3] = c0[3]; a[4] = c1[0]; a[5] = c1[1]; a[6] = c1[2]; a[7] = c1[3]; }
#pragma unroll
        for (int k = 0; k < 4; ++k) { const int tt = tl0 + ti + k - 2;
            if (tt >= 0 && tt < seqlen) { const u32x4 v = cin[k]; const f32x4 w0 = *(const LAS f32x4*)(LC + k * 64 + c8 * 8), w1 = *(const LAS f32x4*)(LC + k * 64 + c8 * 8 + 4); const float w[8] = {w0[0], w0[1], w0[2], w0[3], w1[0], w1[1], w1[2], w1[3]};
                a[0] += w[0] * blo(v.x); a[1] += w[1] * bhi(v.x); a[2] += w[2] * blo(v.y); a[3] += w[3] * bhi(v.y); a[4] += w[4] * blo(v.z); a[5] += w[5] * bhi(v.z); a[6] += w[6] * blo(v.w); a[7] += w[7] * bhi(v.w); } }
        u32x4 o; o.x = cvt_pk_bf16(a[0], a[1]); o.y = cvt_pk_bf16(a[2], a[3]); o.z = cvt_pk_bf16(a[4], a[5]); o.w = cvt_pk_bf16(a[6], a[7]);
        *(LAS u32x4*)(Cs + ti * 72 + c8 * 8) = o;
    }
    __syncthreads();
    {
        const int mt = wave & 3, dir = wave >> 2, fr = lane & 15, q4 = lane >> 4;
        bf16x8 af[2];
#pragma unroll
        for (int ks = 0; ks < 2; ++ks) af[ks] = *(const LAS bf16x8*)(Cs + (16 * mt + fr) * 72 + ks * 32 + q4 * 8);
        f32x4 acc[8];
#pragma unroll
        for (int t = 0; t < 8; ++t) { acc[t] = (f32x4){0.f, 0.f, 0.f, 0.f};
#pragma unroll
            for (int ks = 0; ks < 2; ++ks) acc[t] = __builtin_amdgcn_mfma_f32_16x16x32_bf16(af[ks], wf[t][ks], acc[t], 0, 0, 0); }
#pragma unroll
        for (int t = 0; t < 4; ++t) { const int chl = t * 16 + fr, ch = n * 64 + chl;
            const LAS float* GC = (const LAS float*)(X.lds + LRU_CONST) + 320 + dir * 192 + chl; (void)ch;
            const float ba = GC[0], bx = GC[64], sp = GC[128];
#pragma unroll
            for (int i = 0; i < 4; ++i) { const int tk = 16 * mt + 4 * q4 + i;
                const float r = __builtin_amdgcn_rcpf(1.0f + __builtin_amdgcn_exp2f(fmaf(acc[t][i], -1.44269504088896f, ba))), ig = __builtin_amdgcn_rcpf(1.0f + __builtin_amdgcn_exp2f(fmaf(acc[4 + t][i], -1.44269504088896f, bx)));
                const float a = __builtin_amdgcn_exp2f(r * sp);
                const float cv = bf2f(Cs[tk * 72 + chl]);
                AB[(dir * 64 + tk) * 64 + chl] = (f32x2){a, __builtin_amdgcn_sqrtf(fmaxf(1.0f - a * a, 0.0f)) * ig * cv}; } }
    }
    __syncthreads();
    const int sdir = tid >> 8, ssub = (tid >> 6) & 3, schl = tid & 63;
    {
        float A = 1.f, B = 0.f;
        if (sdir == 0) { for (int t = 16 * ssub; t < 16 * ssub + 16; ++t) { const f32x2 ab = AB[(0 * 64 + t) * 64 + schl]; A *= ab.x; B = ab.x * B + ab.y; } }
        else { for (int t = 16 * ssub + 15; t >= 16 * ssub; --t) { const f32x2 ab = AB[(1 * 64 + t) * 64 + schl]; A *= ab.x; B = ab.x * B + ab.y; } }
        SUB[(sdir * 4 + ssub) * 64 + schl] = (f32x2){A, B};
    }
    if (tid == 0) *slotw = nn;
    __syncthreads();
    if (pass == 1) {
        if (ssub == 0) { float A = 1.f, B = 0.f;
            for (int q = 0; q < 4; ++q) { const f32x2 s = SUB[(sdir * 4 + (sdir ? 3 - q : q)) * 64 + schl]; A *= s.x; B = s.x * B + s.y; }
            ((f32x2*)(X.ws + WS_LAGG))[((size_t)sdir * LCH + c) * 256 + n * 64 + schl] = (f32x2){A, B}; }
    } else {
        float h = hinp;
        if (sdir == 0) { for (int q = 0; q < ssub; ++q) { const f32x2 s = SUB[(0 * 4 + q) * 64 + schl]; h = s.x * h + s.y; }
            for (int t = 16 * ssub; t < 16 * ssub + 16; ++t) { const f32x2 ab = AB[(0 * 64 + t) * 64 + schl]; h = ab.x * h + ab.y; AB[(0 * 64 + t) * 64 + schl].x = h; } }
        else { for (int q = 3; q > ssub; --q) { const f32x2 s = SUB[(1 * 4 + q) * 64 + schl]; h = s.x * h + s.y; }
            for (int t = 16 * ssub + 15; t >= 16 * ssub; --t) { const f32x2 ab = AB[(1 * 64 + t) * 64 + schl]; h = ab.x * h + ab.y; AB[(1 * 64 + t) * 64 + schl].x = h; } }
        __syncthreads();
        const int ti = tid >> 3, c8 = tid & 7, ch0 = n * 64 + c8 * 8;
        const u32x4 gv = gvp; const unsigned gw[4] = {gv.x, gv.y, gv.z, gv.w}; unsigned o[4];
#pragma unroll
        for (int q = 0; q < 4; ++q) { const int cl = c8 * 8 + 2 * q;
            const float y0 = AB[(0 * 64 + ti) * 64 + cl].x + AB[(1 * 64 + ti) * 64 + cl].x, y1 = AB[(0 * 64 + ti) * 64 + cl + 1].x + AB[(1 * 64 + ti) * 64 + cl + 1].x;
            o[q] = cvt_pk_bf16(y0 * gelu_tanh(blo(gw[q])), y1 * gelu_tanh(bhi(gw[q]))); }
        *(u32x4*)((bf16_t*)(X.ws + WS_MIX) + (size_t)(t0 + ti) * 1024 + ch0) = (u32x4){o[0], o[1], o[2], o[3]};
    }
}
DEV void phase_lru(KParams& P, Ctx& X, int l, int pass, int q) {
    const int n = X.bid & 3, fr = X.lane & 15, q4 = X.lane >> 4, dir = X.wave >> 2;
    const bf16_t* Wt = (const bf16_t*)(X.ws + WS_WLRU) + (size_t)(l * 4 + n) * 256 * 64;
    bf16x8 wf[8][2];
#pragma unroll
    for (int t = 0; t < 8; ++t)
#pragma unroll
        for (int ks = 0; ks < 2; ++ks) wf[t][ks] = *(const bf16x8*)(Wt + (size_t)(dir * 128 + t * 16 + fr) * 64 + ks * 32 + q4 * 8);
    unsigned* head = X.ctl + CW_WQ + 64 * (100 + q * 4 + n);
    volatile LAS int* slot = (volatile LAS int*)(X.lds + LDS_MISC + 1024);
    { LAS float* LC = (LAS float*)(X.lds + LRU_CONST);
      for (int i = X.tid; i < 704; i += NTHREADS) { float v;
          if (i < 256) v = PIN(9)[(size_t)(l * 4 + (i >> 6)) * 256 + n * 64 + (i & 63)];
          else if (i < 320) v = PIN(10)[l * 256 + n * 64 + (i - 256)];
          else { const int j = i - 320, d = j / 192, wh = (j % 192) >> 6, ch = n * 64 + (j & 63);
              v = wh == 0 ? PIN(12)[(l * 2 + d) * 256 + ch] * -1.44269504088896f : wh == 1 ? PIN(14)[(l * 2 + d) * 256 + ch] * -1.44269504088896f
                          : ((const float*)(X.ws + WS_MOD + 160 * 1024))[(l * 2 + d) * 256 + ch] * (-8.0f * 1.44269504088896f); }
          LC[i] = v; } }
    __syncthreads();
    if (X.tid == 0) { slot[0] = (int)atomicAdd(head, 1u); slot[1] = (int)atomicAdd(head, 1u); }
    __syncthreads();
    int c = slot[0], cn = slot[1], par = 0;
    __syncthreads();
    u32x4 cin[4], cnx[4], gvc = (u32x4){0u, 0u, 0u, 0u}, gvn = (u32x4){0u, 0u, 0u, 0u}; float hc = 0.f, hn = 0.f;
    if (c < LCH) lru_load(X, c, n, pass, cin, gvc, hc);
    while (c < LCH) {
        int nn = 0; if (X.tid == 0) nn = (int)atomicAdd(head, 1u);
        if (cn < LCH) lru_load(X, cn, n, pass, cnx, gvn, hn);
        lru_unit(P, X, l, c, n, pass, wf, cin, gvc, hc, nn, slot + par);
        c = cn; cn = slot[par]; par ^= 1;
#pragma unroll
        for (int k = 0; k < 4; ++k) cin[k] = cnx[k];
        gvc = gvn; hc = hn;
    }
    __syncthreads();
}

DEV void lru_carry_block(Ctx& X, int wt) {
    const int b = wt >> 3, dir = (wt >> 2) & 1, ch = (wt & 3) * 64 + X.lane, w = X.wave;
    const f32x2* AGG = (const f32x2*)(X.ws + WS_LAGG) + (size_t)dir * LCH * 256 + ch; float* CIN = (float*)(X.ws + WS_LCIN) + (size_t)dir * LCH * 256 + ch;
    LAS f32x2* E = (LAS f32x2*)(X.lds + 65536);
    const int s0 = 33 * w, s1 = min(s0 + 33, 260);
    float A = 1.f, B = 0.f;
#pragma unroll 11
    for (int s = s0; s < s1; ++s) { const int cidx = dir == 0 ? (s < 4 ? 512 + b * 4 + s : b * 256 + (s - 4)) : (s < 4 ? 512 + b * 4 + (3 - s) : b * 256 + (259 - s));
        const f32x2 ab = AGG[(size_t)cidx * 256]; A *= ab.x; B = ab.x * B + ab.y; }
    E[w * 64 + X.lane] = (f32x2){A, B};
    __syncthreads();
    float h = 0.f;
    for (int j = 0; j < w; ++j) { const f32x2 e = E[j * 64 + X.lane]; h = e.x * h + e.y; }
#pragma unroll 11
    for (int s = s0; s < s1; ++s) { const int cidx = dir == 0 ? (s < 4 ? 512 + b * 4 + s : b * 256 + (s - 4)) : (s < 4 ? 512 + b * 4 + (3 - s) : b * 256 + (259 - s));
        const f32x2 ab = AGG[(size_t)cidx * 256]; CIN[(size_t)cidx * 256] = h; h = ab.x * h + ab.y; }
    __syncthreads();
}
DEV void s5_carry_block(Ctx& X, int l, int st) {
    const int b = st >> 5, dir = (st >> 4) & 1, g = st & 15, p = X.lane, w = X.wave;
    const f32x2 lm = ((const f32x2*)(X.ws + WS_LAM16))[((size_t)(l * 2 + dir) * 16 + g) * 64 + p];
    const float* SL = (const float*)(X.ws + WS_SL) + (size_t)g * NCHKP * 256 + dir * 128 + p; bf16_t* AX = (bf16_t*)(X.ws + WS_AX) + (size_t)g * NCHKP * 512 + 256 + dir * 128 + p;
    LAS f32x2* E = (LAS f32x2*)(X.lds + 65536);
    const int s0 = 130 * w;
    float xr = 0.f, xi = 0.f;
#pragma unroll 13
    for (int s = s0; s < s0 + 130; ++s) { const int cidx = dir == 0 ? (s < 16 ? 2048 + b * 16 + s : b * 1024 + (s - 16)) : (s < 16 ? 2048 + b * 16 + (15 - s) : b * 1024 + (1039 - s));
        const float sr = SL[(size_t)cidx * 256], si = SL[(size_t)cidx * 256 + 64];
        const float nr = lm.x * xr - lm.y * xi + sr, ni = lm.x * xi + lm.y * xr + si; xr = nr; xi = ni; }
    E[w * 64 + p] = (f32x2){xr, xi};
    float pr = 1.f, pi = 0.f;
    for (int k = 0; k < 130; ++k) { const float nr = pr * lm.x - pi * lm.y, ni = pr * lm.y + pi * lm.x; pr = nr; pi = ni; }
    __syncthreads();
    xr = 0.f; xi = 0.f;
    for (int j = 0; j < w; ++j) { const f32x2 e = E[j * 64 + p]; const float nr = pr * xr - pi * xi + e.x, ni = pr * xi + pi * xr + e.y; xr = nr; xi = ni; }
#pragma unroll 13
    for (int s = s0; s < s0 + 130; ++s) { const int cidx = dir == 0 ? (s < 16 ? 2048 + b * 16 + s : b * 1024 + (s - 16)) : (s < 16 ? 2048 + b * 16 + (15 - s) : b * 1024 + (1039 - s));
        const float sr = SL[(size_t)cidx * 256], si = SL[(size_t)cidx * 256 + 64];
        AX[(size_t)cidx * 512] = (bf16_t)(cvt_pk_bf16(xr, 0.f) & 0xffffu); AX[(size_t)cidx * 512 + 64] = (bf16_t)(cvt_pk_bf16(xi, 0.f) & 0xffffu);
        const float nr = lm.x * xr - lm.y * xi + sr, ni = lm.x * xi + lm.y * xr + si; xr = nr; xi = ni; }
    __syncthreads();
}

template <class T> DEV T ldg32(const void* base, unsigned off) { return *(const T*)((const char*)base + off); }
constexpr int A_CK = 2048, A_CV = A_CK + 256 * 80, A_LK = A_CV + 64 * 272, A_LV = A_LK + 576 * 80, A_NEG = A_LV + 64 * 880, A_END = A_NEG + 1024, A_SLOT = 160000;
static_assert(A_END <= A_SLOT, "attention LDS map");
DEV u32x2 cvt8_fp8(const u32x4& v) {
    u32x2 o; o.x = g8::pk_fp8x4_nc(blo(v.x), bhi(v.x), blo(v.y), bhi(v.y)); o.y = g8::pk_fp8x4_nc(blo(v.z), bhi(v.z), blo(v.w), bhi(v.w)); return o; }
typedef long i64_t;
DEV i64_t as_i64(const u32x2& v) { return __builtin_bit_cast(i64_t, v); }
DEV float max3f(float a, float b, float c) { float r; asm("v_max3_f32 %0, %1, %2, %3" : "=v"(r) : "v"(a), "v"(b), "v"(c)); return r; }
constexpr float ATT_C2 = 0.125f * 1.44269504088896f;
template <class HOOK> DEV void attn_tile(KParams& P, Ctx& X, int l, int b, int h, int r, int cb, bool lat, const u32x4& q0, const u32x4& q1, HOOK&& hook) {
    const int lane = X.lane, fr = lane & 15, q4 = lane >> 4;
    const LAS float* BIAS = (const LAS float*)(X.lds);
    const int tq = lat ? b * SEQ + r * 64 + cb * 16 + fr : NLAT + b * CTXL + cb * 16 + fr;
    hook();
    const i64_t qp[2] = {as_i64((u32x2){q0.x, q0.y}), as_i64((u32x2){q0.z, q0.w})}, qr[2] = {as_i64((u32x2){q1.x, q1.y}), as_i64((u32x2){q1.z, q1.w})};
    const int rs = min(max(r - 4, 0), 248), bs = min(max(cb * 16 - 8, 0), 32);
    f32x4 sc[16];
    f32x4 oacc[4];
#pragma unroll
    for (int dt = 0; dt < 4; ++dt) oacc[dt] = (f32x4){0.f, 0.f, 0.f, 0.f};
    float mrun = -3.0e38f, sum = 0.f;
    if (lat) {
        float mx = -3.0e38f;
        const int qc = cb * 16 + fr, ws0 = min(max(qc - 8, 0), 48);
        const LAS float* bptr[8];
#pragma unroll
        for (int e = 0; e < 8; ++e) { const int kc = bs + 16 * (e >> 2) + 4 * q4 + (e & 3); const bool ok = (kc >= ws0) && (kc < ws0 + 16);
            bptr[e] = ok ? BIAS + (rs - r + 7) * 31 + min(max(kc - qc + 15, 0), 30) : (const LAS float*)(X.lds + A_NEG); }
        const LAS unsigned char* klds = X.lds + A_LK + (bs + fr) * 80 + q4 * 8;
        const LAS unsigned char* vlds = X.lds + A_LV + fr * 880 + ((bs >> 2) + q4) * 8;
        const int s0 = rs % 9;
        i64_t kf[2][4];
#define ATT_LDK(buf, j) do { const int sl_ = s0 + (j) >= 9 ? s0 + (j) - 9 : s0 + (j); _Pragma("unroll") for (int c2 = 0; c2 < 2; ++c2) { const LAS unsigned char* kp = klds + (sl_ * 64 + 16 * c2) * 80; \
            kf[buf][2 * c2] = *(const LAS i64_t*)kp; kf[buf][2 * c2 + 1] = *(const LAS i64_t*)(kp + 32); } } while (0)
        ATT_LDK(0, 0);
        float bvn[8];
#pragma unroll
        for (int e = 0; e < 8; ++e) bvn[e] = bptr[e][0];
#pragma unroll
        for (int j = 0; j < 8; ++j) {
            if (j < 7) ATT_LDK((j + 1) & 1, j + 1);
            float bvv[8];
#pragma unroll
            for (int e = 0; e < 8; ++e) bvv[e] = bvn[e];
            if (j < 7) {
#pragma unroll
                for (int e = 0; e < 8; ++e) bvn[e] = bptr[e][(j + 1) * 31]; }
            f32x4 a[2];
#pragma unroll
            for (int c2 = 0; c2 < 2; ++c2) a[c2] = __builtin_amdgcn_mfma_f32_16x16x32_fp8_fp8(kf[j & 1][2 * c2], qr[0], (f32x4){0.f, 0.f, 0.f, 0.f}, 0, 0, 0);
#pragma unroll
            for (int c2 = 0; c2 < 2; ++c2) a[c2] = __builtin_amdgcn_mfma_f32_16x16x32_fp8_fp8(kf[j & 1][2 * c2 + 1], qr[1], a[c2], 0, 0, 0);
#pragma unroll
            for (int c2 = 0; c2 < 2; ++c2) {
#pragma unroll
                for (int i = 0; i < 4; ++i) a[c2][i] = fmaf(a[c2][i], ATT_C2, bvv[c2 * 4 + i]);
                mx = max3f(mx, a[c2][0], a[c2][1]); mx = max3f(mx, a[c2][2], a[c2][3]);
                sc[2 * j + c2] = a[c2]; }
        }
#undef ATT_LDK
        mx = fmaxf(mx, __shfl_xor(mx, 16)); mx = fmaxf(mx, __shfl_xor(mx, 32));
        const float mm = mx - 8.0f;
#pragma unroll
        for (int t = 0; t < 16; ++t)
#pragma unroll
            for (int i = 0; i < 4; ++i) { const float e = __builtin_amdgcn_exp2f(sc[t][i] - mm); sc[t][i] = e; sum += e; }
        i64_t vf[2][4];
#define ATT_LDV(buf, j) do { const int sl_ = s0 + (j) >= 9 ? s0 + (j) - 9 : s0 + (j); _Pragma("unroll") for (int dt = 0; dt < 4; ++dt) vf[buf][dt] = *(const LAS i64_t*)(vlds + dt * 16 * 880 + sl_ * 96); } while (0)
        ATT_LDV(0, 0);
#pragma unroll
        for (int j = 0; j < 8; ++j) {
            if (j < 7) ATT_LDV((j + 1) & 1, j + 1);
            const i64_t pb = as_i64((u32x2){g8::pk_fp8x4_nc(sc[2 * j][0], sc[2 * j][1], sc[2 * j][2], sc[2 * j][3]), g8::pk_fp8x4_nc(sc[2 * j + 1][0], sc[2 * j + 1][1], sc[2 * j + 1][2], sc[2 * j + 1][3])});
#pragma unroll
            for (int dt = 0; dt < 4; ++dt) oacc[dt] = __builtin_amdgcn_mfma_f32_16x16x32_fp8_fp8(vf[j & 1][dt], pb, oacc[dt], 0, 0, 0);
        }
#undef ATT_LDV
        mrun = mx;
    }
    {
        float mx = -3.0e38f;
        const LAS unsigned char* kcl = X.lds + A_CK + fr * 80 + q4 * 8;
        const LAS unsigned char* vcl = X.lds + A_CV + fr * 272 + q4 * 8;
        i64_t kc[2][4];
#define ATT_LDKC(buf, g) do { _Pragma("unroll") for (int t = 0; t < 2; ++t) { const LAS unsigned char* kp = kcl + (16 * (2 * (g) + t)) * 80; \
            kc[buf][2 * t] = *(const LAS i64_t*)kp; kc[buf][2 * t + 1] = *(const LAS i64_t*)(kp + 32); } } while (0)
        ATT_LDKC(0, 0);
#pragma unroll
        for (int g = 0; g < 8; ++g) {
            if (g < 7) ATT_LDKC((g + 1) & 1, g + 1);
            f32x4 a[2];
#pragma unroll
            for (int t = 0; t < 2; ++t) a[t] = __builtin_amdgcn_mfma_f32_16x16x32_fp8_fp8(kc[g & 1][2 * t], qp[0], (f32x4){0.f, 0.f, 0.f, 0.f}, 0, 0, 0);
#pragma unroll
            for (int t = 0; t < 2; ++t) a[t] = __builtin_amdgcn_mfma_f32_16x16x32_fp8_fp8(kc[g & 1][2 * t + 1], qp[1], a[t], 0, 0, 0);
#pragma unroll
            for (int t = 0; t < 2; ++t) { a[t] = a[t] * ATT_C2; mx = max3f(mx, a[t][0], a[t][1]); mx = max3f(mx, a[t][2], a[t][3]); sc[2 * g + t] = a[t]; }
        }
#undef ATT_LDKC
        mx = fmaxf(mx, __shfl_xor(mx, 16)); mx = fmaxf(mx, __shfl_xor(mx, 32));
        const float mnew = fmaxf(mrun, mx), alpha = __builtin_amdgcn_exp2f(mrun - mnew), mm = mnew - 8.0f;
        sum *= alpha;
#pragma unroll
        for (int dt = 0; dt < 4; ++dt) oacc[dt] = oacc[dt] * alpha;
#pragma unroll
        for (int t = 0; t < 16; ++t)
#pragma unroll
            for (int i = 0; i < 4; ++i) { const float e = __builtin_amdgcn_exp2f(sc[t][i] - mm); sc[t][i] = e; sum += e; }
        i64_t vc[2][4];
#define ATT_LDVC(buf, t2) do { _Pragma("unroll") for (int dt = 0; dt < 4; ++dt) vc[buf][dt] = *(const LAS i64_t*)(vcl + dt * 16 * 272 + 32 * (t2)); } while (0)
        ATT_LDVC(0, 0);
#pragma unroll
        for (int t2 = 0; t2 < 8; ++t2) {
            if (t2 < 7) ATT_LDVC((t2 + 1) & 1, t2 + 1);
            const i64_t pb = as_i64((u32x2){g8::pk_fp8x4_nc(sc[2 * t2][0], sc[2 * t2][1], sc[2 * t2][2], sc[2 * t2][3]), g8::pk_fp8x4_nc(sc[2 * t2 + 1][0], sc[2 * t2 + 1][1], sc[2 * t2 + 1][2], sc[2 * t2 + 1][3])});
#pragma unroll
            for (int dt = 0; dt < 4; ++dt) oacc[dt] = __builtin_amdgcn_mfma_f32_16x16x32_fp8_fp8(vc[t2 & 1][dt], pb, oacc[dt], 0, 0, 0);
        }
#undef ATT_LDVC
    }
    sum += __shfl_xor(sum, 16); sum += __shfl_xor(sum, 32);
    const float inv = 1.0f / sum;
    bf16_t* op = (bf16_t*)(X.ws + WS_MIX) + (size_t)tq * 1024 + 512 + h * 64 + 4 * q4;
#pragma unroll
    for (int dt = 0; dt < 4; ++dt) { u32x2 w; w.x = cvt_pk_bf16(oacc[dt][0] * inv, oacc[dt][1] * inv); w.y = cvt_pk_bf16(oacc[dt][2] * inv, oacc[dt][3] * inv); *(u32x2*)(op + 16 * dt) = w; }
}
DEV int mix2_take(Ctx& X, unsigned* wq, int nb16, int kb, unsigned old) {
    if ((int)(old & 0xffffu) < (int)(old >> 16)) return (int)(old & 0xffffu);
    for (;;) {
        unsigned v = 0; if (X.lane < nb16 && X.lane != kb) v = __hip_atomic_load(wq + X.lane, __ATOMIC_RELAXED, __HIP_MEMORY_SCOPE_AGENT);
        const int rem = max((int)(v >> 16) - (int)(v & 0xffffu), 0);
        int key = (rem << 8) | X.lane;
#pragma unroll
        for (int o = 32; o; o >>= 1) key = max(key, __shfl_xor(key, o));
        if ((key >> 8) == 0) return -1;
        const int V = key & 255; const unsigned vv = (unsigned)__shfl((int)v, V);
        const int vlo = (int)(vv & 0xffffu), vhi = (int)(vv >> 16), mid = vlo + ((vhi - vlo) >> 1);
        int ok = 0;
        if (X.lane == 0) { ok = atomicCAS(wq + V, vv, (unsigned)vlo | ((unsigned)mid << 16)) == vv;
            if (ok) __hip_atomic_store(wq + kb, (unsigned)(mid + 1) | ((unsigned)vhi << 16), __ATOMIC_RELAXED, __HIP_MEMORY_SCOPE_AGENT); }
        if (rfl(ok)) return mid;
    }
}
DEV void phase_mix2(KParams& P, Ctx& X, int l, int q) {
    if (X.bid < 64) s5_carry_block(X, l, X.bid); else if (X.bid < 80) lru_carry_block(X, X.bid - 64);
    const int g16 = X.bid & 15, b = g16 >> 3, h = g16 & 7;
    const bf16_t* IN7g = (const bf16_t*)(X.ws + WS_IN7); const bf16_t* VTg = (const bf16_t*)(X.ws + WS_VT);
    { LAS float* B = (LAS float*)X.lds; const float* src = PIN(26) + (size_t)(l * 8 + h) * 465; for (int i = X.tid; i < 465; i += NTHREADS) B[i] = src[i] * 1.44269504088896f;
      if (X.tid < 256) ((LAS float*)(X.lds + A_NEG))[X.tid] = -3.0e38f;
      for (int i = X.tid; i < 2048; i += NTHREADS) { const int key = i >> 3, pc = i & 7;
          *(LAS u32x2*)(X.lds + A_CK + key * 80 + pc * 8) = cvt8_fp8(*(const u32x4*)(IN7g + (size_t)(NLAT + b * CTXL + key) * LD7 + COL_K + h * 64 + pc * 8)); }
      for (int i = X.tid; i < 2048; i += NTHREADS) { const int dim = i >> 5, pc = i & 31;
          const u32x2 v = cvt8_fp8(*(const u32x4*)(VTg + ((size_t)((NLAT + b * CTXL) / 8 + pc) * 512 + h * 64 + dim) * 8));
          const int grp = pc >> 2, a = pc & 3, T = a >> 1, q0 = 2 * (a & 1);
          LAS unsigned char* row = X.lds + A_CV + dim * 272 + grp * 32;
          *(LAS unsigned*)(row + q0 * 8 + T * 4) = v.x; *(LAS unsigned*)(row + (q0 + 1) * 8 + T * 4) = v.y; } }
    __syncthreads();
    unsigned* wq = X.ctl + CW_WQ + 64 * (32 + q * 16 + g16);
    const int kb = X.bid >> 4, nb16 = (X.G - g16 + 15) >> 4;
    volatile LAS int* slot = (volatile LAS int*)(X.lds + A_SLOT);
#define MIX2_LDROW(KR, VR, row) do { int tz_ = X.tid; asm volatile("" : "+v"(tz_)); \
        KR = *(const u32x4*)(IN7g + (size_t)(b * SEQ + (row) * 64 + (tz_ >> 3)) * LD7 + COL_K + h * 64 + (tz_ & 7) * 8); \
        VR = *(const u32x4*)(VTg + ((size_t)((b * SEQ + (row) * 64) / 8 + (tz_ >> 6)) * 512 + h * 64 + (tz_ & 63)) * 8); } while (0)
#define MIX2_STROW(KR, VR, row) do { int tz_ = X.tid; asm volatile("" : "+v"(tz_)); const int sl_ = (row) % 9; \
        *(LAS u32x2*)(X.lds + A_LK + (sl_ * 64 + (tz_ >> 3)) * 80 + (tz_ & 7) * 8) = cvt8_fp8(KR); \
        const u32x2 v8 = cvt8_fp8(VR); const int u0 = 2 * X.wave;                   \
        LAS unsigned char* vrow = X.lds + A_LV + (tz_ & 63) * 880 + sl_ * 96; \
        if (u0 <= 11) *(LAS unsigned*)(vrow + u0 * 8) = v8.x;             \
        if (u0 >= 4) *(LAS unsigned*)(vrow + (u0 - 4) * 8 + 4) = v8.x;     \
        if (u0 + 1 <= 11) *(LAS unsigned*)(vrow + (u0 + 1) * 8) = v8.y; \
        if (u0 + 1 >= 4) *(LAS unsigned*)(vrow + (u0 - 3) * 8 + 4) = v8.y; } while (0)
    unsigned old = 0;
    if (X.wave == 0) { if (X.lane == 0) old = atomicAdd(wq + kb, 1u); const int t = mix2_take(X, wq, nb16, kb, (unsigned)rfl((int)old)); if (X.lane == 0) slot[0] = t; }
    __syncthreads();
    int it = slot[0], hb = -100;
    u32x4 qa, qb; bool haveq = false;
    const unsigned char* QB = X.ws + WS_IN7 + (size_t)(COL_Q + h * 64) * 2;
    while (it >= 0) {
        const bool loc = it < 128; const int rb = min(max(2 * it - 4, 0), 247);
        const int tq = loc ? b * SEQ + (2 * it + (X.wave >> 2)) * 64 + (X.wave & 3) * 16 + (X.lane & 15) : NLAT + b * CTXL + ((it - 128) * 8 + X.wave) * 16 + (X.lane & 15);
        if (!haveq) { const unsigned char* qsrc = QB + (size_t)tq * (LD7 * 2) + (X.lane >> 4) * 32; qa = *(const u32x4*)qsrc; qb = *(const u32x4*)(qsrc + 16); }
        if (loc && hb != rb) {
            u32x4 kk[9], vv[9];
#pragma unroll
            for (int i = 0; i < 9; ++i) MIX2_LDROW(kk[i], vv[i], rb + i);
#pragma unroll
            for (int i = 0; i < 9; ++i) MIX2_STROW(kk[i], vv[i], rb + i);
            hb = rb;
            __syncthreads();
        }
        int d = 0; if (loc && it + 1 < 128) d = min(max(2 * it - 2, 0), 247) - rb;
        u32x4 kreg[2], vreg[2], na, nb;
        auto hook = [&]() {
            if (loc && it + 1 < 128) { const unsigned char* qsrc = QB + (size_t)(tq + 128) * (LD7 * 2) + (X.lane >> 4) * 32; na = *(const u32x4*)qsrc; nb = *(const u32x4*)(qsrc + 16); }
            if (d > 0) MIX2_LDROW(kreg[0], vreg[0], rb + 9);
            if (d > 1) MIX2_LDROW(kreg[1], vreg[1], rb + 10);
            if (X.tid == 0) old = atomicAdd(wq + kb, 1u);
        };
        if (loc) attn_tile(P, X, l, b, h, 2 * it + (X.wave >> 2), X.wave & 3, true, qa, qb, hook);
        else attn_tile(P, X, l, b, h, 0, (it - 128) * 8 + X.wave, false, qa, qb, hook);
        if (X.wave == 0) { const int t = mix2_take(X, wq, nb16, kb, (unsigned)rfl((int)old)); if (X.lane == 0) slot[0] = t; }
        __syncthreads();
        const int itn = slot[0];
        if (loc && itn == it + 1 && itn < 128) {
            if (d > 0) MIX2_STROW(kreg[0], vreg[0], rb + 9);
            if (d > 1) MIX2_STROW(kreg[1], vreg[1], rb + 10);
            hb = rb + d; qa = na; qb = nb; haveq = true;
        } else haveq = false;
        __syncthreads();
        it = itn;
    }
#undef MIX2_LDROW
#undef MIX2_STROW
    __syncthreads();
}

DEV f32x4 ld_xrow(KParams& P, const bf16_t* XS, int l, int r, int c) {
    if (l == 0) return *(const f32x4*)(row_src0(P, r) + c);
    const u32x2 w = *(const u32x2*)(XS + (size_t)r * D + c); return (f32x4){blo(w.x), bhi(w.x), blo(w.y), bhi(w.y)};
}
DEV void st_xrow(bf16_t* XS, int r, int c, const f32x4& v) { u32x2 w; w.x = cvt_pk_bf16(v[0], v[1]); w.y = cvt_pk_bf16(v[2], v[3]); *(u32x2*)(XS + (size_t)r * D + c) = w; }
DEV void phase_rowB(KParams& P, Ctx& X, int l) {
    LAS unsigned char* FT = X.lds;
    LAS float* PART = (LAS float*)(X.lds + 36864);
    LAS int* ENT = (LAS int*)(X.lds + 36864 + 16384 + 2048);
    LAS int* CNTT = (LAS int*)(X.lds + 36864 + 16384 + 2048 + 8192);
    const float* mod = (const float*)(X.ws + WS_MOD) + (size_t)l * 3 * 6144; const float* g1 = PIN(6) + (size_t)(l * 4 + 1) * 1024; const float* g2 = g1 + 1024;
    const bf16_t* MIXO = (const bf16_t*)(X.ws + WS_MIXO); bf16_t* XS = (bf16_t*)(X.ws + WS_XS); unsigned char* F8 = X.ws + WS_H;
    const bf16_t* WrT = (const bf16_t*)(X.ws + WS_WRT) + (size_t)l * 32 * 1024;
    const int lane = X.lane, wave = X.wave, tid = X.tid;
    const int fr = lane & 15, q4 = lane >> 4;
    bf16x8 wb0[4], wb1[4];
#pragma unroll
    for (int ks = 0; ks < 4; ++ks) { const int k0 = wave * 128 + ks * 32 + q4 * 8; wb0[ks] = *(const bf16x8*)(WrT + (size_t)fr * 1024 + k0); wb1[ks] = *(const bf16x8*)(WrT + (size_t)(16 + fr) * 1024 + k0); }
    const float brv = PIN(28)[l * 32 + (tid & 31)];
    if (l == 0 && X.G >= 32) {
        const bf16_t* PART = (const bf16_t*)(X.ws + WS_SL); bf16_t* MO = (bf16_t*)(X.ws + WS_MIXO);
        for (int g = NLAT / 16; g < NTOK / 16; ++g) if (g % X.G == X.bid) {
            const int r = g * 16 + (tid >> 5) - NLAT, c0 = (tid & 31) * 32;
#pragma unroll
            for (int v = 0; v < 4; ++v) { f32x4 s0 = (f32x4){0.f, 0.f, 0.f, 0.f}, s1 = s0;
#pragma unroll
                for (int p = 0; p < 4; ++p) { const u32x4 w = *(const u32x4*)(PART + ((size_t)p * 512 + r) * 1024 + c0 + v * 8);
                    s0[0] += blo(w.x); s0[1] += bhi(w.x); s0[2] += blo(w.y); s0[3] += bhi(w.y); s1[0] += blo(w.z); s1[1] += bhi(w.z); s1[2] += blo(w.w); s1[3] += bhi(w.w); }
                *(u32x4*)(MO + (size_t)(NLAT + r) * D + c0 + v * 8) = g8::pack8(s0, s1); } }
        __threadfence_block(); __syncthreads(); }
    LAS float* LG = (LAS float*)(X.lds + 65536);
    for (int i = tid; i < 11 * 256; i += NTHREADS) { const int v = i >> 8, c4 = (i & 255) * 4;
        const float* s = v < 2 ? g1 + v * 1024 : mod + ((v - 2) / 3) * 6144 + (2 + (v - 2) % 3) * 1024;
        *(LAS f32x4*)(LG + v * 1024 + c4) = *(const f32x4*)(s + c4); }
    __syncthreads();
    int nent = 0;
    u32x2 mraw[2][4], mnx[2][4]; f32x4 xv[2][4], xnx[2][4];
    int grp = X.bid;
    if (grp < NTOK / 16) {
#pragma unroll
        for (int q = 0; q < 2; ++q) { const int r = grp * 16 + wave * 2 + q;
#pragma unroll
            for (int j = 0; j < 4; ++j) { const int c = 4 * lane + 256 * j; mnx[q][j] = *(const u32x2*)(MIXO + (size_t)r * D + c); xnx[q][j] = ld_xrow(P, XS, l, r, c); } }
    }
    for (; grp < NTOK / 16; grp += X.G) {
#pragma unroll
        for (int q = 0; q < 2; ++q)
#pragma unroll
            for (int j = 0; j < 4; ++j) { mraw[q][j] = mnx[q][j]; xv[q][j] = xnx[q][j]; }
        {
            const int gn = grp + X.G;
            if (gn < NTOK / 16) {
#pragma unroll
                for (int q = 0; q < 2; ++q) { const int r = gn * 16 + wave * 2 + q;
#pragma unroll
                    for (int j = 0; j < 4; ++j) { const int c = 4 * lane + 256 * j; mnx[q][j] = *(const u32x2*)(MIXO + (size_t)r * D + c); xnx[q][j] = ld_xrow(P, XS, l, r, c); } }
            }
        }
        {
            f32x4 mo[2][4]; float ss[2] = {0.f, 0.f}, ss2[2] = {0.f, 0.f};
#pragma unroll
            for (int q = 0; q < 2; ++q)
#pragma unroll
                for (int j = 0; j < 4; ++j) { const u32x2 w = mraw[q][j]; mo[q][j] = (f32x4){blo(w.x), bhi(w.x), blo(w.y), bhi(w.y)};
                    ss[q] += mo[q][j][0] * mo[q][j][0] + mo[q][j][1] * mo[q][j][1] + mo[q][j][2] * mo[q][j][2] + mo[q][j][3] * mo[q][j][3]; }
#pragma unroll
            for (int q = 0; q < 2; ++q) { const int r = grp * 16 + wave * 2 + q; const LAS float* m = LG + 2048 + mod_sel(r) * 3072;
                const float rstd1 = rsqrtf(wave_sum(ss[q]) * (1.0f / D) + EPS);
#pragma unroll
                for (int j = 0; j < 4; ++j) { const int c = 4 * lane + 256 * j; const f32x4 gg = *(const LAS f32x4*)(LG + c), m2 = *(const LAS f32x4*)(m + c);
#pragma unroll
                    for (int e = 0; e < 4; ++e) { xv[q][j][e] += m2[e] * (mo[q][j][e] * rstd1 * gg[e]); ss2[q] += xv[q][j][e] * xv[q][j][e]; }
                    st_xrow(XS, r, c, xv[q][j]); } }
#pragma unroll
            for (int q = 0; q < 2; ++q) { const int lr = wave * 2 + q, r = grp * 16 + lr; const LAS float* m = LG + 2048 + mod_sel(r) * 3072;
                const float rstd2 = rsqrtf(wave_sum(ss2[q]) * (1.0f / D) + EPS);
#pragma unroll
                for (int j = 0; j < 4; ++j) { const int c = 4 * lane + 256 * j; const f32x4 gg = *(const LAS f32x4*)(LG + 1024 + c), sh = *(const LAS f32x4*)(m + 1024 + c), sc = *(const LAS f32x4*)(m + 2048 + c);
                    f32x4 o;
#pragma unroll
                    for (int e = 0; e < 4; ++e) o[e] = xv[q][j][e] * rstd2 * gg[e] * (1.0f + sc[e]) + sh[e];
                    u32x2 w; w.x = cvt_pk_bf16(o[0], o[1]); w.y = cvt_pk_bf16(o[2], o[3]);
                    *(unsigned*)(F8 + (size_t)r * D + c) = g8::pk_fp8x4(o[0] * 8.0f, o[1] * 8.0f, o[2] * 8.0f, o[3] * 8.0f); *(LAS u32x2*)(FT + lr * 2064 + c * 2) = w; } }
        }
        __syncthreads();
        {
            f32x4 a0 = (f32x4){0.f, 0.f, 0.f, 0.f}, a1 = a0;
#pragma unroll
            for (int ks = 0; ks < 4; ++ks) { const int k0 = wave * 128 + ks * 32 + q4 * 8;
                const bf16x8 af = *(const LAS bf16x8*)(FT + fr * 2064 + k0 * 2);
                a0 = __builtin_amdgcn_mfma_f32_16x16x32_bf16(af, wb0[ks], a0, 0, 0, 0); a1 = __builtin_amdgcn_mfma_f32_16x16x32_bf16(af, wb1[ks], a1, 0, 0, 0); }
#pragma unroll
            for (int i = 0; i < 4; ++i) { PART[(wave * 16 + 4 * q4 + i) * 32 + fr] = a0[i]; PART[(wave * 16 + 4 * q4 + i) * 32 + 16 + fr] = a1[i]; }
        }
        __syncthreads();
        {
            const int row = tid >> 5, e = tid & 31; float v = brv;
#pragma unroll
            for (int w = 0; w < 8; ++w) v += PART[(w * 16 + row) * 32 + e];
            float tv[4]; int ti[4];
#pragma unroll
            for (int k = 0; k < 4; ++k) { float m = v; int mi = e;
#pragma unroll
                for (int o = 16; o >= 1; o >>= 1) { const float ov = __shfl_xor(m, o); const int oi = __shfl_xor(mi, o); const bool take = (ov > m) || (ov == m && oi < mi); m = take ? ov : m; mi = take ? oi : mi; }
                tv[k] = m; ti[k] = mi; v = (e == mi) ? -3.0e38f : v; }
            if (e == 0) { const int r = grp * 16 + row;
                const float e1 = __expf(tv[1] - tv[0]), e2 = __expf(tv[2] - tv[0]), e3 = __expf(tv[3] - tv[0]), is = 1.0f / (1.0f + e1 + e2 + e3);
                *(f32x4*)((float*)(X.ws + WS_GATE) + (size_t)r * 4) = (f32x4){is, e1 * is, e2 * is, e3 * is};
#pragma unroll
                for (int k = 0; k < 4; ++k) { ENT[nent * 64 + row * 4 + k] = ti[k]; ENT[640 + nent * 64 + row * 4 + k] = r * 4 + k; } }
        }
        ++nent;
    }
    __syncthreads();
    int myrank[2] = {0, 0}, mye[2] = {-1, -1};
#pragma unroll
    for (int t = 0; t < 2; ++t) { const int c = wave + 8 * t;
        if (c < nent) { const int e = ENT[c * 64 + lane]; mye[t] = e; int cnt_mine = 0;
            for (int x = 0; x < 32; ++x) { const unsigned long long mk = __ballot(e == x); if (e == x) myrank[t] = __popcll(mk & ((1ull << lane) - 1ull)); if (lane == x) cnt_mine = __popcll(mk); }
            if (lane < 32) CNTT[c * 32 + lane] = cnt_mine; } }
    __syncthreads();
    if (tid < 32) { int tot = 0; for (int c = 0; c < nent; ++c) tot += CNTT[c * 32 + tid];
        int base = tot ? (int)atomicAdd(X.ctl + CW_CNT + l * 32 + tid, (unsigned)tot) : 0;
        for (int c = 0; c < nent; ++c) { const int n = CNTT[c * 32 + tid]; CNTT[c * 32 + tid] = base; base += n; } }
    __syncthreads();
    { int* inv = (int*)(X.ws + WS_INV);
#pragma unroll
      for (int t = 0; t < 2; ++t) { const int c = wave + 8 * t;
        if (c < nent) { const int e = mye[t], pos = CNTT[c * 32 + e] + myrank[t], rk = ENT[640 + c * 64 + lane];
            ((int*)(X.ws + WS_LTOK))[(size_t)e * NTOK + pos] = rk >> 2; inv[rk] = (e << 20) | pos; } } }
    __syncthreads();
}

DEV void moe_table(Ctx& X, int l) {
    volatile LAS int* bs = (volatile LAS int*)(X.lds + LDS_MISC);
    if (X.tid < 64) { const int e = X.lane & 31; const int cnt = (int)X.ctl[CW_CNT + l * 32 + e]; int nb = (cnt + 255) >> 8; int inc = nb;
#pragma unroll
        for (int o = 1; o < 32; o <<= 1) { const int v = __shfl_up(inc, o); if ((X.lane & 31) >= o) inc += v; }
        if (X.lane < 32) { bs[e] = inc - nb; bs[33 + e] = cnt; if (e == 31) bs[32] = inc; } }
    __syncthreads();
}

DEV void phase_rowC(KParams& P, Ctx& X, int l, bool dry = false) {
    const int gw = X.bid * NWAVES + X.wave, NGW = X.G * NWAVES, lane = X.lane;
    const float* mod = (const float*)(X.ws + WS_MOD) + (size_t)l * 3 * 6144; const float* g3 = PIN(6) + (size_t)(l * 4 + 3) * 1024;
    const unsigned char* YB = X.ws + WS_YB; bf16_t* XS = (bf16_t*)(X.ws + WS_XS);
    const int* INV = (const int*)(X.ws + WS_INV); const float* GATE = (const float*)(X.ws + WS_GATE);
    bf16_t* XSW = XS; bf16_t* HW = (bf16_t*)(X.ws + WS_H);
    LAS float* LG = (LAS float*)X.lds;
    { const float* mod1 = (const float*)(X.ws + WS_MOD) + (size_t)3 * 6144; const float* g0 = PIN(6) + (size_t)4 * 1024;
      for (int i = X.tid; i < 11 * 256; i += NTHREADS) { const int v = i >> 8, c4 = (i & 255) * 4; const int cl = (v - 2) / 3, wh = (v - 2) % 3;
          const float* s = v == 0 ? g3 : v == 1 ? g0 : wh == 0 ? mod + cl * 6144 + 5 * 1024 : mod1 + cl * 6144 + (wh - 1) * 1024;
          *(LAS f32x4*)(LG + v * 1024 + c4) = *(const f32x4*)(s + c4); } }
    int bsl; { const int e = lane & 31; const int cnt = (int)X.ctl[CW_CNT + l * 32 + e]; const int nb = (cnt + 255) >> 8; int inc = nb;
#pragma unroll
        for (int o = 1; o < 32; o <<= 1) { const int v = __shfl_up(inc, o); if ((lane & 31) >= o) inc += v; }
        bsl = inc - nb; }
    __syncthreads();
    const int ST = NGW * 2;
    int r0 = gw * 2; int ivc = 0, ivn = 0; float gtc = 0.f, gtn = 0.f;
    if (r0 < NTOK && lane < 8) { ivc = INV[r0 * 4 + lane]; gtc = GATE[r0 * 4 + lane]; }
    if (r0 + ST < NTOK && lane < 8) { ivn = INV[(r0 + ST) * 4 + lane]; gtn = GATE[(r0 + ST) * 4 + lane]; }
    unsigned yb[2][4][4], ybn[2][4][4]; u32x2 xr[2][4], xrn[2][4];
#define ROWC_GATHER(dst, dstx, ivw, rr) do { _Pragma("unroll") for (int q = 0; q < 2; ++q) { _Pragma("unroll") for (int k = 0; k < 4; ++k) { const int iv = __shfl(ivw, q * 4 + k); const int e = iv >> 20, pos = iv & 0xfffff; \
        const size_t dest = (size_t)__shfl(bsl, e) * 256 + pos; _Pragma("unroll") for (int j = 0; j < 4; ++j) dst[q][k][j] = *(const unsigned*)(YB + dest * D + 4 * lane + 256 * j); } \
        _Pragma("unroll") for (int j = 0; j < 4; ++j) dstx[q][j] = *(const u32x2*)(XS + (size_t)((rr) + q) * D + 4 * lane + 256 * j); } } while (0)
    if (r0 < NTOK) ROWC_GATHER(yb, xr, ivc, r0);
    for (; r0 < NTOK; r0 += ST) {
        int iv2 = 0; float gt2 = 0.f;
        if (r0 + ST < NTOK) ROWC_GATHER(ybn, xrn, ivn, r0 + ST);
        if (r0 + 2 * ST < NTOK && lane < 8) { iv2 = INV[(r0 + 2 * ST) * 4 + lane]; gt2 = GATE[(r0 + 2 * ST) * 4 + lane]; }
        f32x4 y[2][4], xv[2][4]; float gk[2][4];
#pragma unroll
        for (int q = 0; q < 2; ++q)
#pragma unroll
            for (int k = 0; k < 4; ++k) gk[q][k] = __shfl(gtc, q * 4 + k);
#pragma unroll
        for (int q = 0; q < 2; ++q)
#pragma unroll
            for (int j = 0; j < 4; ++j) { const u32x2 w = xr[q][j]; xv[q][j] = (f32x4){blo(w.x), bhi(w.x), blo(w.y), bhi(w.y)}; }
#pragma unroll
        for (int q = 0; q < 2; ++q) {
#pragma unroll
            for (int j = 0; j < 4; ++j) { y[q][j] = (f32x4){0.f, 0.f, 0.f, 0.f};
#pragma unroll
                for (int k = 0; k < 4; ++k) { const unsigned w = yb[q][k][j]; const f32x2 lo = __builtin_amdgcn_cvt_pk_f32_fp8(w, false), hi = __builtin_amdgcn_cvt_pk_f32_fp8(w, true); const float gq = gk[q][k] * (1.0f / 16.0f);
                    y[q][j][0] += gq * lo.x; y[q][j][1] += gq * lo.y; y[q][j][2] += gq * hi.x; y[q][j][3] += gq * hi.y; } } }
#pragma unroll
        for (int q = 0; q < 2; ++q) { const int r = r0 + q; const LAS float* m = LG + 2048 + mod_sel(r) * 3072;
            float ss = 0.f;
#pragma unroll
            for (int j = 0; j < 4; ++j) ss += y[q][j][0] * y[q][j][0] + y[q][j][1] * y[q][j][1] + y[q][j][2] * y[q][j][2] + y[q][j][3] * y[q][j][3];
            const float rstd = rsqrtf(wave_sum(ss) * (1.0f / D) + EPS); float ss2 = 0.f;
#pragma unroll
            for (int j = 0; j < 4; ++j) { const int c = 4 * lane + 256 * j; const f32x4 gg = *(const LAS f32x4*)(LG + c), m5 = *(const LAS f32x4*)(m + c);
#pragma unroll
                for (int e = 0; e < 4; ++e) { xv[q][j][e] += m5[e] * (y[q][j][e] * rstd * gg[e]); ss2 += xv[q][j][e] * xv[q][j][e]; } }
            if (l == 0) {
                const float rstd2 = rsqrtf(wave_sum(ss2) * (1.0f / D) + EPS);
#pragma unroll
                for (int j = 0; j < 4; ++j) { const int c = 4 * lane + 256 * j; st_xrow(XSW, r, c, xv[q][j]);
                    const f32x4 gg = *(const LAS f32x4*)(LG + 1024 + c), sh = *(const LAS f32x4*)(m + 1024 + c), sc = *(const LAS f32x4*)(m + 2048 + c); f32x4 o;
#pragma unroll
                    for (int e = 0; e < 4; ++e) o[e] = xv[q][j][e] * rstd2 * gg[e] * (1.0f + sc[e]) + sh[e];
                    u32x2 w; w.x = cvt_pk_bf16(o[0], o[1]); w.y = cvt_pk_bf16(o[2], o[3]); *(u32x2*)(HW + (size_t)r * D + c) = w; }
            } else if (r < NLAT) {
#pragma unroll
                for (int j = 0; j < 4; ++j) *(f32x4*)(POUT + (size_t)r * D + 4 * lane + 256 * j) = xv[q][j];
            }
        }
#pragma unroll
        for (int q = 0; q < 2; ++q) {
#pragma unroll
            for (int k = 0; k < 4; ++k)
#pragma unroll
                for (int j = 0; j < 4; ++j) yb[q][k][j] = ybn[q][k][j];
#pragma unroll
            for (int j = 0; j < 4; ++j) xr[q][j] = xrn[q][j]; }
        ivc = ivn; gtc = gtn; ivn = iv2; gtn = gt2;
    }
#undef ROWC_GATHER
    __syncthreads();
}

#define XB_TMO      128
#define XB_XCNT(j)  (256  + 64 * (j))
#define XB_XSUB(j)  (1280 + 64 * (j))
#define XB_XGEN(j)  (2304 + 64 * (j))
#define XB_TOP      3328
#define XB_TOPGEN   3392
#define XB_SPIN_CAP (1u << 22)
DEV unsigned xb_ld(unsigned* p)              { return __hip_atomic_load(p, __ATOMIC_RELAXED, __HIP_MEMORY_SCOPE_AGENT); }
DEV unsigned xb_add(unsigned* p, unsigned v) { return __hip_atomic_fetch_add(p, v, __ATOMIC_RELAXED, __HIP_MEMORY_SCOPE_AGENT); }
DEV unsigned xb_xcc_id() { return (unsigned)__builtin_amdgcn_s_getreg((3 << 11) | 20) & 0xFu; }
#define XB_SPIN(cond, bar) do { unsigned _sp = 0; while (cond) { __builtin_amdgcn_s_sleep(1); \
    if ((++_sp & 255u) == 0u) { if (xb_ld(&(bar)[XB_TMO])) break; if (_sp > XB_SPIN_CAP) { atomicAdd(&(bar)[XB_TMO], 1u); break; } } } } while (0)
DEV void xcd_barrier_complete(unsigned* bar, unsigned x, unsigned& nloc, unsigned& nx) {
    const unsigned G = gridDim.x;
    unsigned sum, cnt, mine, sp = 0u;
    for (;;) {
        sum = 0u; cnt = 0u; mine = 0u;
#pragma unroll
        for (unsigned j = 0; j < 16; ++j) { const unsigned c = xb_ld(&bar[XB_XCNT(j)]); sum += c; cnt += (c > 0u) ? 1u : 0u; mine = (j == x) ? c : mine; }
        if (sum == G) break;
        __builtin_amdgcn_s_sleep(1);
        if ((++sp & 255u) == 0u) { if (xb_ld(&bar[XB_TMO])) break; if (sp > XB_SPIN_CAP) { atomicAdd(&bar[XB_TMO], 1u); break; } }
    }
    nloc = mine > 0u ? mine : 1u; nx = cnt > 0u ? cnt : 1u;
}
DEV void xcd_barrier(unsigned* bar, unsigned x, volatile LAS unsigned* st, int tid) {
    asm volatile("" : "+s"(bar), "+s"(x));
    asm volatile("s_waitcnt vmcnt(0)" ::: "memory");
    __syncthreads();
    if (tid == 0) {
        __builtin_amdgcn_s_waitcnt(0);
        unsigned nloc = st[0], nx = st[1];
        if (nloc == 0u) { xcd_barrier_complete(bar, x, nloc, nx); st[0] = nloc; st[1] = nx; }
        const unsigned old = xb_add(&bar[XB_XSUB(x)], 1u);
        const unsigned gen = old / nloc;
        if (old + 1u == (gen + 1u) * nloc) {
            __builtin_amdgcn_fence(__ATOMIC_RELEASE, "agent");
            asm volatile("s_waitcnt vmcnt(0)" ::: "memory");
            const unsigned og = xb_add(&bar[XB_TOP], 1u);
            const unsigned tg = og / nx;
            if (og + 1u == (tg + 1u) * nx) xb_add(&bar[XB_TOPGEN], 1u);
            else XB_SPIN(xb_ld(&bar[XB_TOPGEN]) == tg, bar);
            __builtin_amdgcn_fence(__ATOMIC_ACQUIRE, "agent");
            xb_add(&bar[XB_XGEN(x)], 1u);
            asm volatile("s_waitcnt vmcnt(0)" ::: "memory");
        } else {
            XB_SPIN(xb_ld(&bar[XB_XGEN(x)]) == gen, bar);
            __builtin_amdgcn_fence(__ATOMIC_ACQUIRE, "agent");
            asm volatile("s_waitcnt vmcnt(0)" ::: "memory");
        }
    }
    __syncthreads();
}

DEV void relaunder(Ctx& X, int wave0, unsigned char* wsp) {
    int wv_ = wave0; asm volatile("" : "+s"(wv_)); int t_ = (wv_ << 6) | lane_fresh(); asm volatile("" : "+v"(t_)); X.tid = t_; X.lane = t_ & 63; X.wave = wv_;
    int g_ = gridDim.x, b_ = blockIdx.x; asm volatile("" : "+s"(g_), "+s"(b_)); X.G = g_; X.bid = b_;
    GAS unsigned char* w_ = (GAS unsigned char*)wsp; asm volatile("" : "+s"(w_)); X.ws = (unsigned char*)w_; X.ctl = (unsigned*)(X.ws + WS_CTL);
}

__global__ void __launch_bounds__(NTHREADS, 2) mega_fwd(Params P_) {
    extern __shared__ __attribute__((aligned(16))) unsigned char lds_raw[];
    const int wave0_ = rfl((int)threadIdx.x >> 6);
    Ctx X; X.lds = (LAS unsigned char*)lds_raw; X.tid = 0; X.lane = 0; X.wave = 0; X.G = gridDim.x; X.bid = blockIdx.x;
    X.ws = P_.ws; X.ctl = (unsigned*)(P_.ws + WS_CTL);
    cg::grid_group grid = cg::this_grid();
    unsigned* xbar = (unsigned*)(P_.ws + WS_CTL) + CW_BAR;
    volatile LAS unsigned* xst = (volatile LAS unsigned*)(X.lds + LDS_XST);
    const unsigned xcc = xb_xcc_id();
    { const int t0_ = (wave0_ << 6) | lane_fresh();
      if (t0_ < 2) xst[t0_] = 0u;
      if (t0_ == 0) (void)xb_add(&xbar[XB_XCNT(xcc)], 1u);
      __syncthreads(); }
    const int lo = P_.ph_lo, hi = P_.ph_hi;
    int ph = 0;
#ifdef DBG_ONLY
#define DBGSEL(k) if (DBG_ONLY == (k))
#else
#define DBGSEL(k)
#endif
#ifdef DBG_SUB
#define DSUB(k) if (DBG_SUB == (k))
#else
#define DSUB(k)
#endif
#define PH_BEGIN if (lo <= ph && ph < hi) { KParams* pp_ = (KParams*)__builtin_amdgcn_kernarg_segment_ptr(); asm volatile("" : "+s"(pp_)); KParams& P = *pp_; relaunder(X, wave0_, P.ws); ws = X.ws;
#ifndef PROBE_DUP
#define PROBE_DUP 0
#endif
#define REP(bit) for (int rep = 0; rep < (((PROBE_DUP) & (bit)) ? 2 : 1); ++rep) if (relaunder(X, wave0_, P.ws), true)
#define PH_END   if (ph + 1 < hi) { if (lo < 0) grid.sync();   xcd_barrier(xbar, xcc, xst, X.tid); if ((PROBE_DUP) & 512) xcd_barrier(xbar, xcc, xst, X.tid); } } ++ph;
    unsigned char* ws = P_.ws;
    PH_BEGIN DBGSEL(0) REP(1) { p0_prologue(P, X); __syncthreads(); } PH_END
    for (int l = 0; l < 2; ++l) {
        if (l == 0) { PH_BEGIN DBGSEL(1) REP(256) phase_rowA(P, X, 0); PH_END }
        PH_BEGIN DBGSEL(2) { g8::JobInProj J{(const bf16_t*)(ws + WS_H), (const bf16_t*)(ws + WS_WIN) + (size_t)l * 2304 * 1024, (bf16_t*)(ws + WS_IN7), (bf16_t*)(ws + WS_AX), (bf16_t*)(ws + WS_VT), (const LAS unsigned*)(X.lds + LDS_MISC), (const LAS unsigned*)(X.lds + LDS_MISC + 12288), X.G, X.bid};
                   { const f32x2* RT = (const f32x2*)(ws + WS_ROPE); LAS unsigned* TC = (LAS unsigned*)(X.lds + LDS_MISC); LAS unsigned* TR = (LAS unsigned*)(X.lds + LDS_MISC + 12288);
                     for (int i = X.tid; i < 320 * 16; i += NTHREADS) { const int k = i < 1024 ? i : i - 1024; const f32x2 cs = RT[k];
                         const unsigned pk = (unsigned)__builtin_bit_cast(unsigned short, (_Float16)cs.x) | ((unsigned)__builtin_bit_cast(unsigned short, (_Float16)cs.y) << 16);
                         if (i < 1024) TC[k] = pk; else TR[k] = pk; }
                     __syncthreads(); }
                   { const int full = (1170 / X.G) * X.G; if (full >= 910) J.hi = full; }
                   REP(2) g8::gemm_phase(X.lds, J, X.tid); } PH_END
        PH_BEGIN DBGSEL(3) { g8::JobS5<256> J{(const bf16_t*)(ws + WS_AX), (const bf16_t*)(ws + WS_S5B1) + (size_t)l * 16 * 256 * 256, (float*)(ws + WS_SL), nullptr, X.G, X.bid};
                   REP(4) { DSUB(1) g8::gemm_phase(X.lds, J, X.tid);
                            { const int full = (1170 / X.G) * X.G; const int j = X.G - 1 - X.bid;
                              if (full >= 910 && j < 1170 - full) { g8::JobInProj JV{(const bf16_t*)(ws + WS_H), (const bf16_t*)(ws + WS_WIN) + (size_t)l * 2304 * 1024, (bf16_t*)(ws + WS_IN7), (bf16_t*)(ws + WS_AX), (bf16_t*)(ws + WS_VT), nullptr, nullptr, 1 << 20, j, full, 1170};
                                  g8::gemm_phase(X.lds, JV, X.tid); relaunder(X, wave0_, P.ws); } }
                            DSUB(2) phase_lru(P, X, l, 1, (l * 2 + 0) * 2 + rep); } } PH_END
        PH_BEGIN DBGSEL(4) REP(8) phase_mix2(P, X, l, l * 2 + rep); PH_END
        PH_BEGIN DBGSEL(5) { g8::JobS5<512> J{(const bf16_t*)(ws + WS_AX), (const bf16_t*)(ws + WS_S5B2) + (size_t)l * 16 * 256 * 512, nullptr, (bf16_t*)(ws + WS_Z), X.G, X.bid};
                   g8::gemm_phase(X.lds, J, X.tid);
                   unsigned* dep = X.ctl + 9216 + 64 * (l * 9);
                   if (X.bid < 144 && X.tid == 0) { __builtin_amdgcn_fence(__ATOMIC_RELEASE, "agent"); asm volatile("s_waitcnt vmcnt(0)" ::: "memory");
                       __hip_atomic_fetch_add(dep + 64 * (X.bid % 9), 1u, __ATOMIC_RELAXED, __HIP_MEMORY_SCOPE_AGENT); }
                   if (X.bid < 130) { int pm_, pn_; (void)g8::dense_unit(X.bid, 130, 1, pm_, pn_);
                       if (X.tid == 0) { unsigned sp = 0; while (__hip_atomic_load(dep + 64 * (pm_ >> 4), __ATOMIC_RELAXED, __HIP_MEMORY_SCOPE_AGENT) < 16u && ++sp < (1u << 22)) __builtin_amdgcn_s_sleep(2);
                           __builtin_amdgcn_fence(__ATOMIC_ACQUIRE, "agent"); asm volatile("s_waitcnt vmcnt(0)" ::: "memory"); }
                       __syncthreads();
                       g8::JobGlu JG{(const bf16_t*)(ws + WS_Z), (const bf16_t*)(ws + WS_WGLU) + (size_t)l * 256 * 256, PIN(25) + l * 256, (bf16_t*)(ws + WS_MIX), X.G, X.bid};
                       g8::gemm_phase(X.lds, JG, X.tid); }
                   phase_lru(P, X, l, 2, (l * 2 + 1) * 2); } PH_END
        PH_BEGIN DBGSEL(7) { g8::JobOut J{(const bf16_t*)(ws + WS_MIX), (const bf16_t*)(ws + WS_WOUT) + (size_t)l * 1024 * 1024, (bf16_t*)(ws + WS_MIXO), X.G, X.bid, (l == 0 && X.G < 32) ? 130 : 128};
                   REP(32) { g8::gemm_phase(X.lds, J, X.tid);
                             if (l == 0 && X.G >= 32 && X.bid < 32) { relaunder(X, wave0_, P.ws); g8::JobOutQ JQ{(const bf16_t*)(ws + WS_MIX), (const bf16_t*)(ws + WS_WOUT), (bf16_t*)(ws + WS_SL), X.bid}; g8::gemm_phase(X.lds, JQ, X.tid); } } } PH_END
        PH_BEGIN DBGSEL(8) phase_rowB(P, X, l); PH_END
        PH_BEGIN DBGSEL(9) { moe_table(X, l);
                   g8::JobGu J{ws + WS_H, ws + WS_WGU + (size_t)l * 32 * 2048 * 1024, PIN(30) + (size_t)l * 32 * 2048, (const int*)(ws + WS_LTOK), ws + WS_ACT,
                               (const volatile LAS int*)(X.lds + LDS_MISC), X.G, X.bid, X.lane};
                   REP(64) g8::gemm_phase(X.lds, J, X.tid); } PH_END
        PH_BEGIN DBGSEL(10) { moe_table(X, l);
                   g8::JobDown J{ws + WS_ACT, ws + WS_WDN + (size_t)l * 32 * 1024 * 1024, PIN(32) + (size_t)l * 32 * 1024, ws + WS_YB,
                                 (const volatile LAS int*)(X.lds + LDS_MISC), X.G, X.bid, X.lane};
                   REP(128) g8::gemm_phase(X.lds, J, X.tid); } PH_END
        PH_BEGIN DBGSEL(11) { if ((PROBE_DUP) & 2048) { phase_rowC(P, X, l, true); relaunder(X, wave0_, P.ws); } phase_rowC(P, X, l); } PH_END
    }
}
constexpr int N_PHASES = 20;

extern "C" void kernel_launch(void* const* d_in, const int* in_sizes, int n_in, void* d_out, int out_size, void* d_ws, size_t ws_size, hipStream_t stream) {
    static int grid = 0;
    if (grid == 0) {
        if (n_in != 33 || out_size != NLAT * D || ws_size < WS_END) { fprintf(stderr, "kernel_launch: unexpected shapes (n_in %d, out %d, ws %zu, need %zu)\n", n_in, out_size, ws_size, (size_t)WS_END); grid = -1; return; }
        int dev = 0, cus = 0, per_cu = 0;
        hipGetDevice(&dev); hipDeviceGetAttribute(&cus, hipDeviceAttributeMultiprocessorCount, dev);
        if (hipFuncSetAttribute((const void*)mega_fwd, hipFuncAttributeMaxDynamicSharedMemorySize, LDS_BYTES) != hipSuccess) { fprintf(stderr, "kernel_launch: hipFuncSetAttribute failed\n"); grid = -1; return; }
        hipOccupancyMaxActiveBlocksPerMultiprocessor(&per_cu, (const void*)mega_fwd, NTHREADS, LDS_BYTES);
        (void)hipGetLastError();
        if (per_cu < 1) { fprintf(stderr, "kernel_launch: occupancy query says %d blocks per CU\n", per_cu); }
        grid = cus;
        if (grid % 8 != 0) grid -= grid % 8;
    }
    if (grid < 0) return;
    hipMemsetAsync((char*)d_ws + WS_CTL, 0, CTL_BYTES, stream);
    Params p{};
    for (int i = 0; i < 33; ++i) p.in[i] = (const float*)d_in[i];
    p.out = (float*)d_out; p.ws = (unsigned char*)d_ws;
#if MK_PER_PHASE_LAUNCH
    for (int k = 0; k < N_PHASES; ++k) { p.ph_lo = k; p.ph_hi = k + 1; hipLaunchKernelGGL(mega_fwd, dim3(grid), dim3(NTHREADS), LDS_BYTES, stream, p); }
#else
    p.ph_lo = 0; p.ph_hi = N_PHASES;
    void* args[] = {&p};
    hipError_t e = hipLaunchCooperativeKernel((const void*)mega_fwd, dim3(grid), dim3(NTHREADS), args, LDS_BYTES, stream);
    if (e != hipSuccess) fprintf(stderr, "kernel_launch: cooperative launch failed: %s (grid %d)\n", hipGetErrorString(e), grid);
#endif
}
```

```cpp
#include <hip/hip_runtime.h>
#include <hip/hip_cooperative_groups.h>
#include <cstdio>
#include <cstdint>
namespace cg = cooperative_groups;

#ifndef MK_PER_PHASE_LAUNCH
#define MK_PER_PHASE_LAUNCH 0
#endif

#define DEV __device__ __forceinline__
#define LAS __attribute__((address_space(3)))
typedef unsigned short bf16_t;
typedef short bf16x8 __attribute__((ext_vector_type(8)));
typedef short s16x4 __attribute__((ext_vector_type(4)));
typedef float f32x4 __attribute__((ext_vector_type(4)));
typedef float f32x2 __attribute__((ext_vector_type(2)));
typedef unsigned u32x4 __attribute__((ext_vector_type(4)));
typedef unsigned u32x2 __attribute__((ext_vector_type(2)));

constexpr int D = 1024, SEQ = 16384, NLAT = 32768, CTXL = 256, NCTX = 512, NTOK = 33280;
constexpr int LD7 = 1792, COL_LU = 0, COL_LG = 256, COL_Q = 768, COL_K = 1280;
constexpr int NCHK = 2080, NCHKP = 2304;
constexpr int LCH = 520;
constexpr int NE = 32, NBMAX = 552, CAPROWS = NBMAX * 256;
constexpr float EPS = 1e-6f;
constexpr int NTHREADS = 512, NWAVES = 8;

constexpr size_t MiB = 1u << 20;
constexpr size_t al1(size_t x) { return (x + MiB - 1) & ~(MiB - 1); }
constexpr size_t WS_CTL = 0, CTL_BYTES = 64 * 1024;
constexpr size_t WS_MOD = 1 * MiB;
constexpr size_t WS_ROPE = WS_MOD + 256 * 1024;
constexpr size_t WS_LAM16 = WS_ROPE + 64 * 1024;
constexpr size_t WS_WRT = WS_LAM16 + 64 * 1024;
constexpr size_t WS_WLRU = WS_WRT + 128 * 1024;
constexpr size_t WS_WGLU = WS_WLRU + 256 * 1024;
constexpr size_t WS_S5B1 = 2 * MiB;
constexpr size_t WS_S5B2 = WS_S5B1 + 4 * MiB;
constexpr size_t WS_WIN = WS_S5B2 + 8 * MiB;
constexpr size_t WS_WOUT = WS_WIN + 9 * MiB;
constexpr size_t WS_WGU = WS_WOUT + 4 * MiB;
constexpr size_t WS_WDN = WS_WGU + 256 * MiB;
constexpr size_t WS_XS = WS_WDN + 128 * MiB;
constexpr size_t WS_H = WS_XS + al1((size_t)NTOK * D * 4);
constexpr size_t WS_IN7 = WS_H + al1((size_t)NTOK * D * 2);
constexpr size_t WS_VT = WS_IN7 + al1((size_t)NTOK * LD7 * 2);
constexpr size_t WS_AX = WS_VT + al1((size_t)512 * NTOK * 2);
constexpr size_t WS_SL = WS_AX + al1((size_t)16 * NCHKP * 512 * 2);
constexpr size_t WS_Z = WS_SL + al1((size_t)16 * NCHKP * 256 * 4);
constexpr size_t WS_MIX = WS_Z + al1((size_t)NTOK * 256 * 2);
constexpr size_t WS_MIXO = WS_MIX + al1((size_t)NTOK * D * 2);
constexpr size_t WS_LAGG = WS_MIXO + al1((size_t)NTOK * D * 2);
constexpr size_t WS_LCIN = WS_LAGG + al1((size_t)2 * LCH * 256 * 8);
constexpr size_t WS_LTOK = WS_LCIN + al1((size_t)2 * LCH * 256 * 4);
constexpr size_t WS_INV = WS_LTOK + al1((size_t)NE * NTOK * 4);
constexpr size_t WS_GATE = WS_INV + al1((size_t)NTOK * 16);
constexpr size_t WS_ACT = WS_GATE + al1((size_t)NTOK * 16);
constexpr size_t WS_YB = WS_ACT + al1((size_t)CAPROWS * D * 2);
constexpr size_t WS_WIN8 = WS_YB + al1((size_t)CAPROWS * D * 2);
constexpr size_t WS_END = WS_WIN8 + al1((size_t)2 * 1536 * 1024);
constexpr size_t WS_H8 = WS_ACT;
constexpr int CW_CNT = 0;
constexpr int CW_WQ = 256;
constexpr int CW_BAR = 12288;

constexpr int LDS_STAGE = 131072, LDS_MISC = LDS_STAGE, LDS_BYTES = 163840, LDS_XST = 163776;

struct Params { const float* in[33]; float* out; unsigned char* ws; int ph_lo, ph_hi; };
#define GAS __attribute__((address_space(1)))
#define PIN(k) ((const float*)(const GAS float*)P.in[k])
#define POUT ((float*)(GAS float*)P.out)
typedef __attribute__((address_space(4))) const Params KParams;

DEV int rfl(int v) { return __builtin_amdgcn_readfirstlane(v); }
DEV int lane_fresh() { int t; asm volatile("v_mbcnt_lo_u32_b32 %0, -1, 0\n\tv_mbcnt_hi_u32_b32 %0, -1, %0" : "=v"(t)); return t; }
DEV float bf2f(unsigned v) { return __uint_as_float(v << 16); }
DEV unsigned cvt_pk_bf16(float lo, float hi) { unsigned r; asm("v_cvt_pk_bf16_f32 %0, %1, %2" : "=v"(r) : "v"(lo), "v"(hi)); return r; }
DEV float blo(unsigned w) { return __uint_as_float(w << 16); }
DEV float bhi(unsigned w) { return __uint_as_float(w & 0xffff0000u); }
DEV float wave_sum(float v) {
#pragma unroll
    for (int o = 1; o < 64; o <<= 1) v += __shfl_xor(v, o);
    return v;
}
DEV float sigmoidf_(float x) { return __builtin_amdgcn_rcpf(1.0f + __expf(-x)); }
DEV float gelu_tanh(float x) { const float u = 1.5957691216057308f * (x + 0.044715f * x * x * x); return x * __builtin_amdgcn_rcpf(1.0f + __expf(-u)); }
DEV float silu_(float x) { return x * __builtin_amdgcn_rcpf(1.0f + __expf(-x)); }
DEV void sincos_red(float ang, float& c, float& s) {
    const float k = rintf(ang * 0.15915494309189535f);
    float r = fmaf(-k, 6.2831854820251465f, ang);
    r = fmaf(-k, -1.7484555e-7f, r);
    c = __cosf(r); s = __sinf(r);
}
#define LDS_WAIT() asm volatile("s_waitcnt lgkmcnt(0)" ::: "memory")

namespace g8 {
constexpr int BM = 256, BK = 64, HALF = 128, HTB = HALF * BK * 2;
DEV void stage_rc(int b, int& R, int& C) { const int st = b / 1024, sb = b % 1024, swz = sb ^ (((sb >> 9) & 1) << 5); R = (st >> 1) * 16 + swz / 64; C = (st & 1) * 32 + (swz % 64) / 2; }
DEV int lds_byte(int r, int c) { const int st = (r >> 4) * 2 + (c >> 5), rr = r & 15, cc = c & 31, ob = rr * 64 + cc * 2; return st * 1024 + (ob ^ (((ob >> 9) & 1) << 5)); }
DEV int f8_swz(int r) { return ((r >> 1) & 1) | (((r >> 3) & 1) << 2); }
DEV void stage_rc_f8(int b, int& R, int& C) { R = b >> 7; C = (((b >> 4) & 7) ^ f8_swz(R & 15)) * 8; }
DEV int lds_byte_f8(int r, int piece) { return r * 128 + ((piece ^ f8_swz(r & 15)) << 4); }
DEV int perm32(int rho) { const int n = rho >> 4, i = rho & 15; return 8 * (i >> 2) + 4 * n + (i & 3); }

struct Unit { int pm, pn, e, x; };
typedef int v8i __attribute__((ext_vector_type(8)));
DEV v8i cat8(const bf16x8& a, const bf16x8& b) { typedef int v4i __attribute__((ext_vector_type(4))); const v4i x = __builtin_bit_cast(v4i, a), y = __builtin_bit_cast(v4i, b); return __builtin_shufflevector(x, y, 0, 1, 2, 3, 4, 5, 6, 7); }

template <class T, class = void> struct NtOf { static constexpr int v = T::K / 64; };
template <class T> struct NtOf<T, decltype((void)T::NT)> { static constexpr int v = T::NT; };
template <class T, class = void> struct PreOf { static constexpr bool v = false; static constexpr int nst = 0; };
template <class T> struct PreOf<T, decltype((void)T::NST)> { static constexpr bool v = true; static constexpr int nst = T::NST; };
constexpr int PRE_LTOK = 12288, PRE_BIAS = 13312;
template <class T>
DEV void gemm_phase(LAS unsigned char* lds, const T& tr, int tid) {
    const int wid = rfl(tid >> 6), lane = tid & 63, wr = wid >> 2, wc = wid & 3, fr = lane & 15, fq = lane >> 4;
    constexpr int K = T::K, nt = NtOf<T>::v;
    unsigned voffB[2];
#pragma unroll
    for (int i = 0; i < 2; ++i) { int R_, C_; if constexpr (T::FP8) stage_rc_f8(tid * 16 + i * 8192, R_, C_); else stage_rc(tid * 16 + i * 8192, R_, C_); const int Rb = (R_ & ~31) + perm32(R_ & 31); voffB[i] = (unsigned)(Rb * K + C_) * 2u; }
    const size_t hstepB = (size_t)HALF * K * 2;
    const unsigned ldsw = (unsigned)wid * 1024u;
    constexpr bool F8 = T::FP8; constexpr int KOFF = F8 ? 16 : 1024;
    const int aoff = F8 ? lds_byte_f8(wr * 64 + fr, 2 * fq) : lds_byte(wr * 64 + fr, fq * 8), boff = F8 ? lds_byte_f8(wc * 32 + fr, 2 * fq) : lds_byte(wc * 32 + fr, fq * 8);
    const int aoff1 = aoff ^ 16, boff1 = boff ^ 16;
#define G8_SA(b, h) (((b) * 2 + (h)) * HTB)
#define G8_SB(b, h) ((4 + (b) * 2 + (h)) * HTB)
#define G8_STAGE(bufoff, gbase, voff) do { _Pragma("unroll") for (int _i = 0; _i < 2; ++_i) \
        __builtin_amdgcn_global_load_lds((const unsigned*)((const char*)(gbase) + (voff)[_i]), (LAS unsigned*)(lds + (bufoff) + ldsw + _i * 8192), 16, 0, 0); } while (0)
#define G8_LDA(dst, b, h) do { if constexpr (F8) { _Pragma("unroll") for (int m = 0; m < 4; ++m) { dst##8[m].lo = *(const LAS v4i*)(lds + G8_SA(b, h) + aoff + m * 2048); dst##8[m].hi = *(const LAS v4i*)(lds + G8_SA(b, h) + aoff1 + m * 2048); } } \
        else { _Pragma("unroll") for (int m = 0; m < 4; ++m) _Pragma("unroll") for (int k = 0; k < 2; ++k) dst[m][k] = *(const LAS bf16x8*)(lds + G8_SA(b, h) + aoff + m * 2048 + k * KOFF); } } while (0)
#define G8_LDB(dst, b, h) do { if constexpr (F8) { _Pragma("unroll") for (int n = 0; n < 2; ++n) { dst##8[n].lo = *(const LAS v4i*)(lds + G8_SB(b, h) + boff + n * 2048); dst##8[n].hi = *(const LAS v4i*)(lds + G8_SB(b, h) + boff1 + n * 2048); } } \
        else { _Pragma("unroll") for (int n = 0; n < 2; ++n) _Pragma("unroll") for (int k = 0; k < 2; ++k) dst[n][k] = *(const LAS bf16x8*)(lds + G8_SB(b, h) + boff + n * 2048 + k * KOFF); } } while (0)
#define G8_MMA(ai, bj, At, Bt) do { __builtin_amdgcn_s_setprio(1); _Pragma("unroll") for (int m = 0; m < 4; ++m) _Pragma("unroll") for (int n = 0; n < 2; ++n) { \
        if constexpr (F8) asm volatile("v_mfma_scale_f32_16x16x128_f8f6f4 %0, %1, %2, %0, %3, %3 op_sel_hi:[0,0,0]" : "+v"(acc[ai][bj][m][n]) : "v"(Bt##8[n]), "v"(At##8[m]), "v"(sc1)); \
        else { _Pragma("unroll") for (int k = 0; k < 2; ++k) acc[ai][bj][m][n] = __builtin_amdgcn_mfma_f32_16x16x32_bf16(Bt[n][k], At[m][k], acc[ai][bj][m][n], 0, 0, 0); } } __builtin_amdgcn_s_setprio(0); } while (0)
#define G8_WAIT_V(n) asm volatile("s_waitcnt vmcnt(" #n ")" ::: "memory")
#define G8_WAIT_L(n) asm volatile("s_waitcnt lgkmcnt(" #n ")" ::: "memory")
#define G8_BAR __builtin_amdgcn_s_barrier()
#define G8_SCHED __builtin_amdgcn_sched_barrier(0)
    Unit cur, nxt; int ui = 0;
    if (!tr.unit(0, cur)) return;
    f32x4 acc[2][2][4][2];
#pragma unroll
    for (int a = 0; a < 2; ++a)
#pragma unroll
        for (int b = 0; b < 2; ++b)
#pragma unroll
            for (int m = 0; m < 4; ++m)
#pragma unroll
                for (int n = 0; n < 2; ++n) acc[a][b][m][n] = (f32x4){0.f, 0.f, 0.f, 0.f};
    typedef int v4i __attribute__((ext_vector_type(4)));
    const int sc1 = 0x7f7f7f7f;
    bf16x8 At[F8 ? 1 : 4][2], B0[F8 ? 1 : 2][2], B1[F8 ? 1 : 2][2];
    v8i At8[F8 ? 4 : 1], B08[F8 ? 2 : 1], B18[F8 ? 2 : 1];
    unsigned ca0[2], ca1[2];
    constexpr bool PRE = PreOf<T>::v; constexpr int NST = PreOf<T>::nst;
#define G8_PRE(u, par) do { if constexpr (PRE) __builtin_amdgcn_global_load_lds(tr.pre_src(u, wid, lane), (LAS unsigned*)(lds + LDS_MISC + tr.pre_dst(wid, par)), 4, 0, 0); } while (0)
#define G8_WAIT_VN(n) asm volatile("s_waitcnt vmcnt(%0)" :: "n"(n) : "memory")
    { int tl_ = tid; asm volatile("" : "+v"(tl_)); int Rr[2], Cc[2]; if constexpr (T::FP8) { stage_rc_f8(tl_ * 16, Rr[0], Cc[0]); stage_rc_f8(tl_ * 16 + 8192, Rr[1], Cc[1]); } else { stage_rc(tl_ * 16, Rr[0], Cc[0]); stage_rc(tl_ * 16 + 8192, Rr[1], Cc[1]); } tr.aoffs(cur, Rr, Cc, ca0, ca1); }
    const char* cAb = tr.abase(cur); const char* cB = tr.bptr(cur);
    G8_PRE(cur, 0);
    G8_STAGE(G8_SB(0, 0), cB, voffB); G8_STAGE(G8_SB(0, 1), cB + hstepB, voffB); G8_STAGE(G8_SA(0, 0), cAb, ca0); G8_STAGE(G8_SA(0, 1), cAb, ca1);
    if (wr == 1) G8_BAR;
    G8_WAIT_V(2); G8_BAR;
    G8_STAGE(G8_SB(1, 0), cB + 128, voffB); G8_STAGE(G8_SA(1, 0), cAb + 128, ca0); G8_STAGE(G8_SB(1, 1), cB + hstepB + 128, voffB);
    G8_WAIT_V(6); G8_BAR;
    for (;;) {
        const bool has_next = tr.unit(ui + 1, nxt);
        const char* nAb = cAb; const char* nB = cB;
        if constexpr (PRE) { if (has_next) { nAb = tr.abase(nxt); nB = tr.bptr(nxt); G8_PRE(nxt, (ui + 1) & 1); } else G8_PRE(cur, (ui + 1) & 1); }
        else {
            unsigned na0[2], na1[2];
            if (has_next) { int tl_ = tid; asm volatile("" : "+v"(tl_)); int Rr[2], Cc[2]; if constexpr (T::FP8) { stage_rc_f8(tl_ * 16, Rr[0], Cc[0]); stage_rc_f8(tl_ * 16 + 8192, Rr[1], Cc[1]); } else { stage_rc(tl_ * 16, Rr[0], Cc[0]); stage_rc(tl_ * 16 + 8192, Rr[1], Cc[1]); } tr.aoffs(nxt, Rr, Cc, na0, na1); nAb = tr.abase(nxt); nB = tr.bptr(nxt); }
            else { na0[0] = ca0[0]; na0[1] = ca0[1]; na1[0] = ca1[0]; na1[1] = ca1[1]; }
            *(LAS u32x4*)(lds + LDS_MISC + 4096 + tid * 16) = (u32x4){na0[0], na0[1], na1[0], na1[1]};
        }
#pragma unroll 1
        for (int t = 0; t < nt; t += 2) {
            const bool last = (t == nt - 2);
            const bool relax = PRE && t == 0;
            const char* a1 = cAb + (size_t)(t + 1) * 128;
            const char* a2 = last ? nAb : cAb + (size_t)(t + 2) * 128; const char* b2 = last ? nB : cB + (size_t)(t + 2) * 128;
            const char* a3 = a2 + 128; const char* b3 = b2 + 128;
            G8_LDB(B0, 0, 0); G8_LDB(B1, 0, 1); G8_SCHED; G8_LDA(At, 0, 0); G8_STAGE(G8_SA(1, 1), a1, ca1);
            if (last) {
                if constexpr (PRE) { if (has_next) { int tl_ = tid; asm volatile("" : "+v"(tl_)); int Rr[2], Cc[2]; stage_rc_f8(tl_ * 16, Rr[0], Cc[0]); stage_rc_f8(tl_ * 16 + 8192, Rr[1], Cc[1]); tr.aoffs_lds(nxt, Rr, Cc, ca0, ca1, lds + LDS_MISC + PRE_LTOK); } }
                else { const u32x4 nx = *(const LAS u32x4*)(lds + LDS_MISC + 4096 + tid * 16); ca0[0] = nx.x; ca0[1] = nx.y; ca1[0] = nx.z; ca1[1] = nx.w; } }
            if (relax) { if (ui > 0) G8_WAIT_VN(9 + NST); else G8_WAIT_VN(9); } else G8_WAIT_V(8);
            G8_WAIT_L(0); G8_BAR; G8_MMA(0, 0, At, B0); G8_MMA(0, 1, At, B1); G8_BAR; G8_SCHED;
            G8_LDA(At, 0, 1); G8_STAGE(G8_SB(0, 0), b2, voffB); G8_STAGE(G8_SB(0, 1), b2 + hstepB, voffB); G8_STAGE(G8_SA(0, 0), a2, ca0);
            if (relax) { if (ui > 0) G8_WAIT_VN(9 + NST); else G8_WAIT_VN(9); } else G8_WAIT_V(8);
            G8_WAIT_L(0); G8_BAR; G8_MMA(1, 0, At, B0); G8_MMA(1, 1, At, B1); G8_BAR; G8_SCHED;
            G8_LDB(B0, 1, 0); G8_LDB(B1, 1, 1); G8_SCHED; G8_LDA(At, 1, 0); G8_STAGE(G8_SA(0, 1), a2, ca1);
            G8_WAIT_V(8); G8_WAIT_L(0); G8_BAR; G8_MMA(0, 0, At, B0); G8_MMA(0, 1, At, B1); G8_BAR; G8_SCHED;
            G8_LDA(At, 1, 1); G8_STAGE(G8_SB(1, 0), b3, voffB); G8_STAGE(G8_SB(1, 1), b3 + hstepB, voffB); G8_STAGE(G8_SA(1, 0), a3, ca0);
            G8_WAIT_V(8); G8_WAIT_L(0); G8_BAR; G8_MMA(1, 0, At, B0); G8_MMA(1, 1, At, B1); G8_BAR; G8_SCHED;
        }
        if (wr == 0) G8_BAR;
        if constexpr (F8) asm volatile("s_nop 15\n\ts_nop 15" ::: "memory");
        if constexpr (PRE) tr.epi(acc, cur, wr, wc, fr, fq, (const LAS float*)(lds + LDS_MISC + PRE_BIAS + (ui & 1) * 1024)); else tr.epi(acc, cur, wr, wc, fr, fq);
        if (!has_next) break;
#pragma unroll
        for (int a = 0; a < 2; ++a)
#pragma unroll
            for (int b = 0; b < 2; ++b)
#pragma unroll
                for (int m = 0; m < 4; ++m)
#pragma unroll
                    for (int n = 0; n < 2; ++n) acc[a][b][m][n] = (f32x4){0.f, 0.f, 0.f, 0.f};
        cur = nxt; cAb = nAb; cB = nB; ++ui;
        if (wr == 1) G8_BAR;
    }
    G8_WAIT_V(0);
    G8_BAR;
#undef G8_PRE
#undef G8_WAIT_VN
#undef G8_SA
#undef G8_SB
#undef G8_STAGE
#undef G8_LDA
#undef G8_LDB
#undef G8_MMA
#undef G8_WAIT_V
#undef G8_WAIT_L
#undef G8_BAR
#undef G8_SCHED
}

DEV bool dense_unit(int L, int nM, int nN, int& pm, int& pn) {
    const int nwg = nM * nN; if (L >= nwg) return false;
    int wgid = L; { const int q = nwg / 8, r = nwg % 8, xcd = wgid % 8, off = wgid / 8; wgid = (xcd < r ? xcd * (q + 1) : r * (q + 1) + (xcd - r) * q) + off; }
    const int nig = 8 * nN, gid = wgid / nig, fm = gid * 8, gsz = (nM - fm) < 8 ? (nM - fm) : 8;
    pm = fm + ((wgid % nig) % gsz); pn = (wgid % nig) / gsz; return true;
}
DEV void dense_aoffs(int pm, int lda, const int (&R)[2], const int (&C)[2], unsigned (&a0)[2], unsigned (&a1)[2]) {
#pragma unroll
    for (int i = 0; i < 2; ++i) { a0[i] = (unsigned)((pm * 256 + R[i]) * lda + C[i]) * 2u; a1[i] = (unsigned)((pm * 256 + 128 + R[i]) * lda + C[i]) * 2u; }
}
DEV unsigned pk_fp8x4(float a, float b, float c, float d) {
    a = fminf(fmaxf(a, -448.f), 448.f); b = fminf(fmaxf(b, -448.f), 448.f); c = fminf(fmaxf(c, -448.f), 448.f); d = fminf(fmaxf(d, -448.f), 448.f);
    unsigned w = 0; w = __builtin_amdgcn_cvt_pk_fp8_f32(a, b, w, false); w = __builtin_amdgcn_cvt_pk_fp8_f32(c, d, w, true); return w; }
DEV unsigned pk_fp8x4_nc(float a, float b, float c, float d) { unsigned w = 0; w = __builtin_amdgcn_cvt_pk_fp8_f32(a, b, w, false); w = __builtin_amdgcn_cvt_pk_fp8_f32(c, d, w, true); return w; }
DEV u32x4 pack8(const f32x4& v0, const f32x4& v1) { u32x4 w; w.x = cvt_pk_bf16(v0[0], v0[1]); w.y = cvt_pk_bf16(v0[2], v0[3]); w.z = cvt_pk_bf16(v1[0], v1[1]); w.w = cvt_pk_bf16(v1[2], v1[3]); return w; }

template <bool F8_> struct JobInProjT {
    static constexpr int K = F8_ ? 512 : 1024; static constexpr bool FP8 = F8_; static constexpr int ES = F8_ ? 1 : 2;
    const unsigned char* H; const unsigned char* Win;
    bf16_t* IN7; bf16_t* AX; bf16_t* VT; const LAS unsigned* TC; const LAS unsigned* TR; int G, c; int mode = 0, lo = 0, hi = 1170;
    DEV bool unit(int i, Unit& u) const {
        int L;
        if (mode == 0) { L = lo + i * G + c; if (L >= hi) return false; if (L < 910) { u.x = 0; return dense_unit(L, 130, 7, u.pm, u.pn); } u.x = 1; return dense_unit(L - 910, 2, 130, u.pm, u.pn); }
        if (mode == 1) { L = i * G + c; if (L >= 390) return false; u.x = 0; return dense_unit(L, 130, 3, u.pm, u.pn); }
        if (mode == 2) { if (i < 2) L = i * 256 + c; else { if (c < 134 || i >= 4) return false; L = 512 + (i - 2) * 122 + (c - 134); } }
        else { if (i > 0) return false; L = lo + c; if (L >= 780) return false; }
        if (L < 520) { u.x = 0; const bool ok = dense_unit(L, 130, 4, u.pm, u.pn); u.pn += 3; return ok; }
        u.x = 1; return dense_unit(L - 520, 2, 130, u.pm, u.pn);
    }
    DEV void aoffs(const Unit& u, const int (&R)[2], const int (&C)[2], unsigned (&a0)[2], unsigned (&a1)[2]) const { dense_aoffs(u.pm, K, R, C, a0, a1); }
    DEV const char* abase(const Unit& u) const { return u.x ? (const char*)(Win + (size_t)(F8_ ? 1024 : 1792) * 1024 * ES) : (const char*)H; }
    DEV const char* bptr(const Unit& u) const { return u.x ? (const char*)(H + (size_t)u.pn * 256 * 1024 * ES) : (const char*)(Win + (size_t)(u.pn * 256 - (F8_ ? 768 : 0)) * 1024 * ES); }
    DEV void epi(const f32x4 (&acc)[2][2][4][2], const Unit& u, int wr, int wc, int fr, int fq) const {
        const bool isq = !u.x && (u.pn == 3 || u.pn == 4);
        const bool rope = !u.x && u.pn >= 3 && u.pm < 128;
#pragma unroll
        for (int ai = 0; ai < 2; ++ai)
#pragma unroll
            for (int m = 0; m < 4; ++m) {
                const int row = u.pm * 256 + ai * 128 + wr * 64 + m * 16 + fr;
                u32x4 csp[2];
                if (rope) { const int tl = row & (SEQ - 1); const LAS unsigned* t = ((wc & 1) ? TC + (tl & 63) * 16 : TR + (tl >> 6) * 16) + 8 * (fq & 1);
                    csp[0] = *(const LAS u32x4*)t; csp[1] = *(const LAS u32x4*)(t + 4); }
#pragma unroll
                for (int bj = 0; bj < 2; ++bj) {
                    const int cl = bj * 128 + wc * 32 + 8 * fq;
                    f32x4 v0 = acc[ai][bj][m][0], v1 = acc[ai][bj][m][1];
                    if constexpr (F8_) { v0 = v0 * (1.0f / 512.0f); v1 = v1 * (1.0f / 512.0f); }
                    unsigned char* qdst = (unsigned char*)(IN7 + (size_t)row * LD7 + COL_Q + (u.pn - 3) * 256 + bj * 128 + (wc >> 1) * 64) + fq * 32 + (wc & 1) * 8;
                    if (isq) { u32x2 w8; w8.x = pk_fp8x4(v0[0], v0[1], v0[2], v0[3]); w8.y = pk_fp8x4(v1[0], v1[1], v1[2], v1[3]); *(u32x2*)qdst = w8; }
                    if (rope) {
#pragma unroll
                        for (int n = 0; n < 2; ++n) { f32x4& v = n ? v1 : v0; const u32x4 cp = csp[n]; const unsigned cw[4] = {cp.x, cp.y, cp.z, cp.w}; float c[4], s[4];
#pragma unroll
                            for (int j = 0; j < 4; ++j) { c[j] = (float)__builtin_bit_cast(_Float16, (unsigned short)(cw[j] & 0xffffu)); s[j] = (float)__builtin_bit_cast(_Float16, (unsigned short)(cw[j] >> 16)); }
#pragma unroll
                            for (int j = 0; j < 4; ++j) { const float pv = __shfl_xor(v[j], 32); v[j] = fq < 2 ? v[j] * c[j] - pv * s[j] : v[j] * c[j] + pv * s[j]; } } }
                    if (isq) { if (rope) { u32x2 w8; w8.x = pk_fp8x4(v0[0], v0[1], v0[2], v0[3]); w8.y = pk_fp8x4(v1[0], v1[1], v1[2], v1[3]); *(u32x2*)(qdst + 16) = w8; } continue; }
                    if (u.x || u.pn >= 5) {
                        u32x2 w8; w8.x = pk_fp8x4(v0[0], v0[1], v0[2], v0[3]); w8.y = pk_fp8x4(v1[0], v1[1], v1[2], v1[3]);
                        unsigned char* d8 = u.x ? (unsigned char*)VT + ((size_t)((u.pn * 256 + cl) >> 3) * 512 + row) * 8
                                                : (unsigned char*)(IN7 + (size_t)row * LD7 + COL_K) + (u.pn - 5) * 256 + cl;
                        *(u32x2*)d8 = w8; continue; }
                    const u32x4 w = pack8(v0, v1);
                    bf16_t* dst;
                    if (u.x) dst = VT + ((size_t)((u.pn * 256 + cl) >> 3) * 512 + row) * 8;
                    else if (u.pn == 2) dst = AX + ((size_t)((cl >> 4) * NCHKP + (row >> 4)) * 512 + (row & 15) * 16 + (cl & 15));
                    else dst = IN7 + (size_t)row * LD7 + (u.pn < 2 ? u.pn * 256 : 768 + (u.pn - 3) * 256) + cl;
                    *(u32x4*)dst = w;
                }
            }
    }
};
using JobInProj = JobInProjT<false>; using JobInProj8 = JobInProjT<true>;
template <int KK> struct JobS5 {
    static constexpr int K = KK; static constexpr bool FP8 = false;
    const bf16_t* AX; const bf16_t* Bt; float* SL; bf16_t* Z; int G, c;
    DEV bool unit(int i, Unit& u) const { const int L = i * G + c; if (L >= 144) return false; u.e = L / 9; u.pm = L % 9; u.pn = 0; u.x = 0; return true; }
    DEV void aoffs(const Unit& u, const int (&R)[2], const int (&C)[2], unsigned (&a0)[2], unsigned (&a1)[2]) const { dense_aoffs(u.pm, 512, R, C, a0, a1); }
    DEV const char* abase(const Unit& u) const { return (const char*)(AX + (size_t)u.e * NCHKP * 512); }
    DEV const char* bptr(const Unit& u) const { return (const char*)(Bt + (size_t)u.e * 256 * KK); }
    DEV void epi(const f32x4 (&acc)[2][2][4][2], const Unit& u, int wr, int wc, int fr, int fq) const {
#pragma unroll
        for (int ai = 0; ai < 2; ++ai)
#pragma unroll
            for (int m = 0; m < 4; ++m) {
                const int row = u.pm * 256 + ai * 128 + wr * 64 + m * 16 + fr;
#pragma unroll
                for (int bj = 0; bj < 2; ++bj) {
                    const int cl = bj * 128 + wc * 32 + 8 * fq;
                    if (KK == 256) {
                        float* dst = SL + ((size_t)(u.e * NCHKP + row) * 256 + cl);
                        *(f32x4*)dst = acc[ai][bj][m][0]; *(f32x4*)(dst + 4) = acc[ai][bj][m][1];
                    } else if (row < NCHK) {
                        f32x4 v0 = acc[ai][bj][m][0], v1 = acc[ai][bj][m][1];
#pragma unroll
                        for (int j = 0; j < 4; ++j) { v0[j] = gelu_tanh(v0[j]); v1[j] = gelu_tanh(v1[j]); }
                        bf16_t* dst = Z + ((size_t)(row * 16 + (cl >> 4)) * 256 + u.e * 16 + (cl & 15));
                        *(u32x4*)dst = pack8(v0, v1);
                    }
                }
            }
    }
};
struct JobGlu {
    static constexpr int K = 256; static constexpr bool FP8 = false;
    const bf16_t* Z; const bf16_t* Bt; const float* bias; bf16_t* MIX; int G, c;
    DEV bool unit(int i, Unit& u) const { u.x = 0; u.e = 0; return dense_unit(i * G + c, 130, 1, u.pm, u.pn); }
    DEV void aoffs(const Unit& u, const int (&R)[2], const int (&C)[2], unsigned (&a0)[2], unsigned (&a1)[2]) const { dense_aoffs(u.pm, 256, R, C, a0, a1); }
    DEV const char* abase(const Unit&) const { return (const char*)Z; }
    DEV const char* bptr(const Unit&) const { return (const char*)Bt; }
    DEV void epi(const f32x4 (&acc)[2][2][4][2], const Unit& u, int wr, int wc, int fr, int fq) const {
#pragma unroll
        for (int bj = 0; bj < 2; ++bj) {
            const int cl = bj * 128 + wc * 32 + 8 * fq;
            const f32x4 b0 = *(const f32x4*)(bias + cl), b1 = *(const f32x4*)(bias + cl + 4);
#pragma unroll
            for (int ai = 0; ai < 2; ++ai)
#pragma unroll
                for (int m = 0; m < 4; ++m) {
                    const int row = u.pm * 256 + ai * 128 + wr * 64 + m * 16 + fr;
                    const u32x4 zz = *(const u32x4*)(Z + (size_t)row * 256 + cl);
                    f32x4 v0 = acc[ai][bj][m][0] + b0, v1 = acc[ai][bj][m][1] + b1;
                    v0[0] = blo(zz.x) * sigmoidf_(v0[0]); v0[1] = bhi(zz.x) * sigmoidf_(v0[1]); v0[2] = blo(zz.y) * sigmoidf_(v0[2]); v0[3] = bhi(zz.y) * sigmoidf_(v0[3]);
                    v1[0] = blo(zz.z) * sigmoidf_(v1[0]); v1[1] = bhi(zz.z) * sigmoidf_(v1[1]); v1[2] = blo(zz.w) * sigmoidf_(v1[2]); v1[3] = bhi(zz.w) * sigmoidf_(v1[3]);
#ifdef DIAG_GLU_CONST
                    v0 = (f32x4){0.5f * blo(zz.x), 0.5f * bhi(zz.x), 0.5f * blo(zz.y), 0.5f * bhi(zz.y)}; v1 = (f32x4){0.5f * blo(zz.z), 0.5f * bhi(zz.z), 0.5f * blo(zz.w), 0.5f * bhi(zz.w)};
#endif
#ifdef DIAG_S5_ZERO
                    v0 = (f32x4){0.f, 0.f, 0.f, 0.f}; v1 = v0;
#endif
                    *(u32x4*)(MIX + (size_t)row * 1024 + 256 + cl) = pack8(v0, v1);
                }
        }
    }
};
struct JobOut {
    static constexpr int K = 1024; static constexpr bool FP8 = false;
    const bf16_t* MIX; const bf16_t* Bt; bf16_t* MIXO; int G, c, nM;
    DEV bool unit(int i, Unit& u) const { u.x = 0; u.e = 0; return dense_unit(i * G + c, nM, 4, u.pm, u.pn); }
    DEV void aoffs(const Unit& u, const int (&R)[2], const int (&C)[2], unsigned (&a0)[2], unsigned (&a1)[2]) const { dense_aoffs(u.pm, 1024, R, C, a0, a1); }
    DEV const char* abase(const Unit&) const { return (const char*)MIX; }
    DEV const char* bptr(const Unit& u) const { return (const char*)(Bt + (size_t)u.pn * 256 * 1024); }
    DEV void epi(const f32x4 (&acc)[2][2][4][2], const Unit& u, int wr, int wc, int fr, int fq) const {
#pragma unroll
        for (int ai = 0; ai < 2; ++ai)
#pragma unroll
            for (int m = 0; m < 4; ++m) {
                const int row = u.pm * 256 + ai * 128 + wr * 64 + m * 16 + fr;
#pragma unroll
                for (int bj = 0; bj < 2; ++bj) {
                    const int cl = u.pn * 256 + bj * 128 + wc * 32 + 8 * fq;
                    *(u32x4*)(MIXO + (size_t)row * 1024 + cl) = pack8(acc[ai][bj][m][0], acc[ai][bj][m][1]);
                }
            }
    }
};
struct JobOutQ {
    static constexpr int K = 1024; static constexpr bool FP8 = false; static constexpr int NT = 4;
    const bf16_t* MIX; const bf16_t* Bt; bf16_t* PART; int c;
    DEV bool unit(int i, Unit& u) const { u.x = 0; u.e = c & 3; u.pm = 128 + (c >> 4); u.pn = (c >> 2) & 3; return i == 0; }
    DEV void aoffs(const Unit& u, const int (&R)[2], const int (&C)[2], unsigned (&a0)[2], unsigned (&a1)[2]) const { dense_aoffs(u.pm, 1024, R, C, a0, a1); }
    DEV const char* abase(const Unit& u) const { return (const char*)(MIX + u.e * 256); }
    DEV const char* bptr(const Unit& u) const { return (const char*)(Bt + (size_t)u.pn * 256 * 1024 + u.e * 256); }
    DEV void epi(const f32x4 (&acc)[2][2][4][2], const Unit& u, int wr, int wc, int fr, int fq) const {
#pragma unroll
        for (int ai = 0; ai < 2; ++ai)
#pragma unroll
            for (int m = 0; m < 4; ++m) {
                const int row = (u.pm - 128) * 256 + ai * 128 + wr * 64 + m * 16 + fr;
#pragma unroll
                for (int bj = 0; bj < 2; ++bj) {
                    const int cl = u.pn * 256 + bj * 128 + wc * 32 + 8 * fq;
                    *(u32x4*)(PART + ((size_t)u.e * 512 + row) * 1024 + cl) = pack8(acc[ai][bj][m][0], acc[ai][bj][m][1]);
                }
            }
    }
};
template <int NT> DEV bool moe_unit(int i, int G, int c, const volatile LAS int* bs, int lane_unused, Unit& u) {
    const int lane = lane_fresh();
    const int total = bs[32] * NT, per = (total + 7) >> 3, j = i * (G >> 3) + (c >> 3);
    if (j >= per) return false;
    const int up = (c & 7) * per + j; if (up >= total) return false;
    const int rb = up / NT; u.pn = up % NT; u.pm = rb;
    const unsigned long long m = __ballot(lane < 32 && bs[(lane & 31) + 1] <= rb);
    u.e = __popcll(m); u.x = (rb - bs[u.e]) * 256;
    return true;
}
struct JobGu {
    static constexpr int K = 512; static constexpr bool FP8 = true;
    const unsigned char* F8; const unsigned char* Wgu; const float* bgu; const int* ltok; unsigned char* ACT; const volatile LAS int* bs; int G, c, lane;
    DEV bool unit(int i, Unit& u) const { return moe_unit<8>(i, G, c, bs, lane, u); }
    DEV void aoffs(const Unit& u, const int (&R)[2], const int (&C)[2], unsigned (&a0)[2], unsigned (&a1)[2]) const {
        const int cnt = bs[33 + u.e];
#pragma unroll
        for (int i = 0; i < 2; ++i) {
            const int p0 = u.x + R[i], p1 = p0 + 128;
            const int t0 = p0 < cnt ? ltok[(size_t)u.e * NTOK + p0] : 0, t1 = p1 < cnt ? ltok[(size_t)u.e * NTOK + p1] : 0;
            a0[i] = (unsigned)(t0 * 512 + C[i]) * 2u; a1[i] = (unsigned)(t1 * 512 + C[i]) * 2u;
        }
    }
    static constexpr int NST = 4;
    DEV const unsigned* pre_src(const Unit& u, int wid, int lane) const {
        if (wid < 4) return (const unsigned*)(ltok + (size_t)u.e * NTOK + u.x + wid * 64 + lane);
        const int i = (wid - 4) * 64 + lane; return (const unsigned*)(bgu + (size_t)u.e * 2048 + u.pn * 128 + (i < 128 ? i : 1024 + i - 128)); }
    DEV int pre_dst(int wid, int par) const { return wid < 4 ? PRE_LTOK + wid * 256 : PRE_BIAS + par * 1024 + (wid - 4) * 256; }
    DEV void aoffs_lds(const Unit& u, const int (&R)[2], const int (&C)[2], unsigned (&a0)[2], unsigned (&a1)[2], const LAS unsigned char* lt) const {
        const int cnt = bs[33 + u.e];
#pragma unroll
        for (int i = 0; i < 2; ++i) {
            const int p0 = u.x + R[i], p1 = p0 + 128;
            const int v0 = ((const LAS int*)lt)[R[i]], v1 = ((const LAS int*)lt)[R[i] + 128];
            const int t0 = p0 < cnt ? v0 : 0, t1 = p1 < cnt ? v1 : 0;
            a0[i] = (unsigned)(t0 * 512 + C[i]) * 2u; a1[i] = (unsigned)(t1 * 512 + C[i]) * 2u;
        }
    }
    DEV const char* abase(const Unit&) const { return (const char*)F8; }
    DEV const char* bptr(const Unit& u) const { return (const char*)(Wgu + ((size_t)u.e * 2048 + u.pn * 256) * 1024); }
    DEV void epi(const f32x4 (&acc)[2][2][4][2], const Unit& u, int wr, int wc, int fr, int fq, const LAS float* bias) const {
        const int cl = wc * 32 + 8 * fq;
        const LAS float* bg = bias + cl;
        const f32x4 g0 = *(const LAS f32x4*)bg, g1 = *(const LAS f32x4*)(bg + 4), l0 = *(const LAS f32x4*)(bg + 128), l1 = *(const LAS f32x4*)(bg + 132);
        constexpr float SC = 1.0f / 512.0f;
        const bool odd = fq & 1;
#pragma unroll
        for (int ai = 0; ai < 2; ++ai)
#pragma unroll
            for (int mp = 0; mp < 2; ++mp) {
                u32x2 w2[2];
#pragma unroll
                for (int mm = 0; mm < 2; ++mm) { const int m = 2 * mp + mm;
                    f32x4 a0 = acc[ai][0][m][0] * SC + g0, a1 = acc[ai][0][m][1] * SC + g1, b0 = acc[ai][1][m][0] * SC + l0, b1 = acc[ai][1][m][1] * SC + l1;
#pragma unroll
                    for (int j = 0; j < 4; ++j) {
                        float gl = fminf(a0[j], 7.0f), li = fminf(fmaxf(b0[j], -7.0f), 7.0f); a0[j] = (gl * __builtin_amdgcn_rcpf(1.0f + __builtin_amdgcn_exp2f(gl * -2.45546695959f))) * fmaf(li, 4.0f, 4.0f);
                        gl = fminf(a1[j], 7.0f); li = fminf(fmaxf(b1[j], -7.0f), 7.0f); a1[j] = (gl * __builtin_amdgcn_rcpf(1.0f + __builtin_amdgcn_exp2f(gl * -2.45546695959f))) * fmaf(li, 4.0f, 4.0f);
                    }
                    w2[mm].x = pk_fp8x4_nc(a0[0], a0[1], a0[2], a0[3]); w2[mm].y = pk_fp8x4_nc(a1[0], a1[1], a1[2], a1[3]); }
                const u32x2 snd = odd ? w2[0] : w2[1]; u32x2 rcv; rcv.x = (unsigned)__shfl_xor((int)snd.x, 16); rcv.y = (unsigned)__shfl_xor((int)snd.y, 16);
                const u32x2 own = odd ? w2[1] : w2[0];
                const u32x4 o = odd ? (u32x4){rcv.x, rcv.y, own.x, own.y} : (u32x4){own.x, own.y, rcv.x, rcv.y};
                const int row = u.pm * 256 + ai * 128 + wr * 64 + (2 * mp + (odd ? 1 : 0)) * 16 + fr;
                *(u32x4*)(ACT + (size_t)row * 1024 + u.pn * 128 + wc * 32 + 16 * (fq >> 1)) = o;
            }
    }
};
struct JobDown {
    static constexpr int K = 512; static constexpr bool FP8 = true;
    const unsigned char* ACT; const unsigned char* Wdn; const float* bdn; unsigned char* YB; const volatile LAS int* bs; int G, c, lane;
    DEV bool unit(int i, Unit& u) const { return moe_unit<4>(i, G, c, bs, lane, u); }
    DEV void aoffs(const Unit& u, const int (&R)[2], const int (&C)[2], unsigned (&a0)[2], unsigned (&a1)[2]) const { dense_aoffs(u.pm, 512, R, C, a0, a1); }
    DEV const char* abase(const Unit&) const { return (const char*)ACT; }
    DEV const char* bptr(const Unit& u) const { return (const char*)(Wdn + ((size_t)u.e * 1024 + u.pn * 256) * 1024); }
    static constexpr int NST = 8;
    DEV const unsigned* pre_src(const Unit& u, int wid, int lane) const { return (const unsigned*)(bdn + (size_t)u.e * 1024 + u.pn * 256 + (wid & 3) * 64 + lane); }
    DEV int pre_dst(int wid, int par) const { return wid < 4 ? PRE_LTOK + wid * 256 : PRE_BIAS + par * 1024 + (wid - 4) * 256; }
    DEV void aoffs_lds(const Unit& u, const int (&R)[2], const int (&C)[2], unsigned (&a0)[2], unsigned (&a1)[2], const LAS unsigned char*) const { dense_aoffs(u.pm, 512, R, C, a0, a1); }
    DEV void epi(const f32x4 (&acc)[2][2][4][2], const Unit& u, int wr, int wc, int fr, int fq, const LAS float* bias) const {
        constexpr float SC = 1.0f / 256.0f;
#pragma unroll
        for (int bj = 0; bj < 2; ++bj) {
            const int cl = u.pn * 256 + bj * 128 + wc * 32 + 8 * fq;
            const LAS float* bp = bias + bj * 128 + wc * 32 + 8 * fq;
            const f32x4 b0 = *(const LAS f32x4*)bp, b1 = *(const LAS f32x4*)(bp + 4);
            const bool odd = fq & 1;
#pragma unroll
            for (int ai = 0; ai < 2; ++ai)
#pragma unroll
                for (int mp = 0; mp < 2; ++mp) {
                    u32x2 w2[2];
#pragma unroll
                    for (int mm = 0; mm < 2; ++mm) { const int m = 2 * mp + mm;
                        const f32x4 y0 = (acc[ai][bj][m][0] * SC + b0) * 16.0f, y1 = (acc[ai][bj][m][1] * SC + b1) * 16.0f;
                        w2[mm].x = pk_fp8x4(y0[0], y0[1], y0[2], y0[3]); w2[mm].y = pk_fp8x4(y1[0], y1[1], y1[2], y1[3]); }
                    const u32x2 snd = odd ? w2[0] : w2[1]; u32x2 rcv; rcv.x = (unsigned)__shfl_xor((int)snd.x, 16); rcv.y = (unsigned)__shfl_xor((int)snd.y, 16);
                    const u32x2 own = odd ? w2[1] : w2[0];
                    const u32x4 o = odd ? (u32x4){rcv.x, rcv.y, own.x, own.y} : (u32x4){own.x, own.y, rcv.x, rcv.y};
                    const int row = u.pm * 256 + ai * 128 + wr * 64 + (2 * mp + (odd ? 1 : 0)) * 16 + fr;
                    *(u32x4*)(YB + (size_t)row * 1024 + u.pn * 256 + bj * 128 + wc * 32 + 16 * (fq >> 1)) = o;
                }
        }
    }
};
}

struct Ctx {
    LAS unsigned char* lds; int tid, lane, wave, G, bid;
    unsigned char* ws; unsigned* ctl;
};
DEV const float* row_src0(KParams& P, int r) { return r < NLAT ? PIN(0) + (size_t)r * D : PIN(2) + (size_t)(r - NLAT) * D; }
DEV int mod_sel(int r) { return r < SEQ ? 0 : (r < NLAT ? 1 : 2); }

DEV void p0_transpose_item(const float* W, int N, bf16_t* WT, int ldt, LAS float* scr, int k0, int n0, int drow0, int lane) {
#pragma unroll 8
    for (int i = 0; i < 32; ++i) { const int kk = 2 * i + (lane >> 5); scr[kk * 33 + (lane & 31)] = W[(size_t)(k0 + kk) * N + n0 + (lane & 31)]; }
    LDS_WAIT();
    const int c = lane & 7;
#pragma unroll
    for (int j = 0; j < 4; ++j) { const int n = (lane >> 3) + 8 * j; const LAS float* s = scr + (8 * c) * 33 + n;
        u32x4 o; o.x = cvt_pk_bf16(s[0 * 33], s[1 * 33]); o.y = cvt_pk_bf16(s[2 * 33], s[3 * 33]); o.z = cvt_pk_bf16(s[4 * 33], s[5 * 33]); o.w = cvt_pk_bf16(s[6 * 33], s[7 * 33]);
        *(u32x4*)(WT + (size_t)(drow0 + n) * ldt + k0 + 8 * c) = o; }
    LDS_WAIT();
}
struct F8Item { const float* src; unsigned char* dst; int N; };
DEV void p0_f8_load(const F8Item& d, f32x4 (&v)[16]) {
#pragma unroll
    for (int i = 0; i < 16; ++i) v[i] = *(const f32x4*)(d.src + (size_t)i * d.N);
}
DEV void p0_f8_finish(const F8Item& d, const f32x4 (&v)[16], float scale) {
    unsigned E[4][4];
#pragma unroll
    for (int kq = 0; kq < 4; ++kq) {
        unsigned Dw[4];
#pragma unroll
        for (int r = 0; r < 4; ++r) { const f32x4 x = v[4 * kq + r] * scale; Dw[r] = g8::pk_fp8x4(x[0], x[1], x[2], x[3]); }
        const unsigned a = __builtin_amdgcn_perm(Dw[1], Dw[0], 0x05010400u), bb = __builtin_amdgcn_perm(Dw[1], Dw[0], 0x07030602u);
        const unsigned c = __builtin_amdgcn_perm(Dw[3], Dw[2], 0x05010400u), dd = __builtin_amdgcn_perm(Dw[3], Dw[2], 0x07030602u);
        E[0][kq] = __builtin_amdgcn_perm(c, a, 0x05040100u); E[1][kq] = __builtin_amdgcn_perm(c, a, 0x07060302u);
        E[2][kq] = __builtin_amdgcn_perm(dd, bb, 0x05040100u); E[3][kq] = __builtin_amdgcn_perm(dd, bb, 0x07060302u);
    }
#pragma unroll
    for (int j = 0; j < 4; ++j) *(u32x4*)(d.dst + (size_t)j * 1024) = (u32x4){E[j][0], E[j][1], E[j][2], E[j][3]};
}
DEV F8Item p0_f8_desc(KParams& P, Ctx& X, int r) {
    const int lane = X.lane, kg = lane >> 3, n4 = lane & 7; F8Item d;
    if (r < 32768) { const int mtx = r >> 9, q = r & 511, kb = q >> 6, nb = q & 63, n0 = nb * 32, half = n0 >> 10, nn = n0 & 1023, drow = (nn >> 7) * 256 + half * 128 + (nn & 127);
        d.N = 2048; d.src = PIN(29) + (size_t)mtx * 1024 * 2048 + (size_t)(kb * 128 + 16 * kg) * 2048 + n0 + 4 * n4;
        d.dst = X.ws + WS_WGU + (size_t)mtx * 2048 * 1024 + (size_t)(drow + 4 * n4) * 1024 + kb * 128 + 16 * kg; }
    else if (r >= 49152) { const int r3 = r - 49152, mtx = r3 / 384, q = r3 % 384, kb = q / 48, nb = q % 48;
        d.N = 2304; d.src = PIN(7) + (size_t)mtx * 1024 * 2304 + (size_t)(kb * 128 + 16 * kg) * 2304 + 768 + nb * 32 + 4 * n4;
        d.dst = X.ws + WS_WIN8 + (size_t)mtx * 1536 * 1024 + (size_t)(nb * 32 + 4 * n4) * 1024 + kb * 128 + 16 * kg; }
    else { const int r2 = r - 32768, mtx = r2 >> 8, q = r2 & 255, kb = q >> 5, nb = q & 31;
        d.N = 1024; d.src = PIN(31) + (size_t)mtx * 1024 * 1024 + (size_t)(kb * 128 + 16 * kg) * 1024 + nb * 32 + 4 * n4;
        d.dst = X.ws + WS_WDN + (size_t)mtx * 1024 * 1024 + (size_t)(nb * 32 + 4 * n4) * 1024 + kb * 128 + 16 * kg; }
    return d;
}
DEV void p0_transpose_item_f8(const float* W, int N, unsigned char* WT, int k0, int n0, int drow0, int lane, float scale) {
    const int kg = lane >> 3, n4 = lane & 7; F8Item d; d.N = N; d.src = W + (size_t)(k0 + 16 * kg) * N + n0 + 4 * n4; d.dst = WT + (size_t)(drow0 + 4 * n4) * 1024 + k0 + 16 * kg;
    f32x4 v[16]; p0_f8_load(d, v); p0_f8_finish(d, v, scale);
}
DEV void p0_s5_setup(KParams& P, Ctx& X, int l, int g) {
    LAS f32x2* LAM = (LAS f32x2*)X.lds; LAS f32x2* BBAR = LAM + 2 * 64 * 17; LAS f32x2* CC = BBAR + 2 * 64 * 16; LAS float* KF = (LAS float*)(CC + 2 * 16 * 64);
    const int tid = X.tid;
    if (tid < 128) {
        const int d = tid >> 6, p = tid & 63; const size_t gi = ((size_t)(l * 2 + d) * 16 + g);
        const float are = PIN(16)[gi * 64 + p], aim = PIN(17)[gi * 64 + p], dt = __expf(PIN(18)[gi]);
        const float mag = __expf(are * dt); float cs, sn; sincos_red(aim * dt, cs, sn);
        const float ar = mag * cs, ai = mag * sn;
        float pr = 1.f, pi = 0.f;
        for (int t = 0; t <= 16; ++t) { LAM[(d * 64 + p) * 17 + t] = (f32x2){pr, pi}; const float nr = pr * ar - pi * ai, ni = pr * ai + pi * ar; pr = nr; pi = ni; }
        const float den = are * are + aim * aim, nr1 = ar - 1.0f;
        const float cr = (nr1 * are + ai * aim) / den, ci = (ai * are - nr1 * aim) / den;
        for (int h = 0; h < 16; ++h) { const float br = PIN(19)[(gi * 64 + p) * 16 + h], bi = PIN(20)[(gi * 64 + p) * 16 + h];
            BBAR[(d * 64 + p) * 16 + h] = (f32x2){cr * br - ci * bi, cr * bi + ci * br}; }
        ((f32x2*)(X.ws + WS_LAM16))[gi * 64 + p] = LAM[(d * 64 + p) * 17 + 16];
    }
    for (int i = tid; i < 2048; i += NTHREADS) { const int d = i >> 10, h = (i >> 6) & 15, p = i & 63; const size_t gi = ((size_t)(l * 2 + d) * 16 + g);
        CC[i] = (f32x2){PIN(21)[(gi * 16 + h) * 64 + p], PIN(22)[(gi * 16 + h) * 64 + p]}; }
    __syncthreads();
    for (int i = tid; i < 8192; i += NTHREADS) {
        const int d = i >> 12, tau = (i >> 8) & 15, h = (i >> 4) & 15, hp = i & 15; float s = 0.f;
        for (int p = 0; p < 64; ++p) { const f32x2 c = CC[(d * 16 + h) * 64 + p], lm = LAM[(d * 64 + p) * 17 + tau], b = BBAR[(d * 64 + p) * 16 + hp];
            const float gr = c.x * lm.x - c.y * lm.y, gi2 = c.x * lm.y + c.y * lm.x; s += gr * b.x - gi2 * b.y; }
        KF[i] = s;
    }
    __syncthreads();
    bf16_t* B1 = (bf16_t*)(X.ws + WS_S5B1) + (size_t)(l * 16 + g) * 256 * 256;
    bf16_t* B2 = (bf16_t*)(X.ws + WS_S5B2) + (size_t)(l * 16 + g) * 256 * 512;
    const float* dsk = PIN(23) + l * 256 + g * 16;
    for (int i = tid; i < 256 * 128; i += NTHREADS) {
        const int row = i >> 7, k = (i & 127) * 2;
        const int ii = row >> 4, h = row & 15, j = k >> 4; float v[2];
#pragma unroll
        for (int q = 0; q < 2; ++q) { const int hp = (k & 15) + q; float s = 0.f;
            if (j <= ii) s += KF[((0 * 16 + (ii - j)) * 16 + h) * 16 + hp];
            if (j >= ii) s += KF[((1 * 16 + (j - ii)) * 16 + h) * 16 + hp];
            if (j == ii && h == hp) s += dsk[h];
            v[q] = s; }
        *(unsigned*)(B2 + (size_t)row * 512 + k) = cvt_pk_bf16(v[0], v[1]);
        { const int n = k; const int d = n >> 7, part = (n >> 6) & 1, p = n & 63; float w[2];
#pragma unroll
          for (int q = 0; q < 2; ++q) { const f32x2 c = CC[(d * 16 + h) * 64 + p + q], lm = LAM[(d * 64 + p + q) * 17 + (d == 0 ? ii + 1 : 16 - ii)];
              const float zr = c.x * lm.x - c.y * lm.y, zi = c.x * lm.y + c.y * lm.x; w[q] = part ? -zi : zr; }
          *(unsigned*)(B2 + (size_t)row * 512 + 256 + k) = cvt_pk_bf16(w[0], w[1]); }
        { const int n = row; const int d = n >> 7, part = (n >> 6) & 1, p = n & 63; float w[2];
#pragma unroll
          for (int q = 0; q < 2; ++q) { const f32x2 lm = LAM[(d * 64 + p) * 17 + (d == 0 ? 15 - j : j)], b = BBAR[(d * 64 + p) * 16 + (k & 15) + q];
              const float zr = lm.x * b.x - lm.y * b.y, zi = lm.x * b.y + lm.y * b.x; w[q] = part ? zi : zr; }
          *(unsigned*)(B1 + (size_t)row * 256 + k) = cvt_pk_bf16(w[0], w[1]); }
    }
    __syncthreads();
}
DEV void p0_mod_item(KParams& P, Ctx& X, int item) {
    const int l = item / 192, j0 = (item % 192) * 32;
    const float* W = PIN(4) + (size_t)l * 1024 * 6144;
    const int col = X.lane & 31, kh = X.lane >> 5, kb = X.wave * 128;
    float s0 = 0.f, s1 = 0.f, s2 = 0.f;
#pragma unroll 8
    for (int i = 0; i < 64; ++i) { const int k = kb + 2 * i + kh; const float w = W[(size_t)k * 6144 + j0 + col];
        s0 += silu_(PIN(1)[k]) * w; s1 += silu_(PIN(1)[1024 + k]) * w; s2 += silu_(PIN(3)[k]) * w; }
    LAS float* red = (LAS float*)X.lds;
    red[((X.wave * 2 + kh) * 32 + col) * 3 + 0] = s0; red[((X.wave * 2 + kh) * 32 + col) * 3 + 1] = s1; red[((X.wave * 2 + kh) * 32 + col) * 3 + 2] = s2;
    __syncthreads();
    if (X.tid < 96) { const int r = X.tid / 32, cc = X.tid % 32; float s = PIN(5)[l * 6144 + j0 + cc];
        for (int q = 0; q < 16; ++q) s += red[(q * 32 + cc) * 3 + r];
        ((float*)(X.ws + WS_MOD))[(size_t)(l * 3 + r) * 6144 + j0 + cc] = s; }
    __syncthreads();
}
DEV void p0_prologue(KParams& P, Ctx& X) {
    if (X.bid < 32) p0_s5_setup(P, X, X.bid >> 4, X.bid & 15);
    if (X.tid < 4) { const int g16 = X.bid & 15, kb = X.bid >> 4, nb16 = (X.G - g16 + 15) >> 4;
        __hip_atomic_store(X.ctl + CW_WQ + 64 * (32 + X.tid * 16 + g16) + kb, (unsigned)((130 * kb) / nb16) | ((unsigned)((130 * (kb + 1)) / nb16) << 16), __ATOMIC_RELAXED, __HIP_MEMORY_SCOPE_AGENT); }
    for (int it = X.bid; it < 384; it += X.G) p0_mod_item(P, X, it);
    if (X.bid == X.G - 2) { for (int i = X.tid; i < 1024; i += NTHREADS) ((float*)(X.ws + WS_MOD + 160 * 1024))[i] = log1pf(__expf(-PIN(15)[i])); }
    if (X.bid == X.G - 1) {
        for (int i = X.tid; i < 4096; i += NTHREADS) { const int pos = i >> 4, f = i & 15; const float inv = powf(10000.0f, -(float)f / 16.0f); float c, s; sincos_red((float)pos * inv, c, s);
            ((f32x2*)(X.ws + WS_ROPE))[i] = (f32x2){c, s}; }
    }
    LAS float* scr = (LAS float*)(X.lds + X.wave * 16384);
    const int gw = X.bid * NWAVES + X.wave, NGW = X.G * NWAVES;
    constexpr int I_GU = 8 * 64, I_DN = 8 * 32, I_IN = 16 * 72, I_OUT = 16 * 32, I_GLU = 4 * 8, I_R = 16, I_LRU = 2;
    constexpr int N_GU = 64 * I_GU, N_DN = 64 * I_DN, N_IN = 2 * I_IN, N_OUT = 2 * I_OUT, N_GLU = 2 * I_GLU, N_R = 2 * I_R, N_LRU = 32 * I_LRU;
    constexpr int I_IN8 = 8 * 48, N_IN8 = 2 * I_IN8;
    constexpr int NITEMS = N_GU + N_DN + N_IN + N_OUT + N_GLU + N_R + N_LRU + N_IN8;
    auto generic_item = [&](int it) {
        int r = it;
        if (r < N_GU) { const int mtx = r / I_GU, q = r % I_GU, kb = q / 64, nb = q % 64, n0 = nb * 32;
            const int half = n0 >> 10, nn = n0 & 1023, drow = (nn >> 7) * 256 + half * 128 + (nn & 127);
            p0_transpose_item_f8(PIN(29) + (size_t)mtx * 1024 * 2048, 2048, X.ws + WS_WGU + (size_t)mtx * 2048 * 1024, kb * 128, n0, drow, X.lane, 64.0f); return; } r -= N_GU;
        if (r < N_DN) { const int mtx = r / I_DN, q = r % I_DN, kb = q / 32, nb = q % 32;
            p0_transpose_item_f8(PIN(31) + (size_t)mtx * 1024 * 1024, 1024, X.ws + WS_WDN + (size_t)mtx * 1024 * 1024, kb * 128, nb * 32, nb * 32, X.lane, 64.0f); return; } r -= N_DN;
        r -= N_IN8;
        if (r < N_IN) { const int mtx = r / I_IN, q = r % I_IN, kb = q / 72, nb = q % 72;
            if (X.G == 256 && nb >= 24) return;
            p0_transpose_item(PIN(7) + (size_t)mtx * 1024 * 2304, 2304, (bf16_t*)(X.ws + WS_WIN) + (size_t)mtx * 2304 * 1024, 1024, scr, kb * 64, nb * 32, nb * 32, X.lane); return; } r -= N_IN;
        if (r < N_OUT) { const int mtx = r / I_OUT, q = r % I_OUT, kb = q / 32, nb = q % 32;
            p0_transpose_item(PIN(8) + (size_t)mtx * 1024 * 1024, 1024, (bf16_t*)(X.ws + WS_WOUT) + (size_t)mtx * 1024 * 1024, 1024, scr, kb * 64, nb * 32, nb * 32, X.lane); return; } r -= N_OUT;
        if (r < N_GLU) { const int mtx = r / I_GLU, q = r % I_GLU, kb = q / 8, nb = q % 8;
            p0_transpose_item(PIN(24) + (size_t)mtx * 256 * 256, 256, (bf16_t*)(X.ws + WS_WGLU) + (size_t)mtx * 256 * 256, 256, scr, kb * 64, nb * 32, nb * 32, X.lane); return; } r -= N_GLU;
        if (r < N_R) { const int mtx = r / I_R, kb = r % I_R;
            p0_transpose_item(PIN(27) + (size_t)mtx * 1024 * 32, 32, (bf16_t*)(X.ws + WS_WRT) + (size_t)mtx * 32 * 1024, 1024, scr, kb * 64, 0, 0, X.lane); return; } r -= N_R;
        { const int mtx = r / I_LRU, nb = r % I_LRU;
          const int n = mtx & 3, dir = (mtx >> 2) & 1, which = (mtx >> 3) & 1, l = mtx >> 4;
          const float* src = (which ? PIN(13) : PIN(11)) + (size_t)((l * 2 + dir) * 4 + n) * 64 * 64;
          bf16_t* dst = (bf16_t*)(X.ws + WS_WLRU) + (size_t)(l * 4 + n) * 256 * 64;
          p0_transpose_item(src, 64, dst, 64, scr, 0, nb * 32, (dir * 2 + which) * 64 + nb * 32, X.lane); }
    };
    constexpr int NFC = (N_GU + N_DN + N_IN8) / 8;
    for (int it = NFC * 8 + gw; it < NITEMS; it += NGW) generic_item(it);
    for (;;) {
      int chunk = 0; if (X.lane == 0) chunk = (int)atomicAdd(X.ctl + CW_WQ + 64 * 30, 1u); chunk = rfl(chunk);
      if (chunk >= NFC) break;
      if (chunk * 8 + 8 <= N_GU + N_DN + N_IN8) {
          f32x4 va[16], vb[16]; F8Item da = p0_f8_desc(P, X, chunk * 8), db; p0_f8_load(da, va);
#pragma unroll 1
          for (int i = 0; i < 8; i += 2) {
              db = p0_f8_desc(P, X, chunk * 8 + i + 1); p0_f8_load(db, vb);
              p0_f8_finish(da, va, 64.0f);
              if (i + 2 < 8) { da = p0_f8_desc(P, X, chunk * 8 + i + 2); p0_f8_load(da, va); }
              p0_f8_finish(db, vb, 64.0f);
          }
          continue;
      }
    }
}

DEV void rowA_one(const float* src, const float* g, const float* shift, const float* scale, bf16_t* dst, int lane) {
    f32x4 v[4]; float ss = 0.f;
#pragma unroll
    for (int j = 0; j < 4; ++j) { v[j] = *(const f32x4*)(src + 4 * lane + 256 * j); ss += v[j][0] * v[j][0] + v[j][1] * v[j][1] + v[j][2] * v[j][2] + v[j][3] * v[j][3]; }
    const float rstd = rsqrtf(wave_sum(ss) * (1.0f / D) + EPS);
#pragma unroll
    for (int j = 0; j < 4; ++j) { const int c = 4 * lane + 256 * j; const f32x4 gg = *(const f32x4*)(g + c), sh = *(const f32x4*)(shift + c), sc = *(const f32x4*)(scale + c);
        f32x4 o;
#pragma unroll
        for (int q = 0; q < 4; ++q) o[q] = v[j][q] * rstd * gg[q] * (1.0f + sc[q]) + sh[q];
        u32x2 w; w.x = cvt_pk_bf16(o[0], o[1]); w.y = cvt_pk_bf16(o[2], o[3]); *(u32x2*)(dst + c) = w; }
}
DEV void phase_rowA(KParams& P, Ctx& X, int l) {
    const int gw = X.bid * NWAVES + X.wave, NGW = X.G * NWAVES, lane = X.lane;
    const float* mod = (const float*)(X.ws + WS_MOD) + (size_t)l * 3 * 6144; const float* g = PIN(6) + (size_t)l * 4 * 1024;
    for (int r0 = gw * 2; r0 < NTOK; r0 += NGW * 2) {
        f32x4 v[2][4]; float ss[2] = {0.f, 0.f};
#pragma unroll
        for (int q = 0; q < 2; ++q) { const float* src = row_src0(P, r0 + q);
#pragma unroll
            for (int j = 0; j < 4; ++j) v[q][j] = *(const f32x4*)(src + 4 * lane + 256 * j); }
#pragma unroll
        for (int q = 0; q < 2; ++q)
#pragma unroll
            for (int j = 0; j < 4; ++j) ss[q] += v[q][j][0] * v[q][j][0] + v[q][j][1] * v[q][j][1] + v[q][j][2] * v[q][j][2] + v[q][j][3] * v[q][j][3];
#pragma unroll
        for (int q = 0; q < 2; ++q) { const float rstd = rsqrtf(wave_sum(ss[q]) * (1.0f / D) + EPS); const float* m = mod + mod_sel(r0 + q) * 6144; bf16_t* dst = (bf16_t*)(X.ws + WS_H) + (size_t)(r0 + q) * D;
#pragma unroll
            for (int j = 0; j < 4; ++j) { const int c = 4 * lane + 256 * j; const f32x4 gg = *(const f32x4*)(g + c), sh = *(const f32x4*)(m + c), sc = *(const f32x4*)(m + 1024 + c); f32x4 o;
#pragma unroll
                for (int e = 0; e < 4; ++e) o[e] = v[q][j][e] * rstd * gg[e] * (1.0f + sc[e]) + sh[e];
                u32x2 w; w.x = cvt_pk_bf16(o[0], o[1]); w.y = cvt_pk_bf16(o[2], o[3]); *(u32x2*)(dst + c) = w;
                *(unsigned*)(X.ws + WS_H8 + (size_t)(r0 + q) * D + c) = g8::pk_fp8x4(o[0] * 8.0f, o[1] * 8.0f, o[2] * 8.0f, o[3] * 8.0f); } }
    }
}

DEV void phase_krope(KParams& P, Ctx& X) {
    bf16_t* IN7 = (bf16_t*)(X.ws + WS_IN7); const f32x2* RT = (const f32x2*)(X.ws + WS_ROPE);
    const int nth = X.G * NTHREADS;
    for (int it = X.bid * NTHREADS + X.tid; it < NLAT * 32; it += nth) {
        const int tok = it >> 5, h = (it >> 2) & 7, s = (it >> 1) & 1, f8 = it & 1; const int tl = tok & (SEQ - 1), pos = s ? (tl & 63) : (tl >> 6);
        bf16_t* p = IN7 + (size_t)tok * LD7 + COL_K + h * 64 + s * 32 + f8 * 8;
        const u32x4 u1 = *(const u32x4*)p, u2 = *(const u32x4*)(p + 16);
        const unsigned a[4] = {u1.x, u1.y, u1.z, u1.w}, b[4] = {u2.x, u2.y, u2.z, u2.w}; unsigned o1[4], o2[4];
#pragma unroll
        for (int q = 0; q < 4; ++q) { const f32x2 t0 = RT[pos * 16 + f8 * 8 + 2 * q], t1 = RT[pos * 16 + f8 * 8 + 2 * q + 1];
            const float x0 = blo(a[q]), x1 = bhi(a[q]), y0 = blo(b[q]), y1 = bhi(b[q]);
            o1[q] = cvt_pk_bf16(x0 * t0.x - y0 * t0.y, x1 * t1.x - y1 * t1.y); o2[q] = cvt_pk_bf16(y0 * t0.x + x0 * t0.y, y1 * t1.x + x1 * t1.y); }
        *(u32x4*)p = (u32x4){o1[0], o1[1], o1[2], o1[3]}; *(u32x4*)(p + 16) = (u32x4){o2[0], o2[1], o2[2], o2[3]};
    }
}

DEV int wq_fetch_block(Ctx& X, int q) {
    volatile LAS int* slot = (volatile LAS int*)(X.lds + LDS_MISC + 1024);
    __syncthreads();
    if (X.tid == 0) slot[0] = (int)atomicAdd(X.ctl + CW_WQ + 64 * q, 1u);
    __syncthreads();
    return slot[0];
}
DEV void lru_load(Ctx& X, int c, int n, int pass, u32x4 (&cin)[4], u32x4& gv, float& hin) {
    const int tid = X.tid, ti = tid >> 3, c8 = tid & 7, ch0 = n * 64 + c8 * 8;
    const bf16_t* IN7 = (const bf16_t*)(X.ws + WS_IN7);
#pragma unroll
    for (int k = 0; k < 4; ++k) { int row = c * 64 + ti + k - 2; row = min(max(row, 0), NTOK - 1); cin[k] = *(const u32x4*)(IN7 + (size_t)row * LD7 + COL_LU + ch0); }
    if (pass == 2) {
        gv = *(const u32x4*)(IN7 + (size_t)(c * 64 + ti) * LD7 + COL_LG + ch0);
        hin = ((const float*)(X.ws + WS_LCIN))[((size_t)(tid >> 8) * LCH + c) * 256 + n * 64 + (tid & 63)]; }
}
constexpr int LRU_CONST = 10240;
DEV void lru_unit(KParams& P, Ctx& X, int l, int c, int n, int pass, const bf16x8 (&wf)[8][2], const u32x4 (&cin)[4], const u32x4& gvp, float hinp, int nn, volatile LAS int* slotw) {
    const int t0 = c * 64, tid = X.tid, lane = X.lane, wave = X.wave;
    const int tl0 = c < 512 ? (c & 255) * 64 : ((c - 512) & 3) * 64, seqlen = c < 512 ? SEQ : CTXL;
    const bf16_t* IN7 = (const bf16_t*)(X.ws + WS_IN7);
    LAS bf16_t* Cs = (LAS bf16_t*)X.lds;
    LAS f32x2* AB = (LAS f32x2*)(X.lds + 16384);
    LAS f32x2* SUB = (LAS f32x2*)(X.lds + 16384 + 65536);
    {
        const int ti = tid >> 3, c8 = tid & 7, ch0 = n * 64 + c8 * 8; float a[8];
        const LAS float* LC = (const LAS float*)(X.lds + LRU_CONST);
        { const f32x4 c0 = *(const LAS f32x4*)(LC + 256 + c8 * 8), c1 = *(const LAS f32x4*)(LC + 256 + c8 * 8 + 4); a[0] = c0[0]; a[1] = c0[1]; a[2] = c0[2]; a[3] = c0[3]; a[4] = c1[0]; a[5] = c1[1]; a[6] = c1[2]; a[7] = c1[3]; }
#pragma unroll
        for (int k = 0; k < 4; ++k) { const int tt = tl0 + ti + k - 2;
            if (tt >= 0 && tt < seqlen) { const u32x4 v = cin[k]; const f32x4 w0 = *(const LAS f32x4*)(LC + k * 64 + c8 * 8), w1 = *(const LAS f32x4*)(LC + k * 64 + c8 * 8 + 4); const float w[8] = {w0[0], w0[1], w0[2], w0[3], w1[0], w1[1], w1[2], w1[3]};
                a[0] += w[0] * blo(v.x); a[1] += w[1] * bhi(v.x); a[2] += w[2] * blo(v.y); a[3] += w[3] * bhi(v.y); a[4] += w[4] * blo(v.z); a[5] += w[5] * bhi(v.z); a[6] += w[6] * blo(v.w); a[7] += w[7] * bhi(v.w); } }
        u32x4 o; o.x = cvt_pk_bf16(a[0], a[1]); o.y = cvt_pk_bf16(a[2], a[3]); o.z = cvt_pk_bf16(a[4], a[5]); o.w = cvt_pk_bf16(a[6], a[7]);
        *(LAS u32x4*)(Cs + ti * 72 + c8 * 8) = o;
    }
    __syncthreads();
    {
        const int mt = wave & 3, dir = wave >> 2, fr = lane & 15, q4 = lane >> 4;
        bf16x8 af[2];
#pragma unroll
        for (int ks = 0; ks < 2; ++ks) af[ks] = *(const LAS bf16x8*)(Cs + (16 * mt + fr) * 72 + ks * 32 + q4 * 8);
        f32x4 acc[8];
#pragma unroll
        for (int t = 0; t < 8; ++t) { acc[t] = (f32x4){0.f, 0.f, 0.f, 0.f};
#pragma unroll
            for (int ks = 0; ks < 2; ++ks) acc[t] = __builtin_amdgcn_mfma_f32_16x16x32_bf16(af[ks], wf[t][ks], acc[t], 0, 0, 0); }
#pragma unroll
        for (int t = 0; t < 4; ++t) { const int chl = t * 16 + fr, ch = n * 64 + chl;
            const LAS float* GC = (const LAS float*)(X.lds + LRU_CONST) + 320 + dir * 192 + chl; (void)ch;
            const float ba = GC[0], bx = GC[64], sp = GC[128];
#pragma unroll
            for (int i = 0; i < 4; ++i) { const int tk = 16 * mt + 4 * q4 + i;
                const float r = __builtin_amdgcn_rcpf(1.0f + __builtin_amdgcn_exp2f(fmaf(acc[t][i], -1.44269504088896f, ba))), ig = __builtin_amdgcn_rcpf(1.0f + __builtin_amdgcn_exp2f(fmaf(acc[4 + t][i], -1.44269504088896f, bx)));
                const float a = __builtin_amdgcn_exp2f(r * sp);
                const float cv = bf2f(Cs[tk * 72 + chl]);
                AB[(dir * 64 + tk) * 64 + chl] = (f32x2){a, __builtin_amdgcn_sqrtf(fmaxf(1.0f - a * a, 0.0f)) * ig * cv}; } }
    }
    __syncthreads();
    const int sdir = tid >> 8, ssub = (tid >> 6) & 3, schl = tid & 63;
    {
        float A = 1.f, B = 0.f;
        if (sdir == 0) { for (int t = 16 * ssub; t < 16 * ssub + 16; ++t) { const f32x2 ab = AB[(0 * 64 + t) * 64 + schl]; A *= ab.x; B = ab.x * B + ab.y; } }
        else { for (int t = 16 * ssub + 15; t >= 16 * ssub; --t) { const f32x2 ab = AB[(1 * 64 + t) * 64 + schl]; A *= ab.x; B = ab.x * B + ab.y; } }
        SUB[(sdir * 4 + ssub) * 64 + schl] = (f32x2){A, B};
    }
    if (tid == 0) *slotw = nn;
    __syncthreads();
    if (pass == 1) {
        if (ssub == 0) { float A = 1.f, B = 0.f;
            for (int q = 0; q < 4; ++q) { const f32x2 s = SUB[(sdir * 4 + (sdir ? 3 - q : q)) * 64 + schl]; A *= s.x; B = s.x * B + s.y; }
            ((f32x2*)(X.ws + WS_LAGG))[((size_t)sdir * LCH + c) * 256 + n * 64 + schl] = (f32x2){A, B}; }
    } else {
        float h = hinp;
        if (sdir == 0) { for (int q = 0; q < ssub; ++q) { const f32x2 s = SUB[(0 * 4 + q) * 64 + schl]; h = s.x * h + s.y; }
            for (int t = 16 * ssub; t < 16 * ssub + 16; ++t) { const f32x2 ab = AB[(0 * 64 + t) * 64 + schl]; h = ab.x * h + ab.y; AB[(0 * 64 + t) * 64 + schl].x = h; } }
        else { for (int q = 3; q > ssub; --q) { const f32x2 s = SUB[(1 * 4 + q) * 64 + schl]; h = s.x * h + s.y; }
            for (int t = 16 * ssub + 15; t >= 16 * ssub; --t) { const f32x2 ab = AB[(1 * 64 + t) * 64 + schl]; h = ab.x * h + ab.y; AB[(1 * 64 + t) * 64 + schl].x = h; } }
        __syncthreads();
        const int ti = tid >> 3, c8 = tid & 7, ch0 = n * 64 + c8 * 8;
        const u32x4 gv = gvp; const unsigned gw[4] = {gv.x, gv.y, gv.z, gv.w}; unsigned o[4];
#pragma unroll
        for (int q = 0; q < 4; ++q) { const int cl = c8 * 8 + 2 * q;
            const float y0 = AB[(0 * 64 + ti) * 64 + cl].x + AB[(1 * 64 + ti) * 64 + cl].x, y1 = AB[(0 * 64 + ti) * 64 + cl + 1].x + AB[(1 * 64 + ti) * 64 + cl + 1].x;
            o[q] = cvt_pk_bf16(y0 * gelu_tanh(blo(gw[q])), y1 * gelu_tanh(bhi(gw[q]))); }
        *(u32x4*)((bf16_t*)(X.ws + WS_MIX) + (size_t)(t0 + ti) * 1024 + ch0) = (u32x4){o[0], o[1], o[2], o[3]};
    }
}
DEV void phase_lru(KParams& P, Ctx& X, int l, int pass, int q) {
    const int n = X.bid & 3, fr = X.lane & 15, q4 = X.lane >> 4, dir = X.wave >> 2;
    const bf16_t* Wt = (const bf16_t*)(X.ws + WS_WLRU) + (size_t)(l * 4 + n) * 256 * 64;
    bf16x8 wf[8][2];
#pragma unroll
    for (int t = 0; t < 8; ++t)
#pragma unroll
        for (int ks = 0; ks < 2; ++ks) wf[t][ks] = *(const bf16x8*)(Wt + (size_t)(dir * 128 + t * 16 + fr) * 64 + ks * 32 + q4 * 8);
    unsigned* head = X.ctl + CW_WQ + 64 * (100 + q * 4 + n);
    volatile LAS int* slot = (volatile LAS int*)(X.lds + LDS_MISC + 1024);
    { LAS float* LC = (LAS float*)(X.lds + LRU_CONST);
      for (int i = X.tid; i < 704; i += NTHREADS) { float v;
          if (i < 256) v = PIN(9)[(size_t)(l * 4 + (i >> 6)) * 256 + n * 64 + (i & 63)];
          else if (i < 320) v = PIN(10)[l * 256 + n * 64 + (i - 256)];
          else { const int j = i - 320, d = j / 192, wh = (j % 192) >> 6, ch = n * 64 + (j & 63);
              v = wh == 0 ? PIN(12)[(l * 2 + d) * 256 + ch] * -1.44269504088896f : wh == 1 ? PIN(14)[(l * 2 + d) * 256 + ch] * -1.44269504088896f
                          : ((const float*)(X.ws + WS_MOD + 160 * 1024))[(l * 2 + d) * 256 + ch] * (-8.0f * 1.44269504088896f); }
          LC[i] = v; } }
    __syncthreads();
    if (X.tid == 0) { slot[0] = (int)atomicAdd(head, 1u); slot[1] = (int)atomicAdd(head, 1u); }
    __syncthreads();
    int c = slot[0], cn = slot[1], par = 0;
    __syncthreads();
    u32x4 cin[4], cnx[4], gvc = (u32x4){0u, 0u, 0u, 0u}, gvn = (u32x4){0u, 0u, 0u, 0u}; float hc = 0.f, hn = 0.f;
    if (c < LCH) lru_load(X, c, n, pass, cin, gvc, hc);
    while (c < LCH) {
        int nn = 0; if (X.tid == 0) nn = (int)atomicAdd(head, 1u);
        if (cn < LCH) lru_load(X, cn, n, pass, cnx, gvn, hn);
        lru_unit(P, X, l, c, n, pass, wf, cin, gvc, hc, nn, slot + par);
        c = cn; cn = slot[par]; par ^= 1;
#pragma unroll
        for (int k = 0; k < 4; ++k) cin[k] = cnx[k];
        gvc = gvn; hc = hn;
    }
    __syncthreads();
}

DEV void lru_carry_block(Ctx& X, int wt) {
    const int b = wt >> 3, dir = (wt >> 2) & 1, ch = (wt & 3) * 64 + X.lane, w = X.wave;
    const f32x2* AGG = (const f32x2*)(X.ws + WS_LAGG) + (size_t)dir * LCH * 256 + ch; float* CIN = (float*)(X.ws + WS_LCIN) + (size_t)dir * LCH * 256 + ch;
    LAS f32x2* E = (LAS f32x2*)(X.lds + 65536);
    const int s0 = 33 * w, s1 = min(s0 + 33, 260);
    float A = 1.f, B = 0.f;
#pragma unroll 11
    for (int s = s0; s < s1; ++s) { const int cidx = dir == 0 ? (s < 4 ? 512 + b * 4 + s : b * 256 + (s - 4)) : (s < 4 ? 512 + b * 4 + (3 - s) : b * 256 + (259 - s));
        const f32x2 ab = AGG[(size_t)cidx * 256]; A *= ab.x; B = ab.x * B + ab.y; }
    E[w * 64 + X.lane] = (f32x2){A, B};
    __syncthreads();
    float h = 0.f;
    for (int j = 0; j < w; ++j) { const f32x2 e = E[j * 64 + X.lane]; h = e.x * h + e.y; }
#pragma unroll 11
    for (int s = s0; s < s1; ++s) { const int cidx = dir == 0 ? (s < 4 ? 512 + b * 4 + s : b * 256 + (s - 4)) : (s < 4 ? 512 + b * 4 + (3 - s) : b * 256 + (259 - s));
        const f32x2 ab = AGG[(size_t)cidx * 256]; CIN[(size_t)cidx * 256] = h; h = ab.x * h + ab.y; }
    __syncthreads();
}
DEV void s5_carry_block(Ctx& X, int l, int st) {
    const int b = st >> 5, dir = (st >> 4) & 1, g = st & 15, p = X.lane, w = X.wave;
    const f32x2 lm = ((const f32x2*)(X.ws + WS_LAM16))[((size_t)(l * 2 + dir) * 16 + g) * 64 + p];
    const float* SL = (const float*)(X.ws + WS_SL) + (size_t)g * NCHKP * 256 + dir * 128 + p; bf16_t* AX = (bf16_t*)(X.ws + WS_AX) + (size_t)g * NCHKP * 512 + 256 + dir * 128 + p;
    LAS f32x2* E = (LAS f32x2*)(X.lds + 65536);
    const int s0 = 130 * w;
    float xr = 0.f, xi = 0.f;
#pragma unroll 13
    for (int s = s0; s < s0 + 130; ++s) { const int cidx = dir == 0 ? (s < 16 ? 2048 + b * 16 + s : b * 1024 + (s - 16)) : (s < 16 ? 2048 + b * 16 + (15 - s) : b * 1024 + (1039 - s));
        const float sr = SL[(size_t)cidx * 256], si = SL[(size_t)cidx * 256 + 64];
        const float nr = lm.x * xr - lm.y * xi + sr, ni = lm.x * xi + lm.y * xr + si; xr = nr; xi = ni; }
    E[w * 64 + p] = (f32x2){xr, xi};
    float pr = 1.f, pi = 0.f;
    for (int k = 0; k < 130; ++k) { const float nr = pr * lm.x - pi * lm.y, ni = pr * lm.y + pi * lm.x; pr = nr; pi = ni; }
    __syncthreads();
    xr = 0.f; xi = 0.f;
    for (int j = 0; j < w; ++j) { const f32x2 e = E[j * 64 + p]; const float nr = pr * xr - pi * xi + e.x, ni = pr * xi + pi * xr + e.y; xr = nr; xi = ni; }
#pragma unroll 13
    for (int s = s0; s < s0 + 130; ++s) { const int cidx = dir == 0 ? (s < 16 ? 2048 + b * 16 + s : b * 1024 + (s - 16)) : (s < 16 ? 2048 + b * 16 + (15 - s) : b * 1024 + (1039 - s));
        const float sr = SL[(size_t)cidx * 256], si = SL[(size_t)cidx * 256 + 64];
        AX[(size_t)cidx * 512] = (bf16_t)(cvt_pk_bf16(xr, 0.f) & 0xffffu); AX[(size_t)cidx * 512 + 64] = (bf16_t)(cvt_pk_bf16(xi, 0.f) & 0xffffu);
        const float nr = lm.x * xr - lm.y * xi + sr, ni = lm.x * xi + lm.y * xr + si; xr = nr; xi = ni; }
    __syncthreads();
}

template <class T> DEV T ldg32(const void* base, unsigned off) { return *(const T*)((const char*)base + off); }
constexpr int A_CK = 2048, A_CV = A_CK + 256 * 80, A_LK = A_CV + 64 * 272, A_LV = A_LK + 576 * 80, A_NEG = A_LV + 64 * 880, A_END = A_NEG + 1024, A_SLOT = 160000;
static_assert(A_END <= A_SLOT, "attention LDS map");
DEV u32x2 cvt8_fp8(const u32x4& v) {
    u32x2 o; o.x = g8::pk_fp8x4_nc(blo(v.x), bhi(v.x), blo(v.y), bhi(v.y)); o.y = g8::pk_fp8x4_nc(blo(v.z), bhi(v.z), blo(v.w), bhi(v.w)); return o; }
typedef long i64_t;
DEV i64_t as_i64(const u32x2& v) { return __builtin_bit_cast(i64_t, v); }
DEV float max3f(float a, float b, float c) { float r; asm("v_max3_f32 %0, %1, %2, %3" : "=v"(r) : "v"(a), "v"(b), "v"(c)); return r; }
constexpr float ATT_C2 = 0.125f * 1.44269504088896f;
template <class HOOK> DEV void attn_tile(KParams& P, Ctx& X, int l, int b, int h, int r, int cb, bool lat, const u32x4& q0, const u32x4& q1, HOOK&& hook) {
    const int lane = X.lane, fr = lane & 15, q4 = lane >> 4;
    const LAS float* BIAS = (const LAS float*)(X.lds);
    const int tq = lat ? b * SEQ + r * 64 + cb * 16 + fr : NLAT + b * CTXL + cb * 16 + fr;
    hook();
    const i64_t qp[2] = {as_i64((u32x2){q0.x, q0.y}), as_i64((u32x2){q0.z, q0.w})}, qr[2] = {as_i64((u32x2){q1.x, q1.y}), as_i64((u32x2){q1.z, q1.w})};
    const int rs = min(max(r - 4, 0), 248), bs = min(max(cb * 16 - 8, 0), 32);
    f32x4 sc[16];
    f32x4 oacc[4];
#pragma unroll
    for (int dt = 0; dt < 4; ++dt) oacc[dt] = (f32x4){0.f, 0.f, 0.f, 0.f};
    float mrun = -3.0e38f, sum = 0.f;
    if (lat) {
        float mx = -3.0e38f;
        const int qc = cb * 16 + fr, ws0 = min(max(qc - 8, 0), 48);
        const int off = ws0 - bs; bool v0[4]; const LAS float* bsel[4];
#pragma unroll
        for (int i = 0; i < 4; ++i) { v0[i] = 4 * q4 + i >= off; const int kc = bs + (v0[i] ? 0 : 16) + 4 * q4 + i; bsel[i] = BIAS + (rs - r + 7) * 31 + min(max(kc - qc + 15, 0), 30); }
        const LAS unsigned char* klds = X.lds + A_LK + (bs + fr) * 80 + q4 * 8;
        const LAS unsigned char* vlds = X.lds + A_LV + fr * 880 + ((bs >> 2) + q4) * 8;
        const int s0 = rs % 9;
        i64_t kf[2][4];
#define ATT_LDK(buf, j) do { const int sl_ = s0 + (j) >= 9 ? s0 + (j) - 9 : s0 + (j); _Pragma("unroll") for (int c2 = 0; c2 < 2; ++c2) { const LAS unsigned char* kp = klds + (sl_ * 64 + 16 * c2) * 80; \
            kf[buf][2 * c2] = *(const LAS i64_t*)kp; kf[buf][2 * c2 + 1] = *(const LAS i64_t*)(kp + 32); } } while (0)
        ATT_LDK(0, 0);
        float bvn[4];
#pragma unroll
        for (int e = 0; e < 4; ++e) bvn[e] = bsel[e][0];
#pragma unroll
        for (int j = 0; j < 8; ++j) {
            if (j < 7) ATT_LDK((j + 1) & 1, j + 1);
            float bvv[4];
#pragma unroll
            for (int e = 0; e < 4; ++e) bvv[e] = bvn[e];
            if (j < 7) {
#pragma unroll
                for (int e = 0; e < 4; ++e) bvn[e] = bsel[e][(j + 1) * 31]; }
            f32x4 a[2];
#pragma unroll
            for (int c2 = 0; c2 < 2; ++c2) a[c2] = __builtin_amdgcn_mfma_f32_16x16x32_fp8_fp8(kf[j & 1][2 * c2], qr[0], (f32x4){0.f, 0.f, 0.f, 0.f}, 0, 0, 0);
#pragma unroll
            for (int c2 = 0; c2 < 2; ++c2) a[c2] = __builtin_amdgcn_mfma_f32_16x16x32_fp8_fp8(kf[j & 1][2 * c2 + 1], qr[1], a[c2], 0, 0, 0);
            f32x4 s;
#pragma unroll
            for (int i = 0; i < 4; ++i) s[i] = fmaf(v0[i] ? a[0][i] : a[1][i], ATT_C2, bvv[i]);
            mx = max3f(mx, s[0], s[1]); mx = max3f(mx, s[2], s[3]);
            sc[j] = s;
        }
#undef ATT_LDK
        mx = fmaxf(mx, __shfl_xor(mx, 16)); mx = fmaxf(mx, __shfl_xor(mx, 32));
        const float mm = mx - 8.0f;
#pragma unroll
        for (int t = 0; t < 8; ++t)
#pragma unroll
            for (int i = 0; i < 4; ++i) { const float e = __builtin_amdgcn_exp2f(sc[t][i] - mm); sc[t][i] = e; sum += e; }
        const unsigned pm0 = (v0[0] ? 0xffu : 0u) | (v0[1] ? 0xff00u : 0u) | (v0[2] ? 0xff0000u : 0u) | (v0[3] ? 0xff000000u : 0u);
        i64_t vf[2][4];
#define ATT_LDV(buf, j) do { const int sl_ = s0 + (j) >= 9 ? s0 + (j) - 9 : s0 + (j); _Pragma("unroll") for (int dt = 0; dt < 4; ++dt) vf[buf][dt] = *(const LAS i64_t*)(vlds + dt * 16 * 880 + sl_ * 96); } while (0)
        ATT_LDV(0, 0);
#pragma unroll
        for (int j = 0; j < 8; ++j) {
            if (j < 7) ATT_LDV((j + 1) & 1, j + 1);
            const unsigned w4 = g8::pk_fp8x4_nc(sc[j][0], sc[j][1], sc[j][2], sc[j][3]);
            const i64_t pb = as_i64((u32x2){w4 & pm0, w4 & ~pm0});
#pragma unroll
            for (int dt = 0; dt < 4; ++dt) oacc[dt] = __builtin_amdgcn_mfma_f32_16x16x32_fp8_fp8(vf[j & 1][dt], pb, oacc[dt], 0, 0, 0);
        }
#undef ATT_LDV
        mrun = mx;
    }
    {
        float mx = -3.0e38f;
        const LAS unsigned char* kcl = X.lds + A_CK + fr * 80 + q4 * 8;
        const LAS unsigned char* vcl = X.lds + A_CV + fr * 272 + q4 * 8;
        i64_t kc[2][4];
#define ATT_LDKC(buf, g) do { _Pragma("unroll") for (int t = 0; t < 2; ++t) { const LAS unsigned char* kp = kcl + (16 * (2 * (g) + t)) * 80; \
            kc[buf][2 * t] = *(const LAS i64_t*)kp; kc[buf][2 * t + 1] = *(const LAS i64_t*)(kp + 32); } } while (0)
        ATT_LDKC(0, 0);
#pragma unroll
        for (int g = 0; g < 8; ++g) {
            if (g < 7) ATT_LDKC((g + 1) & 1, g + 1);
            f32x4 a[2];
#pragma unroll
            for (int t = 0; t < 2; ++t) a[t] = __builtin_amdgcn_mfma_f32_16x16x32_fp8_fp8(kc[g & 1][2 * t], qp[0], (f32x4){0.f, 0.f, 0.f, 0.f}, 0, 0, 0);
#pragma unroll
            for (int t = 0; t < 2; ++t) a[t] = __builtin_amdgcn_mfma_f32_16x16x32_fp8_fp8(kc[g & 1][2 * t + 1], qp[1], a[t], 0, 0, 0);
#pragma unroll
            for (int t = 0; t < 2; ++t) { a[t] = a[t] * ATT_C2; mx = max3f(mx, a[t][0], a[t][1]); mx = max3f(mx, a[t][2], a[t][3]); sc[2 * g + t] = a[t]; }
        }
#undef ATT_LDKC
        mx = fmaxf(mx, __shfl_xor(mx, 16)); mx = fmaxf(mx, __shfl_xor(mx, 32));
        const float mnew = fmaxf(mrun, mx), alpha = __builtin_amdgcn_exp2f(mrun - mnew), mm = mnew - 8.0f;
        sum *= alpha;
#pragma unroll
        for (int dt = 0; dt < 4; ++dt) oacc[dt] = oacc[dt] * alpha;
#pragma unroll
        for (int t = 0; t < 16; ++t)
#pragma unroll
            for (int i = 0; i < 4; ++i) { const float e = __builtin_amdgcn_exp2f(sc[t][i] - mm); sc[t][i] = e; sum += e; }
        i64_t vc[2][4];
#define ATT_LDVC(buf, t2) do { _Pragma("unroll") for (int dt = 0; dt < 4; ++dt) vc[buf][dt] = *(const LAS i64_t*)(vcl + dt * 16 * 272 + 32 * (t2)); } while (0)
        ATT_LDVC(0, 0);
#pragma unroll
        for (int t2 = 0; t2 < 8; ++t2) {
            if (t2 < 7) ATT_LDVC((t2 + 1) & 1, t2 + 1);
            const i64_t pb = as_i64((u32x2){g8::pk_fp8x4_nc(sc[2 * t2][0], sc[2 * t2][1], sc[2 * t2][2], sc[2 * t2][3]), g8::pk_fp8x4_nc(sc[2 * t2 + 1][0], sc[2 * t2 + 1][1], sc[2 * t2 + 1][2], sc[2 * t2 + 1][3])});
#pragma unroll
            for (int dt = 0; dt < 4; ++dt) oacc[dt] = __builtin_amdgcn_mfma_f32_16x16x32_fp8_fp8(vc[t2 & 1][dt], pb, oacc[dt], 0, 0, 0);
        }
#undef ATT_LDVC
    }
    sum += __shfl_xor(sum, 16); sum += __shfl_xor(sum, 32);
    const float inv = 1.0f / sum;
    bf16_t* op = (bf16_t*)(X.ws + WS_MIX) + (size_t)tq * 1024 + 512 + h * 64 + 4 * q4;
#pragma unroll
    for (int dt = 0; dt < 4; ++dt) { u32x2 w; w.x = cvt_pk_bf16(oacc[dt][0] * inv, oacc[dt][1] * inv); w.y = cvt_pk_bf16(oacc[dt][2] * inv, oacc[dt][3] * inv); *(u32x2*)(op + 16 * dt) = w; }
}
DEV int mix2_take(Ctx& X, unsigned* wq, int nb16, int kb, unsigned old) {
    if ((int)(old & 0xffffu) < (int)(old >> 16)) return (int)(old & 0xffffu);
    for (;;) {
        unsigned v = 0; if (X.lane < nb16 && X.lane != kb) v = __hip_atomic_load(wq + X.lane, __ATOMIC_RELAXED, __HIP_MEMORY_SCOPE_AGENT);
        const int rem = max((int)(v >> 16) - (int)(v & 0xffffu), 0);
        int key = (rem << 8) | X.lane;
#pragma unroll
        for (int o = 32; o; o >>= 1) key = max(key, __shfl_xor(key, o));
        if ((key >> 8) == 0) return -1;
        const int V = key & 255; const unsigned vv = (unsigned)__shfl((int)v, V);
        const int vlo = (int)(vv & 0xffffu), vhi = (int)(vv >> 16), mid = vlo + ((vhi - vlo) >> 1);
        int ok = 0;
        if (X.lane == 0) { ok = atomicCAS(wq + V, vv, (unsigned)vlo | ((unsigned)mid << 16)) == vv;
            if (ok) __hip_atomic_store(wq + kb, (unsigned)(mid + 1) | ((unsigned)vhi << 16), __ATOMIC_RELAXED, __HIP_MEMORY_SCOPE_AGENT); }
        if (rfl(ok)) return mid;
    }
}
DEV void phase_mix2(KParams& P, Ctx& X, int l, int q) {
    if (X.bid < 64) s5_carry_block(X, l, X.bid); else if (X.bid < 80) lru_carry_block(X, X.bid - 64);
    const int g16 = X.bid & 15, b = g16 >> 3, h = g16 & 7;
    const bf16_t* IN7g = (const bf16_t*)(X.ws + WS_IN7); const bf16_t* VTg = (const bf16_t*)(X.ws + WS_VT);
    { LAS float* B = (LAS float*)X.lds; const float* src = PIN(26) + (size_t)(l * 8 + h) * 465; for (int i = X.tid; i < 465; i += NTHREADS) B[i] = src[i] * 1.44269504088896f;
      if (X.tid < 256) ((LAS float*)(X.lds + A_NEG))[X.tid] = -3.0e38f;
      for (int i = X.tid; i < 2048; i += NTHREADS) { const int key = i >> 3, pc = i & 7;
          *(LAS u32x2*)(X.lds + A_CK + key * 80 + pc * 8) = *(const u32x2*)((const unsigned char*)(IN7g + (size_t)(NLAT + b * CTXL + key) * LD7 + COL_K) + h * 64 + pc * 8); }
      for (int i = X.tid; i < 2048; i += NTHREADS) { const int dim = i >> 5, pc = i & 31;
          const u32x2 v = *(const u32x2*)((const unsigned char*)VTg + ((size_t)((NLAT + b * CTXL) / 8 + pc) * 512 + h * 64 + dim) * 8);
          const int grp = pc >> 2, a = pc & 3, T = a >> 1, q0 = 2 * (a & 1);
          LAS unsigned char* row = X.lds + A_CV + dim * 272 + grp * 32;
          *(LAS unsigned*)(row + q0 * 8 + T * 4) = v.x; *(LAS unsigned*)(row + (q0 + 1) * 8 + T * 4) = v.y; } }
    __syncthreads();
    unsigned* wq = X.ctl + CW_WQ + 64 * (32 + q * 16 + g16);
    const int kb = X.bid >> 4, nb16 = (X.G - g16 + 15) >> 4;
    volatile LAS int* slot = (volatile LAS int*)(X.lds + A_SLOT);
#define MIX2_LDROW(KR, VR, row) do { int tz_ = X.tid; asm volatile("" : "+v"(tz_)); \
        KR = *(const u32x2*)((const unsigned char*)(IN7g + (size_t)(b * SEQ + (row) * 64 + (tz_ >> 3)) * LD7 + COL_K) + h * 64 + (tz_ & 7) * 8); \
        VR = *(const u32x2*)((const unsigned char*)VTg + ((size_t)((b * SEQ + (row) * 64) / 8 + (tz_ >> 6)) * 512 + h * 64 + (tz_ & 63)) * 8); } while (0)
#define MIX2_STROW(KR, VR, row) do { int tz_ = X.tid; asm volatile("" : "+v"(tz_)); const int sl_ = (row) % 9; \
        *(LAS u32x2*)(X.lds + A_LK + (sl_ * 64 + (tz_ >> 3)) * 80 + (tz_ & 7) * 8) = KR; \
        const u32x2 v8 = VR; const int u0 = 2 * X.wave;                   \
        LAS unsigned char* vrow = X.lds + A_LV + (tz_ & 63) * 880 + sl_ * 96; \
        if (u0 <= 11) *(LAS unsigned*)(vrow + u0 * 8) = v8.x;             \
        if (u0 >= 4) *(LAS unsigned*)(vrow + (u0 - 4) * 8 + 4) = v8.x;     \
        if (u0 + 1 <= 11) *(LAS unsigned*)(vrow + (u0 + 1) * 8) = v8.y; \
        if (u0 + 1 >= 4) *(LAS unsigned*)(vrow + (u0 - 3) * 8 + 4) = v8.y; } while (0)
    unsigned old = 0;
    if (X.wave == 0) { if (X.lane == 0) old = atomicAdd(wq + kb, 1u); const int t = mix2_take(X, wq, nb16, kb, (unsigned)rfl((int)old)); if (X.lane == 0) slot[0] = t; }
    __syncthreads();
    int it = slot[0], hb = -100;
    u32x4 qa, qb; bool haveq = false;
    const unsigned char* QB = X.ws + WS_IN7 + (size_t)(COL_Q + h * 64) * 2;
    while (it >= 0) {
        const bool loc = it < 128; const int rb = min(max(2 * it - 4, 0), 247);
        const int tq = loc ? b * SEQ + (2 * it + (X.wave >> 2)) * 64 + (X.wave & 3) * 16 + (X.lane & 15) : NLAT + b * CTXL + ((it - 128) * 8 + X.wave) * 16 + (X.lane & 15);
        if (!haveq) { const unsigned char* qsrc = QB + (size_t)tq * (LD7 * 2) + (X.lane >> 4) * 32; qa = *(const u32x4*)qsrc; qb = *(const u32x4*)(qsrc + 16); }
        if (loc && hb != rb) {
            u32x2 kk[9], vv[9];
#pragma unroll
            for (int i = 0; i < 9; ++i) MIX2_LDROW(kk[i], vv[i], rb + i);
#pragma unroll
            for (int i = 0; i < 9; ++i) MIX2_STROW(kk[i], vv[i], rb + i);
            hb = rb;
            __syncthreads();
        }
        int d = 0; if (loc && it + 1 < 128) d = min(max(2 * it - 2, 0), 247) - rb;
        u32x2 kreg[2], vreg[2]; u32x4 na, nb;
        auto hook = [&]() {
            if (loc && it + 1 < 128) { const unsigned char* qsrc = QB + (size_t)(tq + 128) * (LD7 * 2) + (X.lane >> 4) * 32; na = *(const u32x4*)qsrc; nb = *(const u32x4*)(qsrc + 16); }
            if (d > 0) MIX2_LDROW(kreg[0], vreg[0], rb + 9);
            if (d > 1) MIX2_LDROW(kreg[1], vreg[1], rb + 10);
            if (X.tid == 0) old = atomicAdd(wq + kb, 1u);
        };
        if (loc) attn_tile(P, X, l, b, h, 2 * it + (X.wave >> 2), X.wave & 3, true, qa, qb, hook);
        else attn_tile(P, X, l, b, h, 0, (it - 128) * 8 + X.wave, false, qa, qb, hook);
        if (X.wave == 0) { const int t = mix2_take(X, wq, nb16, kb, (unsigned)rfl((int)old)); if (X.lane == 0) slot[0] = t; }
        __syncthreads();
        const int itn = slot[0];
        if (loc && itn == it + 1 && itn < 128) {
            if (d > 0) MIX2_STROW(kreg[0], vreg[0], rb + 9);
            if (d > 1) MIX2_STROW(kreg[1], vreg[1], rb + 10);
            hb = rb + d; qa = na; qb = nb; haveq = true;
        } else haveq = false;
        __syncthreads();
        it = itn;
    }
#undef MIX2_LDROW
#undef MIX2_STROW
    __syncthreads();
}

DEV f32x4 ld_xrow(KParams& P, const bf16_t* XS, int l, int r, int c) {
    if (l == 0) return *(const f32x4*)(row_src0(P, r) + c);
    const u32x2 w = *(const u32x2*)(XS + (size_t)r * D + c); return (f32x4){blo(w.x), bhi(w.x), blo(w.y), bhi(w.y)};
}
DEV void st_xrow(bf16_t* XS, int r, int c, const f32x4& v) { u32x2 w; w.x = cvt_pk_bf16(v[0], v[1]); w.y = cvt_pk_bf16(v[2], v[3]); *(u32x2*)(XS + (size_t)r * D + c) = w; }
DEV void phase_rowB(KParams& P, Ctx& X, int l) {
    LAS unsigned char* FT = X.lds;
    LAS float* PART = (LAS float*)(X.lds + 36864);
    LAS int* ENT = (LAS int*)(X.lds + 36864 + 16384 + 2048);
    LAS int* CNTT = (LAS int*)(X.lds + 36864 + 16384 + 2048 + 8192);
    const float* mod = (const float*)(X.ws + WS_MOD) + (size_t)l * 3 * 6144; const float* g1 = PIN(6) + (size_t)(l * 4 + 1) * 1024; const float* g2 = g1 + 1024;
    const bf16_t* MIXO = (const bf16_t*)(X.ws + WS_MIXO); bf16_t* XS = (bf16_t*)(X.ws + WS_XS); unsigned char* F8 = X.ws + WS_H;
    const bf16_t* WrT = (const bf16_t*)(X.ws + WS_WRT) + (size_t)l * 32 * 1024;
    const int lane = X.lane, wave = X.wave, tid = X.tid;
    const int NG = (l == 1 ? NLAT : NTOK) / 16;
    const int fr = lane & 15, q4 = lane >> 4;
    bf16x8 wb0[4], wb1[4];
#pragma unroll
    for (int ks = 0; ks < 4; ++ks) { const int k0 = wave * 128 + ks * 32 + q4 * 8; wb0[ks] = *(const bf16x8*)(WrT + (size_t)fr * 1024 + k0); wb1[ks] = *(const bf16x8*)(WrT + (size_t)(16 + fr) * 1024 + k0); }
    const float brv = PIN(28)[l * 32 + (tid & 31)];
    if (l == 0 && X.G >= 32) {
        const bf16_t* PART = (const bf16_t*)(X.ws + WS_SL); bf16_t* MO = (bf16_t*)(X.ws + WS_MIXO);
        for (int g = NLAT / 16; g < NTOK / 16; ++g) if (g % X.G == X.bid) {
            const int r = g * 16 + (tid >> 5) - NLAT, c0 = (tid & 31) * 32;
#pragma unroll
            for (int v = 0; v < 4; ++v) { f32x4 s0 = (f32x4){0.f, 0.f, 0.f, 0.f}, s1 = s0;
#pragma unroll
                for (int p = 0; p < 4; ++p) { const u32x4 w = *(const u32x4*)(PART + ((size_t)p * 512 + r) * 1024 + c0 + v * 8);
                    s0[0] += blo(w.x); s0[1] += bhi(w.x); s0[2] += blo(w.y); s0[3] += bhi(w.y); s1[0] += blo(w.z); s1[1] += bhi(w.z); s1[2] += blo(w.w); s1[3] += bhi(w.w); }
                *(u32x4*)(MO + (size_t)(NLAT + r) * D + c0 + v * 8) = g8::pack8(s0, s1); } }
        __threadfence_block(); __syncthreads(); }
    LAS float* LG = (LAS float*)(X.lds + 65536);
    for (int i = tid; i < 11 * 256; i += NTHREADS) { const int v = i >> 8, c4 = (i & 255) * 4;
        const float* s = v < 2 ? g1 + v * 1024 : mod + ((v - 2) / 3) * 6144 + (2 + (v - 2) % 3) * 1024;
        *(LAS f32x4*)(LG + v * 1024 + c4) = *(const f32x4*)(s + c4); }
    __syncthreads();
    int nent = 0;
    u32x2 mraw[2][4], mnx[2][4]; f32x4 xv[2][4], xnx[2][4];
    int grp = X.bid;
    if (grp < NG) {
#pragma unroll
        for (int q = 0; q < 2; ++q) { const int r = grp * 16 + wave * 2 + q;
#pragma unroll
            for (int j = 0; j < 4; ++j) { const int c = 4 * lane + 256 * j; mnx[q][j] = *(const u32x2*)(MIXO + (size_t)r * D + c); xnx[q][j] = ld_xrow(P, XS, l, r, c); } }
    }
    for (; grp < NG; grp += X.G) {
#pragma unroll
        for (int q = 0; q < 2; ++q)
#pragma unroll
            for (int j = 0; j < 4; ++j) { mraw[q][j] = mnx[q][j]; xv[q][j] = xnx[q][j]; }
        {
            const int gn = grp + X.G;
            if (gn < NG) {
#pragma unroll
                for (int q = 0; q < 2; ++q) { const int r = gn * 16 + wave * 2 + q;
#pragma unroll
                    for (int j = 0; j < 4; ++j) { const int c = 4 * lane + 256 * j; mnx[q][j] = *(const u32x2*)(MIXO + (size_t)r * D + c); xnx[q][j] = ld_xrow(P, XS, l, r, c); } }
            }
        }
        {
            f32x4 mo[2][4]; float ss[2] = {0.f, 0.f}, ss2[2] = {0.f, 0.f};
#pragma unroll
            for (int q = 0; q < 2; ++q)
#pragma unroll
                for (int j = 0; j < 4; ++j) { const u32x2 w = mraw[q][j]; mo[q][j] = (f32x4){blo(w.x), bhi(w.x), blo(w.y), bhi(w.y)};
                    ss[q] += mo[q][j][0] * mo[q][j][0] + mo[q][j][1] * mo[q][j][1] + mo[q][j][2] * mo[q][j][2] + mo[q][j][3] * mo[q][j][3]; }
#pragma unroll
            for (int q = 0; q < 2; ++q) { const int r = grp * 16 + wave * 2 + q; const LAS float* m = LG + 2048 + mod_sel(r) * 3072;
                const float rstd1 = rsqrtf(wave_sum(ss[q]) * (1.0f / D) + EPS);
#pragma unroll
                for (int j = 0; j < 4; ++j) { const int c = 4 * lane + 256 * j; const f32x4 gg = *(const LAS f32x4*)(LG + c), m2 = *(const LAS f32x4*)(m + c);
#pragma unroll
                    for (int e = 0; e < 4; ++e) { xv[q][j][e] += m2[e] * (mo[q][j][e] * rstd1 * gg[e]); ss2[q] += xv[q][j][e] * xv[q][j][e]; }
                    st_xrow(XS, r, c, xv[q][j]); } }
#pragma unroll
            for (int q = 0; q < 2; ++q) { const int lr = wave * 2 + q, r = grp * 16 + lr; const LAS float* m = LG + 2048 + mod_sel(r) * 3072;
                const float rstd2 = rsqrtf(wave_sum(ss2[q]) * (1.0f / D) + EPS);
#pragma unroll
                for (int j = 0; j < 4; ++j) { const int c = 4 * lane + 256 * j; const f32x4 gg = *(const LAS f32x4*)(LG + 1024 + c), sh = *(const LAS f32x4*)(m + 1024 + c), sc = *(const LAS f32x4*)(m + 2048 + c);
                    f32x4 o;
#pragma unroll
                    for (int e = 0; e < 4; ++e) o[e] = xv[q][j][e] * rstd2 * gg[e] * (1.0f + sc[e]) + sh[e];
                    u32x2 w; w.x = cvt_pk_bf16(o[0], o[1]); w.y = cvt_pk_bf16(o[2], o[3]);
                    *(unsigned*)(F8 + (size_t)r * D + c) = g8::pk_fp8x4(o[0] * 8.0f, o[1] * 8.0f, o[2] * 8.0f, o[3] * 8.0f); *(LAS u32x2*)(FT + lr * 2064 + c * 2) = w; } }
        }
        __syncthreads();
        {
            f32x4 a0 = (f32x4){0.f, 0.f, 0.f, 0.f}, a1 = a0;
#pragma unroll
            for (int ks = 0; ks < 4; ++ks) { const int k0 = wave * 128 + ks * 32 + q4 * 8;
                const bf16x8 af = *(const LAS bf16x8*)(FT + fr * 2064 + k0 * 2);
                a0 = __builtin_amdgcn_mfma_f32_16x16x32_bf16(af, wb0[ks], a0, 0, 0, 0); a1 = __builtin_amdgcn_mfma_f32_16x16x32_bf16(af, wb1[ks], a1, 0, 0, 0); }
#pragma unroll
            for (int i = 0; i < 4; ++i) { PART[(wave * 16 + 4 * q4 + i) * 32 + fr] = a0[i]; PART[(wave * 16 + 4 * q4 + i) * 32 + 16 + fr] = a1[i]; }
        }
        __syncthreads();
        {
            const int row = tid >> 5, e = tid & 31; float v = brv;
#pragma unroll
            for (int w = 0; w < 8; ++w) v += PART[(w * 16 + row) * 32 + e];
            float tv[4]; int ti[4];
#pragma unroll
            for (int k = 0; k < 4; ++k) { float m = v; int mi = e;
#pragma unroll
                for (int o = 16; o >= 1; o >>= 1) { const float ov = __shfl_xor(m, o); const int oi = __shfl_xor(mi, o); const bool take = (ov > m) || (ov == m && oi < mi); m = take ? ov : m; mi = take ? oi : mi; }
                tv[k] = m; ti[k] = mi; v = (e == mi) ? -3.0e38f : v; }
            if (e == 0) { const int r = grp * 16 + row;
                const float e1 = __expf(tv[1] - tv[0]), e2 = __expf(tv[2] - tv[0]), e3 = __expf(tv[3] - tv[0]), is = 1.0f / (1.0f + e1 + e2 + e3);
                *(f32x4*)((float*)(X.ws + WS_GATE) + (size_t)r * 4) = (f32x4){is, e1 * is, e2 * is, e3 * is};
#pragma unroll
                for (int k = 0; k < 4; ++k) { ENT[nent * 64 + row * 4 + k] = ti[k]; ENT[640 + nent * 64 + row * 4 + k] = r * 4 + k; } }
        }
        ++nent;
    }
    __syncthreads();
    int myrank[2] = {0, 0}, mye[2] = {-1, -1};
#pragma unroll
    for (int t = 0; t < 2; ++t) { const int c = wave + 8 * t;
        if (c < nent) { const int e = ENT[c * 64 + lane]; mye[t] = e; int cnt_mine = 0;
            for (int x = 0; x < 32; ++x) { const unsigned long long mk = __ballot(e == x); if (e == x) myrank[t] = __popcll(mk & ((1ull << lane) - 1ull)); if (lane == x) cnt_mine = __popcll(mk); }
            if (lane < 32) CNTT[c * 32 + lane] = cnt_mine; } }
    __syncthreads();
    if (tid < 32) { int tot = 0; for (int c = 0; c < nent; ++c) tot += CNTT[c * 32 + tid];
        int base = tot ? (int)atomicAdd(X.ctl + CW_CNT + l * 32 + tid, (unsigned)tot) : 0;
        for (int c = 0; c < nent; ++c) { const int n = CNTT[c * 32 + tid]; CNTT[c * 32 + tid] = base; base += n; } }
    __syncthreads();
    { int* inv = (int*)(X.ws + WS_INV);
#pragma unroll
      for (int t = 0; t < 2; ++t) { const int c = wave + 8 * t;
        if (c < nent) { const int e = mye[t], pos = CNTT[c * 32 + e] + myrank[t], rk = ENT[640 + c * 64 + lane];
            ((int*)(X.ws + WS_LTOK))[(size_t)e * NTOK + pos] = rk >> 2; inv[rk] = (e << 20) | pos; } } }
    __syncthreads();
}

DEV void moe_table(Ctx& X, int l) {
    volatile LAS int* bs = (volatile LAS int*)(X.lds + LDS_MISC);
    if (X.tid < 64) { const int e = X.lane & 31; const int cnt = (int)X.ctl[CW_CNT + l * 32 + e]; int nb = (cnt + 255) >> 8; int inc = nb;
#pragma unroll
        for (int o = 1; o < 32; o <<= 1) { const int v = __shfl_up(inc, o); if ((X.lane & 31) >= o) inc += v; }
        if (X.lane < 32) { bs[e] = inc - nb; bs[33 + e] = cnt; if (e == 31) bs[32] = inc; } }
    __syncthreads();
}

DEV void phase_rowC(KParams& P, Ctx& X, int l, bool dry = false) {
    const int gw = X.bid * NWAVES + X.wave, NGW = X.G * NWAVES, lane = X.lane;
    const int NR = l == 1 ? NLAT : NTOK;
    const float* mod = (const float*)(X.ws + WS_MOD) + (size_t)l * 3 * 6144; const float* g3 = PIN(6) + (size_t)(l * 4 + 3) * 1024;
    const unsigned char* YB = X.ws + WS_YB; bf16_t* XS = (bf16_t*)(X.ws + WS_XS);
    const int* INV = (const int*)(X.ws + WS_INV); const float* GATE = (const float*)(X.ws + WS_GATE);
    bf16_t* XSW = XS; bf16_t* HW = (bf16_t*)(X.ws + WS_H);
    LAS float* LG = (LAS float*)X.lds;
    { const float* mod1 = (const float*)(X.ws + WS_MOD) + (size_t)3 * 6144; const float* g0 = PIN(6) + (size_t)4 * 1024;
      for (int i = X.tid; i < 11 * 256; i += NTHREADS) { const int v = i >> 8, c4 = (i & 255) * 4; const int cl = (v - 2) / 3, wh = (v - 2) % 3;
          const float* s = v == 0 ? g3 : v == 1 ? g0 : wh == 0 ? mod + cl * 6144 + 5 * 1024 : mod1 + cl * 6144 + (wh - 1) * 1024;
          *(LAS f32x4*)(LG + v * 1024 + c4) = *(const f32x4*)(s + c4); } }
    int bsl; { const int e = lane & 31; const int cnt = (int)X.ctl[CW_CNT + l * 32 + e]; const int nb = (cnt + 255) >> 8; int inc = nb;
#pragma unroll
        for (int o = 1; o < 32; o <<= 1) { const int v = __shfl_up(inc, o); if ((lane & 31) >= o) inc += v; }
        bsl = inc - nb; }
    __syncthreads();
    const int ST = NGW * 2;
    int r0 = gw * 2; int ivc = 0, ivn = 0; float gtc = 0.f, gtn = 0.f;
    if (r0 < NR && lane < 8) { ivc = INV[r0 * 4 + lane]; gtc = GATE[r0 * 4 + lane]; }
    if (r0 + ST < NR && lane < 8) { ivn = INV[(r0 + ST) * 4 + lane]; gtn = GATE[(r0 + ST) * 4 + lane]; }
    unsigned yb[2][4][4], ybn[2][4][4]; u32x2 xr[2][4], xrn[2][4];
#define ROWC_GATHER(dst, dstx, ivw, rr) do { _Pragma("unroll") for (int q = 0; q < 2; ++q) { _Pragma("unroll") for (int k = 0; k < 4; ++k) { const int iv = __shfl(ivw, q * 4 + k); const int e = iv >> 20, pos = iv & 0xfffff; \
        const size_t dest = (size_t)__shfl(bsl, e) * 256 + pos; _Pragma("unroll") for (int j = 0; j < 4; ++j) dst[q][k][j] = *(const unsigned*)(YB + dest * D + 4 * lane + 256 * j); } \
        _Pragma("unroll") for (int j = 0; j < 4; ++j) dstx[q][j] = *(const u32x2*)(XS + (size_t)((rr) + q) * D + 4 * lane + 256 * j); } } while (0)
    if (r0 < NR) ROWC_GATHER(yb, xr, ivc, r0);
    for (; r0 < NR; r0 += ST) {
        int iv2 = 0; float gt2 = 0.f;
        if (r0 + ST < NR) ROWC_GATHER(ybn, xrn, ivn, r0 + ST);
        if (r0 + 2 * ST < NR && lane < 8) { iv2 = INV[(r0 + 2 * ST) * 4 + lane]; gt2 = GATE[(r0 + 2 * ST) * 4 + lane]; }
        f32x4 y[2][4], xv[2][4]; float gk[2][4];
#pragma unroll
        for (int q = 0; q < 2; ++q)
#pragma unroll
            for (int k = 0; k < 4; ++k) gk[q][k] = __shfl(gtc, q * 4 + k);
#pragma unroll
        for (int q = 0; q < 2; ++q)
#pragma unroll
            for (int j = 0; j < 4; ++j) { const u32x2 w = xr[q][j]; xv[q][j] = (f32x4){blo(w.x), bhi(w.x), blo(w.y), bhi(w.y)}; }
#pragma unroll
        for (int q = 0; q < 2; ++q) {
#pragma unroll
            for (int j = 0; j < 4; ++j) { y[q][j] = (f32x4){0.f, 0.f, 0.f, 0.f};
#pragma unroll
                for (int k = 0; k < 4; ++k) { const unsigned w = yb[q][k][j]; const f32x2 lo = __builtin_amdgcn_cvt_pk_f32_fp8(w, false), hi = __builtin_amdgcn_cvt_pk_f32_fp8(w, true); const float gq = gk[q][k] * (1.0f / 16.0f);
                    y[q][j][0] += gq * lo.x; y[q][j][1] += gq * lo.y; y[q][j][2] += gq * hi.x; y[q][j][3] += gq * hi.y; } } }
#pragma unroll
        for (int q = 0; q < 2; ++q) { const int r = r0 + q; const LAS float* m = LG + 2048 + mod_sel(r) * 3072;
            float ss = 0.f;
#pragma unroll
            for (int j = 0; j < 4; ++j) ss += y[q][j][0] * y[q][j][0] + y[q][j][1] * y[q][j][1] + y[q][j][2] * y[q][j][2] + y[q][j][3] * y[q][j][3];
            const float rstd = rsqrtf(wave_sum(ss) * (1.0f / D) + EPS); float ss2 = 0.f;
#pragma unroll
            for (int j = 0; j < 4; ++j) { const int c = 4 * lane + 256 * j; const f32x4 gg = *(const LAS f32x4*)(LG + c), m5 = *(const LAS f32x4*)(m + c);
#pragma unroll
                for (int e = 0; e < 4; ++e) { xv[q][j][e] += m5[e] * (y[q][j][e] * rstd * gg[e]); ss2 += xv[q][j][e] * xv[q][j][e]; } }
            if (l == 0) {
                const float rstd2 = rsqrtf(wave_sum(ss2) * (1.0f / D) + EPS);
#pragma unroll
                for (int j = 0; j < 4; ++j) { const int c = 4 * lane + 256 * j; st_xrow(XSW, r, c, xv[q][j]);
                    const f32x4 gg = *(const LAS f32x4*)(LG + 1024 + c), sh = *(const LAS f32x4*)(m + 1024 + c), sc = *(const LAS f32x4*)(m + 2048 + c); f32x4 o;
#pragma unroll
                    for (int e = 0; e < 4; ++e) o[e] = xv[q][j][e] * rstd2 * gg[e] * (1.0f + sc[e]) + sh[e];
                    u32x2 w; w.x = cvt_pk_bf16(o[0], o[1]); w.y = cvt_pk_bf16(o[2], o[3]); *(u32x2*)(HW + (size_t)r * D + c) = w;
                    *(unsigned*)(X.ws + WS_H8 + (size_t)r * D + c) = g8::pk_fp8x4(o[0] * 8.0f, o[1] * 8.0f, o[2] * 8.0f, o[3] * 8.0f); }
            } else if (r < NLAT) {
#pragma unroll
                for (int j = 0; j < 4; ++j) *(f32x4*)(POUT + (size_t)r * D + 4 * lane + 256 * j) = xv[q][j];
            }
        }
#pragma unroll
        for (int q = 0; q < 2; ++q) {
#pragma unroll
            for (int k = 0; k < 4; ++k)
#pragma unroll
                for (int j = 0; j < 4; ++j) yb[q][k][j] = ybn[q][k][j];
#pragma unroll
            for (int j = 0; j < 4; ++j) xr[q][j] = xrn[q][j]; }
        ivc = ivn; gtc = gtn; ivn = iv2; gtn = gt2;
    }
#undef ROWC_GATHER
    __syncthreads();
}

#define XB_TMO      128
#define XB_XCNT(j)  (256  + 64 * (j))
#define XB_XSUB(j)  (1280 + 64 * (j))
#define XB_XGEN(j)  (2304 + 64 * (j))
#define XB_TOP      3328
#define XB_TOPGEN   3392
#define XB_SPIN_CAP (1u << 22)
DEV unsigned xb_ld(unsigned* p)              { return __hip_atomic_load(p, __ATOMIC_RELAXED, __HIP_MEMORY_SCOPE_AGENT); }
DEV unsigned xb_add(unsigned* p, unsigned v) { return __hip_atomic_fetch_add(p, v, __ATOMIC_RELAXED, __HIP_MEMORY_SCOPE_AGENT); }
DEV unsigned xb_xcc_id() { return (unsigned)__builtin_amdgcn_s_getreg((3 << 11) | 20) & 0xFu; }
#define XB_SPIN(cond, bar) do { unsigned _sp = 0; while (cond) { __builtin_amdgcn_s_sleep(1); \
    if ((++_sp & 255u) == 0u) { if (xb_ld(&(bar)[XB_TMO])) break; if (_sp > XB_SPIN_CAP) { atomicAdd(&(bar)[XB_TMO], 1u); break; } } } } while (0)
DEV void xcd_barrier_complete(unsigned* bar, unsigned x, unsigned& nloc, unsigned& nx) {
    const unsigned G = gridDim.x;
    unsigned sum, cnt, mine, sp = 0u;
    for (;;) {
        sum = 0u; cnt = 0u; mine = 0u;
#pragma unroll
        for (unsigned j = 0; j < 16; ++j) { const unsigned c = xb_ld(&bar[XB_XCNT(j)]); sum += c; cnt += (c > 0u) ? 1u : 0u; mine = (j == x) ? c : mine; }
        if (sum == G) break;
        __builtin_amdgcn_s_sleep(1);
        if ((++sp & 255u) == 0u) { if (xb_ld(&bar[XB_TMO])) break; if (sp > XB_SPIN_CAP) { atomicAdd(&bar[XB_TMO], 1u); break; } }
    }
    nloc = mine > 0u ? mine : 1u; nx = cnt > 0u ? cnt : 1u;
}
DEV void xcd_barrier(unsigned* bar, unsigned x, volatile LAS unsigned* st, int tid) {
    asm volatile("" : "+s"(bar), "+s"(x));
    asm volatile("s_waitcnt vmcnt(0)" ::: "memory");
    __syncthreads();
    if (tid == 0) {
        __builtin_amdgcn_s_waitcnt(0);
        unsigned nloc = st[0], nx = st[1];
        if (nloc == 0u) { xcd_barrier_complete(bar, x, nloc, nx); st[0] = nloc; st[1] = nx; }
        const unsigned old = xb_add(&bar[XB_XSUB(x)], 1u);
        const unsigned gen = old / nloc;
        if (old + 1u == (gen + 1u) * nloc) {
            __builtin_amdgcn_fence(__ATOMIC_RELEASE, "agent");
            asm volatile("s_waitcnt vmcnt(0)" ::: "memory");
            const unsigned og = xb_add(&bar[XB_TOP], 1u);
            const unsigned tg = og / nx;
            if (og + 1u == (tg + 1u) * nx) xb_add(&bar[XB_TOPGEN], 1u);
            else XB_SPIN(xb_ld(&bar[XB_TOPGEN]) == tg, bar);
            __builtin_amdgcn_fence(__ATOMIC_ACQUIRE, "agent");
            xb_add(&bar[XB_XGEN(x)], 1u);
            asm volatile("s_waitcnt vmcnt(0)" ::: "memory");
        } else {
            XB_SPIN(xb_ld(&bar[XB_XGEN(x)]) == gen, bar);
            __builtin_amdgcn_fence(__ATOMIC_ACQUIRE, "agent");
            asm volatile("s_waitcnt vmcnt(0)" ::: "memory");
        }
    }
    __syncthreads();
}

DEV void relaunder(Ctx& X, int wave0, unsigned char* wsp) {
    int wv_ = wave0; asm volatile("" : "+s"(wv_)); int t_ = (wv_ << 6) | lane_fresh(); asm volatile("" : "+v"(t_)); X.tid = t_; X.lane = t_ & 63; X.wave = wv_;
    int g_ = gridDim.x, b_ = blockIdx.x; asm volatile("" : "+s"(g_), "+s"(b_)); X.G = g_; X.bid = b_;
    GAS unsigned char* w_ = (GAS unsigned char*)wsp; asm volatile("" : "+s"(w_)); X.ws = (unsigned char*)w_; X.ctl = (unsigned*)(X.ws + WS_CTL);
}

__global__ void __launch_bounds__(NTHREADS, 2) mega_fwd(Params P_) {
    extern __shared__ __attribute__((aligned(16))) unsigned char lds_raw[];
    const int wave0_ = rfl((int)threadIdx.x >> 6);
    Ctx X; X.lds = (LAS unsigned char*)lds_raw; X.tid = 0; X.lane = 0; X.wave = 0; X.G = gridDim.x; X.bid = blockIdx.x;
    X.ws = P_.ws; X.ctl = (unsigned*)(P_.ws + WS_CTL);
    cg::grid_group grid = cg::this_grid();
    unsigned* xbar = (unsigned*)(P_.ws + WS_CTL) + CW_BAR;
    volatile LAS unsigned* xst = (volatile LAS unsigned*)(X.lds + LDS_XST);
    const unsigned xcc = xb_xcc_id();
    { const int t0_ = (wave0_ << 6) | lane_fresh();
      if (t0_ < 2) xst[t0_] = 0u;
      if (t0_ == 0) (void)xb_add(&xbar[XB_XCNT(xcc)], 1u);
      __syncthreads(); }
    const int lo = P_.ph_lo, hi = P_.ph_hi;
    int ph = 0;
#ifdef DBG_ONLY
#define DBGSEL(k) if (DBG_ONLY == (k))
#else
#define DBGSEL(k)
#endif
#ifdef DBG_SUB
#define DSUB(k) if (DBG_SUB == (k))
#else
#define DSUB(k)
#endif
#define PH_BEGIN if (lo <= ph && ph < hi) { KParams* pp_ = (KParams*)__builtin_amdgcn_kernarg_segment_ptr(); asm volatile("" : "+s"(pp_)); KParams& P = *pp_; relaunder(X, wave0_, P.ws); ws = X.ws;
#ifndef PROBE_DUP
#define PROBE_DUP 0
#endif
#define REP(bit) for (int rep = 0; rep < (((PROBE_DUP) & (bit)) ? 2 : 1); ++rep) if (relaunder(X, wave0_, P.ws), true)
#define PH_END   if (ph + 1 < hi) { if (lo < 0) grid.sync();   xcd_barrier(xbar, xcc, xst, X.tid); if ((PROBE_DUP) & 512) xcd_barrier(xbar, xcc, xst, X.tid); } } ++ph;
    unsigned char* ws = P_.ws;
    PH_BEGIN DBGSEL(0) REP(1) { p0_prologue(P, X); __syncthreads(); } PH_END
    for (int l = 0; l < 2; ++l) {
        if (l == 0) { PH_BEGIN DBGSEL(1) REP(256) phase_rowA(P, X, 0); PH_END }
        PH_BEGIN DBGSEL(2) { g8::JobInProj J{ws + WS_H, ws + WS_WIN + (size_t)l * 2304 * 1024 * 2, (bf16_t*)(ws + WS_IN7), (bf16_t*)(ws + WS_AX), (bf16_t*)(ws + WS_VT), (const LAS unsigned*)(X.lds + LDS_MISC), (const LAS unsigned*)(X.lds + LDS_MISC + 12288), X.G, X.bid};
                   { const f32x2* RT = (const f32x2*)(ws + WS_ROPE); LAS unsigned* TC = (LAS unsigned*)(X.lds + LDS_MISC); LAS unsigned* TR = (LAS unsigned*)(X.lds + LDS_MISC + 12288);
                     for (int i = X.tid; i < 320 * 16; i += NTHREADS) { const int k = i < 1024 ? i : i - 1024; const f32x2 cs = RT[k];
                         const unsigned pk = (unsigned)__builtin_bit_cast(unsigned short, (_Float16)cs.x) | ((unsigned)__builtin_bit_cast(unsigned short, (_Float16)cs.y) << 16);
                         if (i < 1024) TC[k] = pk; else TR[k] = pk; }
                     __syncthreads(); }
                   if (X.G == 256) {
                       J.mode = 1;
                       REP(2) { g8::gemm_phase(X.lds, J, X.tid); relaunder(X, wave0_, P.ws);
                                g8::JobInProj8 J8{ws + WS_H8, ws + WS_WIN8 + (size_t)l * 1536 * 1024, (bf16_t*)(ws + WS_IN7), (bf16_t*)(ws + WS_AX), (bf16_t*)(ws + WS_VT), J.TC, J.TR, X.G, X.bid, 2};
                                g8::gemm_phase(X.lds, J8, X.tid); } }
                   else { const int full = (1170 / X.G) * X.G; if (full >= 910) J.hi = full;
                       REP(2) g8::gemm_phase(X.lds, J, X.tid); } } PH_END
        PH_BEGIN DBGSEL(3) { g8::JobS5<256> J{(const bf16_t*)(ws + WS_AX), (const bf16_t*)(ws + WS_S5B1) + (size_t)l * 16 * 256 * 256, (float*)(ws + WS_SL), nullptr, X.G, X.bid};
                   REP(4) { DSUB(1) g8::gemm_phase(X.lds, J, X.tid);
                            { const int full = (1170 / X.G) * X.G; const int j = X.G - 1 - X.bid;
                              if (X.G == 256) { if (j < 24) { g8::JobInProj8 JV{ws + WS_H8, ws + WS_WIN8 + (size_t)l * 1536 * 1024, (bf16_t*)(ws + WS_IN7), (bf16_t*)(ws + WS_AX), (bf16_t*)(ws + WS_VT), nullptr, nullptr, X.G, j, 3, 756};
                                  g8::gemm_phase(X.lds, JV, X.tid); relaunder(X, wave0_, P.ws); } }
                              else if (full >= 910 && j < 1170 - full) { g8::JobInProj JV{ws + WS_H, ws + WS_WIN + (size_t)l * 2304 * 1024 * 2, (bf16_t*)(ws + WS_IN7), (bf16_t*)(ws + WS_AX), (bf16_t*)(ws + WS_VT), nullptr, nullptr, 1 << 20, j, 0, full, 1170};
                                  g8::gemm_phase(X.lds, JV, X.tid); relaunder(X, wave0_, P.ws); } }
                            DSUB(2) phase_lru(P, X, l, 1, (l * 2 + 0) * 2 + rep); } } PH_END
        PH_BEGIN DBGSEL(4) REP(8) phase_mix2(P, X, l, l * 2 + rep); PH_END
        PH_BEGIN DBGSEL(5) { g8::JobS5<512> J{(const bf16_t*)(ws + WS_AX), (const bf16_t*)(ws + WS_S5B2) + (size_t)l * 16 * 256 * 512, nullptr, (bf16_t*)(ws + WS_Z), X.G, X.bid};
                   g8::gemm_phase(X.lds, J, X.tid);
                   unsigned* dep = X.ctl + 9216 + 64 * (l * 9);
                   if (X.bid < 144 && X.tid == 0) { __builtin_amdgcn_fence(__ATOMIC_RELEASE, "agent"); asm volatile("s_waitcnt vmcnt(0)" ::: "memory");
                       __hip_atomic_fetch_add(dep + 64 * (X.bid % 9), 1u, __ATOMIC_RELAXED, __HIP_MEMORY_SCOPE_AGENT); }
                   if (X.bid < 130) { int pm_, pn_; (void)g8::dense_unit(X.bid, 130, 1, pm_, pn_);
                       if (X.tid == 0) { unsigned sp = 0; while (__hip_atomic_load(dep + 64 * (pm_ >> 4), __ATOMIC_RELAXED, __HIP_MEMORY_SCOPE_AGENT) < 16u && ++sp < (1u << 22)) __builtin_amdgcn_s_sleep(2);
                           __builtin_amdgcn_fence(__ATOMIC_ACQUIRE, "agent"); asm volatile("s_waitcnt vmcnt(0)" ::: "memory"); }
                       __syncthreads();
                       g8::JobGlu JG{(const bf16_t*)(ws + WS_Z), (const bf16_t*)(ws + WS_WGLU) + (size_t)l * 256 * 256, PIN(25) + l * 256, (bf16_t*)(ws + WS_MIX), X.G, X.bid};
                       g8::gemm_phase(X.lds, JG, X.tid); }
                   phase_lru(P, X, l, 2, (l * 2 + 1) * 2); } PH_END
        PH_BEGIN DBGSEL(7) { g8::JobOut J{(const bf16_t*)(ws + WS_MIX), (const bf16_t*)(ws + WS_WOUT) + (size_t)l * 1024 * 1024, (bf16_t*)(ws + WS_MIXO), X.G, X.bid, (l == 0 && X.G < 32) ? 130 : 128};
                   REP(32) { g8::gemm_phase(X.lds, J, X.tid);
                             if (l == 0 && X.G >= 32 && X.bid < 32) { relaunder(X, wave0_, P.ws); g8::JobOutQ JQ{(const bf16_t*)(ws + WS_MIX), (const bf16_t*)(ws + WS_WOUT), (bf16_t*)(ws + WS_SL), X.bid}; g8::gemm_phase(X.lds, JQ, X.tid); } } } PH_END
        PH_BEGIN DBGSEL(8) phase_rowB(P, X, l); PH_END
        PH_BEGIN DBGSEL(9) { moe_table(X, l);
                   g8::JobGu J{ws + WS_H, ws + WS_WGU + (size_t)l * 32 * 2048 * 1024, PIN(30) + (size_t)l * 32 * 2048, (const int*)(ws + WS_LTOK), ws + WS_ACT,
                               (const volatile LAS int*)(X.lds + LDS_MISC), X.G, X.bid, X.lane};
                   REP(64) g8::gemm_phase(X.lds, J, X.tid); } PH_END
        PH_BEGIN DBGSEL(10) { moe_table(X, l);
                   g8::JobDown J{ws + WS_ACT, ws + WS_WDN + (size_t)l * 32 * 1024 * 1024, PIN(32) + (size_t)l * 32 * 1024, ws + WS_YB,
                                 (const volatile LAS int*)(X.lds + LDS_MISC), X.G, X.bid, X.lane};
                   REP(128) g8::gemm_phase(X.lds, J, X.tid); } PH_END
        PH_BEGIN DBGSEL(11) { if ((PROBE_DUP) & 2048) { phase_rowC(P, X, l, true); relaunder(X, wave0_, P.ws); } phase_rowC(P, X, l); } PH_END
    }
}
constexpr int N_PHASES = 20;

extern "C" void kernel_launch(void* const* d_in, const int* in_sizes, int n_in, void* d_out, int out_size, void* d_ws, size_t ws_size, hipStream_t stream) {
    static int grid = 0;
    if (grid == 0) {
        if (n_in != 33 || out_size != NLAT * D || ws_size < WS_END) { fprintf(stderr, "kernel_launch: unexpected shapes (n_in %d, out %d, ws %zu, need %zu)\n", n_in, out_size, ws_size, (size_t)WS_END); grid = -1; return; }
        int dev = 0, cus = 0, per_cu = 0;
        hipGetDevice(&dev); hipDeviceGetAttribute(&cus, hipDeviceAttributeMultiprocessorCount, dev);
        if (hipFuncSetAttribute((const void*)mega_fwd, hipFuncAttributeMaxDynamicSharedMemorySize, LDS_BYTES) != hipSuccess) { fprintf(stderr, "kernel_launch: hipFuncSetAttribute failed\n"); grid = -1; return; }
        hipOccupancyMaxActiveBlocksPerMultiprocessor(&per_cu, (const void*)mega_fwd, NTHREADS, LDS_BYTES);
        (void)hipGetLastError();
        if (per_cu < 1) { fprintf(stderr, "kernel_launch: occupancy query says %d blocks per CU\n", per_cu); }
        grid = cus;
        if (grid % 8 != 0) grid -= grid % 8;
    }
    if (grid < 0) return;
    hipMemsetAsync((char*)d_ws + WS_CTL, 0, CTL_BYTES, stream);
    Params p{};
    for (int i = 0; i < 33; ++i) p.in[i] = (const float*)d_in[i];
    p.out = (float*)d_out; p.ws = (unsigned char*)d_ws;
#if MK_PER_PHASE_LAUNCH
    for (int k = 0; k < N_PHASES; ++k) { p.ph_lo = k; p.ph_hi = k + 1; hipLaunchKernelGGL(mega_fwd, dim3(grid), dim3(NTHREADS), LDS_BYTES, stream, p); }
#else
    p.ph_lo = 0; p.ph_hi = N_PHASES;
    void* args[] = {&p};
    hipError_t e = hipLaunchCooperativeKernel((const void*)mega_fwd, dim3(grid), dim3(NTHREADS), args, LDS_BYTES, stream);
    if (e != hipSuccess) fprintf(stderr, "kernel_launch: cooperative launch failed: %s (grid %d)\n", hipGetErrorString(e), grid);
#endif
}
```
